# Optimizing an MI355X kernel written in HIP

```python
import jax, jax.numpy as jnp
from jax import lax
import numpy as np

D_MODEL = 1024
BATCH = 8
SEQ = 2048
DEPTH = 2
DEC_BATCH = 128
DEC_SEQ = 4
PAST_LEN = 16384
PAGE_SIZE = 128

CONV_DIM = D_MODEL // 2
CONV_WIDTH = 31
RET_DIM = D_MODEL - CONV_DIM
RET_HEADS = 4
RET_HEAD_DIM = RET_DIM // RET_HEADS
RET_CHUNK = 128
D_FF = 4 * D_MODEL
ROPE_BASE = 10000.0
EPS = 1e-6
IN_COLS = 2 * CONV_DIM + 4 * RET_DIM

kernel_name = "hymba_conformerconv_retention_decode_step"


def rmsnorm(x, g):
    xf = x.astype(jnp.float32)
    y = xf * lax.rsqrt(jnp.mean(xf * xf, axis=-1, keepdims=True) + EPS)
    return (y * g.astype(jnp.float32)).astype(x.dtype)


def rotary(t, pos):
    half = t.shape[-1] // 2
    inv = ROPE_BASE ** (-jnp.arange(half, dtype=jnp.float32) / half)
    ang = pos[:, None] * inv[None, :]
    cos, sin = jnp.cos(ang), jnp.sin(ang)
    t1, t2 = t[..., :half], t[..., half:]
    return jnp.concatenate([t1 * cos - t2 * sin, t2 * cos + t1 * sin], axis=-1)


def retention_log_gamma():
    return jnp.log(1.0 - jnp.exp2(-5.0 - jnp.arange(RET_HEADS, dtype=jnp.float32)))


def retention_chunk(state, q, k, v, log_gamma):
    L = q.shape[2]
    idx = jnp.arange(L, dtype=jnp.float32)
    diff = idx[:, None] - idx[None, :]
    decay = jnp.where(diff[None] >= 0,
                      jnp.exp(log_gamma[:, None, None] * jnp.maximum(diff, 0.0)[None]), 0.0)
    scores = jnp.einsum('bhid,bhjd->bhij', q, k) * decay
    inner = jnp.einsum('bhij,bhjv->bhiv', scores, v)
    cross = jnp.einsum('bhid,bhdv->bhiv', q, state) * jnp.exp(log_gamma[:, None] * (idx + 1.0))[None, :, :, None]
    k_dec = k * jnp.exp(log_gamma[:, None] * (L - 1.0 - idx))[None, :, :, None]
    new_state = state * jnp.exp(log_gamma * L)[None, :, None, None] + jnp.einsum('bhjd,bhjv->bhdv', k_dec, v)
    return new_state, inner + cross


def retention(q, k, v, state):
    B, H, T, d = q.shape
    C = RET_CHUNK if T % RET_CHUNK == 0 else T
    n = T // C
    log_gamma = retention_log_gamma()

    def to_chunks(t):
        return t.reshape(B, H, n, C, t.shape[-1]).transpose(2, 0, 1, 3, 4)

    def step(s, qkv):
        return retention_chunk(s, qkv[0], qkv[1], qkv[2], log_gamma)

    final, outs = lax.scan(step, state, (to_chunks(q), to_chunks(k), to_chunks(v)))
    o = outs.transpose(1, 2, 0, 3, 4).reshape(B, H, T, v.shape[-1])
    return o, final


def mixer(h, conv_buf, ret_state, pos0, w_in, conv_w, conv_b, conv_ln_g, conv_ln_b, ret_gn_g, w_out):
    B, T, _ = h.shape
    proj = h @ w_in
    c0 = 2 * CONV_DIM
    a, b, q, k, v, g = jnp.split(proj, [CONV_DIM, c0, c0 + RET_DIM, c0 + 2 * RET_DIM, c0 + 3 * RET_DIM], axis=-1)

    glu = a * jax.nn.sigmoid(b)
    xp = jnp.concatenate([conv_buf.astype(glu.dtype), glu], axis=1)
    c = lax.conv_general_dilated(xp, conv_w[:, None, :].astype(xp.dtype), (1,), 'VALID',
                                 dimension_numbers=('NWC', 'WIO', 'NWC'),
                                 feature_group_count=CONV_DIM) + conv_b.astype(xp.dtype)
    new_buf = xp[:, -(CONV_WIDTH - 1):]
    cf = c.astype(jnp.float32)
    mu = jnp.mean(cf, axis=-1, keepdims=True)
    var = jnp.mean(jnp.square(cf - mu), axis=-1, keepdims=True)
    cn = (cf - mu) * lax.rsqrt(var + EPS) * conv_ln_g.astype(jnp.float32) + conv_ln_b.astype(jnp.float32)
    conv_out = jax.nn.silu(cn).astype(h.dtype)

    pos = pos0 + jnp.arange(T, dtype=jnp.float32)

    def heads(t):
        return t.reshape(B, T, RET_HEADS, RET_HEAD_DIM).transpose(0, 2, 1, 3).astype(jnp.float32)

    qh = rotary(heads(q), pos)
    kh = rotary(heads(k), pos) * (RET_HEAD_DIM ** -0.5)
    vh = heads(v)
    o, new_state = retention(qh, kh, vh, ret_state.astype(jnp.float32))
    omu = jnp.mean(o, axis=-1, keepdims=True)
    ovar = jnp.mean(jnp.square(o - omu), axis=-1, keepdims=True)
    on = ((o - omu) * lax.rsqrt(ovar + EPS)).transpose(0, 2, 1, 3).reshape(B, T, RET_DIM)
    ret_out = (on * ret_gn_g.astype(jnp.float32) * jax.nn.silu(g.astype(jnp.float32))).astype(h.dtype)

    y = jnp.concatenate([conv_out, ret_out], axis=-1) @ w_out
    return y, new_buf, new_state.astype(ret_state.dtype)


def trunk(x, conv_bufs, ret_states, pos0, norm1_g, w_in, conv_w, conv_b, conv_ln_g, conv_ln_b,
          ret_gn_g, w_out, norm2_g, w_up, w_down, final_norm_g):
    new_bufs, new_states = [], []
    for l in range(DEPTH):
        y, nb, ns = mixer(rmsnorm(x, norm1_g[l]), conv_bufs[l], ret_states[l], pos0, w_in[l], conv_w[l],
                          conv_b[l], conv_ln_g[l], conv_ln_b[l], ret_gn_g[l], w_out[l])
        x = x + y
        hf = rmsnorm(x, norm2_g[l]) @ w_up[l]
        x = x + jnp.square(jax.nn.relu(hf)) @ w_down[l]
        new_bufs.append(nb)
        new_states.append(ns)
    return rmsnorm(x, final_norm_g), jnp.stack(new_bufs), jnp.stack(new_states)


def setup_inputs(seed: int = 0) -> dict:
    key = jax.random.key(seed)
    ks = jax.random.split(key, 20)
    f32 = jnp.float32
    nrm = lambda k, s, sc: jax.random.normal(k, s, f32) * sc
    return {
        "x_prompt": nrm(ks[0], (BATCH, SEQ, D_MODEL), 1.0),
        "x_sample": nrm(ks[1], (DEC_BATCH, DEC_SEQ, D_MODEL), 1.0),
        "cache_conv": nrm(ks[2], (DEPTH, DEC_BATCH, CONV_WIDTH - 1, CONV_DIM), 0.5),
        "state_ret": nrm(ks[3], (DEPTH, DEC_BATCH, RET_HEADS, RET_HEAD_DIM, RET_HEAD_DIM), 0.5),
        "norm1_g": 1.0 + nrm(ks[4], (DEPTH, D_MODEL), 0.02),
        "w_in": nrm(ks[5], (DEPTH, D_MODEL, IN_COLS), D_MODEL ** -0.5),
        "conv_w": nrm(ks[6], (DEPTH, CONV_WIDTH, CONV_DIM), CONV_WIDTH ** -0.5),
        "conv_b": nrm(ks[7], (DEPTH, CONV_DIM), 0.02),
        "conv_ln_g": 1.0 + nrm(ks[8], (DEPTH, CONV_DIM), 0.02),
        "conv_ln_b": nrm(ks[9], (DEPTH, CONV_DIM), 0.02),
        "ret_gn_g": 1.0 + nrm(ks[10], (DEPTH, RET_DIM), 0.02),
        "w_out": nrm(ks[11], (DEPTH, D_MODEL, D_MODEL), D_MODEL ** -0.5),
        "norm2_g": 1.0 + nrm(ks[12], (DEPTH, D_MODEL), 0.02),
        "w_up": nrm(ks[13], (DEPTH, D_MODEL, D_FF), D_MODEL ** -0.5),
        "w_down": nrm(ks[14], (DEPTH, D_FF, D_MODEL), D_FF ** -0.5),
        "final_norm_g": 1.0 + nrm(ks[15], (D_MODEL,), 0.02),
    }


def reference(x_prompt, x_sample, cache_conv, state_ret, norm1_g, w_in, conv_w, conv_b, conv_ln_g,
              conv_ln_b, ret_gn_g, w_out, norm2_g, w_up, w_down, final_norm_g):
    conv0 = jnp.zeros((DEPTH, x_prompt.shape[0], CONV_WIDTH - 1, CONV_DIM), x_prompt.dtype)
    ret0 = jnp.zeros((DEPTH, x_prompt.shape[0], RET_HEADS, RET_HEAD_DIM, RET_HEAD_DIM), state_ret.dtype)
    y_prompt, new_conv_prompt, new_ret_prompt = trunk(
        x_prompt, conv0, ret0, 0.0, norm1_g, w_in, conv_w, conv_b, conv_ln_g, conv_ln_b,
        ret_gn_g, w_out, norm2_g, w_up, w_down, final_norm_g)
    y_sample, new_conv_sample, new_ret_sample = trunk(
        x_sample, cache_conv, state_ret, float(PAST_LEN), norm1_g, w_in, conv_w, conv_b, conv_ln_g,
        conv_ln_b, ret_gn_g, w_out, norm2_g, w_up, w_down, final_norm_g)
    return (y_prompt, y_sample, new_conv_prompt, new_ret_prompt, new_conv_sample, new_ret_sample)
```

```cpp
#include <hip/hip_runtime.h>
#include <hip/hip_cooperative_groups.h>
#include <cstdio>
#include <cstdint>
namespace cg = cooperative_groups;
namespace pg8 {
#define PG8_LAS __attribute__((address_space(3)))
typedef unsigned short bf16_t;
typedef short bf16x8 __attribute__((ext_vector_type(8)));
typedef float f32x4 __attribute__((ext_vector_type(4)));
typedef unsigned u32x4 __attribute__((ext_vector_type(4)));
constexpr int BM = 256, BK = 64, HALF = 128, HTB = HALF * BK * 2  , STAGE_BYTES = 8 * HTB, NXCD = 8, WGM = 8;

__host__ __device__ __forceinline__ int lds_byte(int r, int c) { const int st = (r >> 4) * 2 + (c >> 5), rr = r & 15, cc = c & 31, ob = rr * 64 + cc * 2; return st * 1024 + (ob ^ (((ob >> 9) & 1) << 5)); }
__host__ __device__ __forceinline__ void stage_rc(int b, int& R, int& C) { const int st = b / 1024, sb = b % 1024, swz = sb ^ (((sb >> 9) & 1) << 5); R = (st >> 1) * 16 + swz / 64; C = (st & 1) * 32 + (swz % 64) / 2; }
__host__ __device__ __forceinline__ int perm32(int rho) { const int n = rho >> 4, i = rho & 15; return 8 * (i >> 2) + 4 * n + (i & 3); }

struct Unit { int pm, pn; };
struct Gemm { const bf16_t* A; const bf16_t* Bt; int M, N, K; };

struct StaticOrder {
    int nM, nN, nwg, G, c;
    __host__ __device__ void init(int M, int N, int G_, int c_) { nM = M / BM; nN = N / BM; nwg = nM * nN; G = G_; c = c_; }
    __host__ __device__ bool next(int i, Unit& u) const {
        const long L = (long)i * G + c; if (L >= nwg) return false;
        int wgid = (int)L; { const int q = nwg / NXCD, r = nwg % NXCD, xcd = wgid % NXCD, off = wgid / NXCD; wgid = (xcd < r ? xcd * (q + 1) : r * (q + 1) + (xcd - r) * q) + off; }
        const int nig = WGM * nN, gid = wgid / nig, fm = gid * WGM, gsz = (nM - fm) < WGM ? (nM - fm) : WGM;
        u.pm = fm + ((wgid % nig) % gsz); u.pn = (wgid % nig) / gsz; return true;
    }
    __device__ __forceinline__ void a_ready(const Unit&) const {}
    __device__ __forceinline__ void done(const Unit&) const {}
};
__device__ __forceinline__ unsigned cvt_pk_bf16(float lo, float hi) { unsigned r; asm volatile("v_cvt_pk_bf16_f32 %0, %1, %2" : "=v"(r) : "v"(lo), "v"(hi)); return r; }
typedef float f32x2 __attribute__((ext_vector_type(2)));
template <class Epi, class Sched, bool ALIGN_EPI = false, bool SP2 = false>
__device__ __forceinline__ void gemm_phase(PG8_LAS unsigned char* lds, const Gemm g, const Sched& S, const Epi& E) {
    int tid_ = threadIdx.x; asm volatile("" : "+v"(tid_)); const int tid = tid_, wid = __builtin_amdgcn_readfirstlane(tid >> 6), lane = tid & 63, wr = wid >> 2, wc = wid & 3, fr = lane & 15, fq = lane >> 4;
    const int K = g.K, nt = K / BK;
    unsigned voffA[2], voffB[2];
#pragma unroll
    for (int i = 0; i < 2; ++i) { int R, C; stage_rc(tid * 16 + i * 8192, R, C); const int Rb = Epi::PERM ? ((R & ~31) + perm32(R & 31)) : R;
        voffA[i] = (unsigned)(R * K + C) * 2u; voffB[i] = (unsigned)(Rb * K + C) * 2u; }
    const size_t kstep = (size_t)(BK * 2);
    const size_t hstep = (size_t)HALF * K * 2;
    const size_t tstep = 2 * hstep;
    const unsigned ldsw = (unsigned)wid * 1024u;
    const int aoff = lds_byte(wr * 64 + fr, fq * 8), boff = lds_byte(wc * 32 + fr, fq * 8);
#define PG8_SA(b, h) (((b) * 2 + (h)) * HTB)
#define PG8_SB(b, h) ((4 + (b) * 2 + (h)) * HTB)
#define PG8_STAGE(bufoff, gbase, voff) do { _Pragma("unroll") for (int _i = 0; _i < 2; ++_i) \
        __builtin_amdgcn_global_load_lds((const unsigned*)((const char*)(gbase) + (voff)[_i]), (PG8_LAS unsigned*)(lds + (bufoff) + ldsw + _i * 8192), 16, 0, 0); } while (0)
#define PG8_LDA(dst, b, h) do { _Pragma("unroll") for (int m = 0; m < 4; ++m) _Pragma("unroll") for (int k = 0; k < 2; ++k) dst[m][k] = *(const PG8_LAS bf16x8*)(lds + PG8_SA(b, h) + aoff + m * 2048 + k * 1024); } while (0)
#define PG8_LDB(dst, b, h) do { _Pragma("unroll") for (int n = 0; n < 2; ++n) _Pragma("unroll") for (int k = 0; k < 2; ++k) dst[n][k] = *(const PG8_LAS bf16x8*)(lds + PG8_SB(b, h) + boff + n * 2048 + k * 1024); } while (0)
#define PG8_MMA(ai, bj, At, Bt) do { __builtin_amdgcn_s_setprio(1); _Pragma("unroll") for (int m = 0; m < 4; ++m) _Pragma("unroll") for (int n = 0; n < 2; ++n) _Pragma("unroll") for (int k = 0; k < 2; ++k) \
        acc[ai][bj][m][n] = __builtin_amdgcn_mfma_f32_16x16x32_bf16(Bt[n][k], At[m][k], acc[ai][bj][m][n], 0, 0, 0); __builtin_amdgcn_s_setprio(0); } while (0)
#define PG8_WAIT_V(n) asm volatile("s_waitcnt vmcnt(" #n ")" ::: "memory")
#define PG8_WAIT_L(n) asm volatile("s_waitcnt lgkmcnt(" #n ")" ::: "memory")
#define PG8_BAR __builtin_amdgcn_s_barrier()
#define PG8_SCHED __builtin_amdgcn_sched_barrier(0)
    Unit cur, nxt; int ui = 0;
    if (!S.next(0, cur)) return;
    f32x4 acc[2][2][4][2];
#pragma unroll
    for (int a = 0; a < 2; ++a)
#pragma unroll
        for (int b = 0; b < 2; ++b)
#pragma unroll
            for (int m = 0; m < 4; ++m)
#pragma unroll
                for (int n = 0; n < 2; ++n) acc[a][b][m][n] = (f32x4){0.f, 0.f, 0.f, 0.f};
    bf16x8 At[4][2], B0[2][2], B1[2][2];
    const char* cA = (const char*)g.A + (size_t)cur.pm * tstep; const char* cB = (const char*)g.Bt + (size_t)cur.pn * tstep;
    S.a_ready(cur);
    if constexpr (SP2) {
        PG8_STAGE(PG8_SB(0, 0), cB, voffB); PG8_STAGE(PG8_SB(0, 1), cB + hstep, voffB); PG8_STAGE(PG8_SA(0, 0), cA, voffA); PG8_STAGE(PG8_SA(0, 1), cA + hstep, voffA);
        if (wr == 1) PG8_BAR;
        PG8_WAIT_V(2); PG8_BAR;
        PG8_STAGE(PG8_SB(1, 0), cB + kstep, voffB); PG8_STAGE(PG8_SA(1, 0), cA + kstep, voffA); PG8_STAGE(PG8_SB(1, 1), cB + hstep + kstep, voffB);
        PG8_WAIT_V(6); PG8_BAR;
    } else {
        PG8_STAGE(PG8_SB(0, 0), cB, voffB); PG8_STAGE(PG8_SA(0, 0), cA, voffA); PG8_STAGE(PG8_SB(0, 1), cB + hstep, voffB); PG8_STAGE(PG8_SA(0, 1), cA + hstep, voffA);
        if (wr == 1) PG8_BAR;
        PG8_WAIT_V(4); PG8_BAR;
        PG8_STAGE(PG8_SB(1, 0), cB + kstep, voffB); PG8_STAGE(PG8_SA(1, 0), cA + kstep, voffA); PG8_STAGE(PG8_SB(1, 1), cB + hstep + kstep, voffB);
        PG8_WAIT_V(6); PG8_BAR;
    }
    for (;;) {
        const bool has_next = S.next(ui + 1, nxt);
        const char* nA = has_next ? (const char*)g.A + (size_t)nxt.pm * tstep : cA; const char* nB = has_next ? (const char*)g.Bt + (size_t)nxt.pn * tstep : cB;
        for (int t = 0; t < nt; t += 2) {
            const bool last = (t == nt - 2);
            const char* a1 = cA + (size_t)(t + 1) * kstep;
            const char* a2 = last ? nA : cA + (size_t)(t + 2) * kstep; const char* b2 = last ? nB : cB + (size_t)(t + 2) * kstep;
            const char* a3 = a2 + kstep; const char* b3 = b2 + kstep;
            if (last && has_next) S.a_ready(nxt);
            if constexpr (SP2) {
            PG8_LDB(B0, 0, 0); PG8_LDB(B1, 0, 1); PG8_SCHED; PG8_LDA(At, 0, 0); PG8_STAGE(PG8_SA(1, 1), a1 + hstep, voffA);
            PG8_WAIT_V(8); PG8_WAIT_L(0); PG8_BAR; PG8_MMA(0, 0, At, B0); PG8_MMA(0, 1, At, B1); PG8_BAR; PG8_SCHED;
            PG8_LDA(At, 0, 1); PG8_STAGE(PG8_SB(0, 0), b2, voffB); PG8_STAGE(PG8_SB(0, 1), b2 + hstep, voffB); PG8_STAGE(PG8_SA(0, 0), a2, voffA);
            PG8_WAIT_V(8); PG8_WAIT_L(0); PG8_BAR; PG8_MMA(1, 0, At, B0); PG8_MMA(1, 1, At, B1); PG8_BAR; PG8_SCHED;
            PG8_LDB(B0, 1, 0); PG8_LDB(B1, 1, 1); PG8_SCHED; PG8_LDA(At, 1, 0); PG8_STAGE(PG8_SA(0, 1), a2 + hstep, voffA);
            PG8_WAIT_V(8); PG8_WAIT_L(0); PG8_BAR; PG8_MMA(0, 0, At, B0); PG8_MMA(0, 1, At, B1); PG8_BAR; PG8_SCHED;
            PG8_LDA(At, 1, 1); PG8_STAGE(PG8_SB(1, 0), b3, voffB); PG8_STAGE(PG8_SB(1, 1), b3 + hstep, voffB); PG8_STAGE(PG8_SA(1, 0), a3, voffA);
            PG8_WAIT_V(8); PG8_WAIT_L(0); PG8_BAR; PG8_MMA(1, 0, At, B0); PG8_MMA(1, 1, At, B1); PG8_BAR; PG8_SCHED;
            } else {
            PG8_LDB(B0, 0, 0); PG8_SCHED; PG8_LDA(At, 0, 0); PG8_STAGE(PG8_SA(1, 1), a1 + hstep, voffA);
            PG8_WAIT_L(8); PG8_BAR; PG8_WAIT_L(0); PG8_MMA(0, 0, At, B0); PG8_BAR; PG8_SCHED;
            PG8_LDB(B1, 0, 1); PG8_STAGE(PG8_SB(0, 0), b2, voffB);
            PG8_BAR; PG8_WAIT_L(0); PG8_MMA(0, 1, At, B1); PG8_BAR;
            PG8_LDA(At, 0, 1); PG8_STAGE(PG8_SA(0, 0), a2, voffA);
            PG8_BAR; PG8_WAIT_L(0); PG8_MMA(1, 0, At, B0); PG8_BAR; PG8_SCHED;
            PG8_STAGE(PG8_SB(0, 1), b2 + hstep, voffB);
            PG8_WAIT_V(6); PG8_BAR; PG8_MMA(1, 1, At, B1); PG8_BAR;
            PG8_LDB(B0, 1, 0); PG8_SCHED; PG8_LDA(At, 1, 0); PG8_STAGE(PG8_SA(0, 1), a2 + hstep, voffA);
            PG8_WAIT_L(8); PG8_BAR; PG8_WAIT_L(0); PG8_MMA(0, 0, At, B0); PG8_BAR; PG8_SCHED;
            PG8_LDB(B1, 1, 1); PG8_STAGE(PG8_SB(1, 0), b3, voffB);
            PG8_BAR; PG8_WAIT_L(0); PG8_MMA(0, 1, At, B1); PG8_BAR;
            PG8_LDA(At, 1, 1); PG8_STAGE(PG8_SA(1, 0), a3, voffA);
            PG8_BAR; PG8_WAIT_L(0); PG8_MMA(1, 0, At, B0); PG8_BAR; PG8_SCHED;
            PG8_STAGE(PG8_SB(1, 1), b3 + hstep, voffB);
            PG8_WAIT_V(6); PG8_BAR; PG8_MMA(1, 1, At, B1); PG8_BAR;
            }
        }
        if constexpr (ALIGN_EPI) { if (wr == 0) PG8_BAR; }
        if constexpr (!Epi::AFTER_DRAIN) { E(acc, cur, wr, wc, fr, fq); S.done(cur); }
        if (!has_next) break;
#pragma unroll
        for (int a = 0; a < 2; ++a)
#pragma unroll
            for (int b = 0; b < 2; ++b)
#pragma unroll
                for (int m = 0; m < 4; ++m)
#pragma unroll
                    for (int n = 0; n < 2; ++n) acc[a][b][m][n] = (f32x4){0.f, 0.f, 0.f, 0.f};
        cur = nxt; cA = nA; cB = nB; ++ui;
        if constexpr (ALIGN_EPI) { if (wr == 1) PG8_BAR; }
    }
    PG8_WAIT_V(0);
    if constexpr (!ALIGN_EPI) { if (wr == 0) PG8_BAR; }
    PG8_BAR;
    if constexpr (Epi::AFTER_DRAIN) { E.fused(acc, cur, wr, wc, fr, fq, lds, wid, lane); S.done(cur); }
#undef PG8_SA
#undef PG8_SB
#undef PG8_STAGE
#undef PG8_LDA
#undef PG8_LDB
#undef PG8_MMA
#undef PG8_WAIT_V
#undef PG8_WAIT_L
#undef PG8_BAR
#undef PG8_SCHED
}
}

#ifndef REP_P0
#define REP_P0 1
#endif
#ifndef REP_BIG
#define REP_BIG 1
#endif
#ifndef REP_SMALL
#define REP_SMALL 1
#endif
#ifndef REP_P2
#define REP_P2 1
#endif
#ifndef REP_P3
#define REP_P3 1
#endif
#define LAS __attribute__((address_space(3)))
typedef unsigned short bf16;
typedef float f32x4 __attribute__((ext_vector_type(4)));
typedef float f32x2 __attribute__((ext_vector_type(2)));
typedef unsigned u32x4 __attribute__((ext_vector_type(4)));
typedef unsigned u32x2 __attribute__((ext_vector_type(2)));
typedef short bf16x8 __attribute__((ext_vector_type(8)));
typedef short s16x4 __attribute__((ext_vector_type(4)));

constexpr int D = 1024, MP = 16384, MS = 512, M = MP + MS, SEQ = 2048, NIN = 3072, FF = 4096, CD = 512, NH = 4, HD = 128, CW = 31, NPOS = 2052;
constexpr float EPS = 1e-6f;
constexpr int NWAVES = 8, NTHREADS = 512;
constexpr int LDS_BYTES = 147456;
constexpr size_t MiB = 1u << 20;
constexpr size_t WS_CTL = 0, CTL_BYTES = 65536;
constexpr size_t WS_ROPE = 1 * MiB;
constexpr size_t WS_ZERO = 2 * MiB + 512 * 1024;
constexpr size_t WS_SSQ = 3 * MiB;
constexpr size_t WS_W = 4 * MiB, W_LAYER = 24 * MiB;
constexpr size_t W_IN = 0, W_OUT = 6 * MiB, W_UP = 8 * MiB, W_DN = 16 * MiB;
constexpr size_t WS_XN = 52 * MiB;
constexpr size_t WS_R1 = 85 * MiB;
constexpr size_t WS_H = WS_R1;
constexpr size_t ACT512 = (size_t)M * 512 * 2;
constexpr size_t WS_GLU = WS_R1, WS_Q = WS_GLU + ACT512, WS_K = WS_Q + ACT512, WS_V = WS_K + ACT512, WS_GATE = WS_V + ACT512;
constexpr size_t WS_MIX = WS_GATE + ACT512;
constexpr size_t WS_KV = WS_MIX + (size_t)M * 1024 * 2;
constexpr size_t WS_SB = WS_KV + 32 * MiB;
constexpr size_t WS_END = WS_SB + 16 * MiB;
static_assert(WS_END <= 256 * MiB, "ws map");
static_assert(WS_H + (size_t)M * FF * 2 <= WS_END, "ws map H");
constexpr size_t O_Y = 0, O_CP = (size_t)M * D, O_RP = O_CP + 2 * 8 * 30 * 512, O_CS = O_RP + 2 * 8 * 4 * 128 * 128, O_RS = O_CS + 2 * 128 * 30 * 512;

__device__ const float ROPE_INV[64] = {
1.0f, 0.865964353f, 0.749894202f, 0.649381638f, 0.562341332f, 0.486967534f, 0.421696514f, 0.365174115f, 0.316227764f, 0.273841977f, 0.237137377f, 0.2053525f, 0.177827939f, 0.153992653f, 0.133352146f, 0.115478195f, 0.100000001f, 0.0865964293f, 0.0749894232f, 0.0649381652f, 0.0562341325f, 0.0486967526f, 0.0421696492f, 0.0365174115f, 0.0316227749f, 0.0273841955f, 0.0237137377f, 0.0205352511f, 0.0177827943f, 0.0153992651f, 0.013335214f, 0.0115478197f, 0.00999999978f, 0.00865964312f, 0.00749894232f, 0.00649381615f, 0.00562341325f, 0.00486967526f, 0.00421696482f, 0.00365174119f, 0.00316227763f, 0.00273841969f, 0.00237137382f, 0.00205352507f, 0.00177827943f, 0.00153992651f, 0.00133352145f, 0.00115478202f, 0.00100000005f, 0.000865964335f, 0.000749894185f, 0.000649381604f, 0.000562341302f, 0.000486967532f, 0.000421696517f, 0.000365174114f, 0.000316227757f, 0.000273841957f, 0.00023713737f, 0.00020535251f, 0.00017782794f, 0.00015399266f, 0.00013335215f, 0.0001154782f
};

struct Args { const float* in[16]; float* out; unsigned char* ws; };

__device__ __forceinline__ float bf2f(unsigned short x) { return __uint_as_float(((unsigned)x) << 16); }
__device__ __forceinline__ float bflo(unsigned w) { return __uint_as_float(w << 16); }
__device__ __forceinline__ float bfhi(unsigned w) { return __uint_as_float(w & 0xffff0000u); }
typedef __bf16 bf16x2_t __attribute__((ext_vector_type(2)));
__device__ __forceinline__ unsigned pk_bf16(float lo, float hi) { const f32x2 v = {lo, hi}; return __builtin_bit_cast(unsigned, __builtin_convertvector(v, bf16x2_t)); }
__device__ __forceinline__ float wave_sum(float v) {
#pragma unroll
    for (int o = 1; o < 64; o <<= 1) v += __shfl_xor(v, o);
    return v;
}
__device__ __forceinline__ int ltid() { int t = threadIdx.x; asm volatile("" : "+v"(t)); return t; }
__device__ __forceinline__ float fast_rcp(float x) { return __builtin_amdgcn_rcpf(x); }
__device__ __forceinline__ float sigmoidf_(float x) { return fast_rcp(1.0f + __expf(-x)); }

struct EpiIn {
    static constexpr bool PERM = true, AFTER_DRAIN = false;
    const float* ssq; bf16 *glu, *q, *k, *v, *gate; const f32x2* rope; const float* gn_g;
    __device__ __forceinline__ void operator()(const f32x4 (&acc)[2][2][4][2], const pg8::Unit& u, int wr, int wc, int fr, int fq) const {
        const int pn = u.pn, cl = wc * 32 + fq * 8;
#pragma unroll
        for (int ai = 0; ai < 2; ++ai)
#pragma unroll
            for (int m = 0; m < 4; ++m) {
                const int row = u.pm * 256 + ai * 128 + wr * 64 + m * 16 + fr;
                const float rstd = rsqrtf(ssq[row] * (1.0f / D) + EPS);
                const f32x4 a0 = acc[ai][0][m][0] * rstd, a1 = acc[ai][0][m][1] * rstd, b0 = acc[ai][1][m][0] * rstd, b1 = acc[ai][1][m][1] * rstd;
                if (pn < 4) {
                    u32x4 w;
                    w.x = pk_bf16(a0[0] * sigmoidf_(b0[0]), a0[1] * sigmoidf_(b0[1])); w.y = pk_bf16(a0[2] * sigmoidf_(b0[2]), a0[3] * sigmoidf_(b0[3]));
                    w.z = pk_bf16(a1[0] * sigmoidf_(b1[0]), a1[1] * sigmoidf_(b1[1])); w.w = pk_bf16(a1[2] * sigmoidf_(b1[2]), a1[3] * sigmoidf_(b1[3]));
                    *(u32x4*)(glu + (size_t)row * 512 + pn * 128 + cl) = w;
                } else if (pn < 8) {
                    const int which = (pn - 4) >> 1, tp = pn & 1, head = 2 * tp + (wc >> 1), dlo = (wc & 1) * 32 + fq * 8;
                    const int prow = row < MP ? (row & (SEQ - 1)) : SEQ + ((row - MP) & 3);
                    const f32x4* rp = (const f32x4*)(rope + (size_t)prow * 64 + dlo);
                    const f32x4 c01 = rp[0], c23 = rp[1], c45 = rp[2], c67 = rp[3];
                    const float sc = which ? 0.08838834764831845f : 1.0f;
                    float o1[8], o2[8];
                    o1[0] = a0[0] * c01[0] - b0[0] * c01[1]; o2[0] = b0[0] * c01[0] + a0[0] * c01[1];
                    o1[1] = a0[1] * c01[2] - b0[1] * c01[3]; o2[1] = b0[1] * c01[2] + a0[1] * c01[3];
                    o1[2] = a0[2] * c23[0] - b0[2] * c23[1]; o2[2] = b0[2] * c23[0] + a0[2] * c23[1];
                    o1[3] = a0[3] * c23[2] - b0[3] * c23[3]; o2[3] = b0[3] * c23[2] + a0[3] * c23[3];
                    o1[4] = a1[0] * c45[0] - b1[0] * c45[1]; o2[4] = b1[0] * c45[0] + a1[0] * c45[1];
                    o1[5] = a1[1] * c45[2] - b1[1] * c45[3]; o2[5] = b1[1] * c45[2] + a1[1] * c45[3];
                    o1[6] = a1[2] * c67[0] - b1[2] * c67[1]; o2[6] = b1[2] * c67[0] + a1[2] * c67[1];
                    o1[7] = a1[3] * c67[2] - b1[3] * c67[3]; o2[7] = b1[3] * c67[2] + a1[3] * c67[3];
                    bf16* dst = (which ? k : q) + (size_t)row * 512 + head * 128 + dlo;
                    u32x4 w1, w2;
                    w1.x = pk_bf16(o1[0] * sc, o1[1] * sc); w1.y = pk_bf16(o1[2] * sc, o1[3] * sc); w1.z = pk_bf16(o1[4] * sc, o1[5] * sc); w1.w = pk_bf16(o1[6] * sc, o1[7] * sc);
                    w2.x = pk_bf16(o2[0] * sc, o2[1] * sc); w2.y = pk_bf16(o2[2] * sc, o2[3] * sc); w2.z = pk_bf16(o2[4] * sc, o2[5] * sc); w2.w = pk_bf16(o2[6] * sc, o2[7] * sc);
                    *(u32x4*)dst = w1; *(u32x4*)(dst + 64) = w2;
                } else if (pn < 10) {
                    bf16* dst = v + (size_t)row * 512 + (pn - 8) * 256 + cl;
                    u32x4 w1, w2;
                    w1.x = pk_bf16(a0[0], a0[1]); w1.y = pk_bf16(a0[2], a0[3]); w1.z = pk_bf16(a1[0], a1[1]); w1.w = pk_bf16(a1[2], a1[3]);
                    w2.x = pk_bf16(b0[0], b0[1]); w2.y = pk_bf16(b0[2], b0[3]); w2.z = pk_bf16(b1[0], b1[1]); w2.w = pk_bf16(b1[2], b1[3]);
                    *(u32x4*)dst = w1; *(u32x4*)(dst + 128) = w2;
                } else {
                    const int c0 = (pn - 10) * 256 + cl;
                    const f32x4 g0 = *(const f32x4*)(gn_g + c0), g1 = *(const f32x4*)(gn_g + c0 + 4), g2 = *(const f32x4*)(gn_g + c0 + 128), g3 = *(const f32x4*)(gn_g + c0 + 132);
                    bf16* dst = gate + (size_t)row * 512 + c0;
                    u32x4 w1, w2;
                    w1.x = pk_bf16(a0[0] * sigmoidf_(a0[0]) * g0[0], a0[1] * sigmoidf_(a0[1]) * g0[1]); w1.y = pk_bf16(a0[2] * sigmoidf_(a0[2]) * g0[2], a0[3] * sigmoidf_(a0[3]) * g0[3]);
                    w1.z = pk_bf16(a1[0] * sigmoidf_(a1[0]) * g1[0], a1[1] * sigmoidf_(a1[1]) * g1[1]); w1.w = pk_bf16(a1[2] * sigmoidf_(a1[2]) * g1[2], a1[3] * sigmoidf_(a1[3]) * g1[3]);
                    w2.x = pk_bf16(b0[0] * sigmoidf_(b0[0]) * g2[0], b0[1] * sigmoidf_(b0[1]) * g2[1]); w2.y = pk_bf16(b0[2] * sigmoidf_(b0[2]) * g2[2], b0[3] * sigmoidf_(b0[3]) * g2[3]);
                    w2.z = pk_bf16(b1[0] * sigmoidf_(b1[0]) * g3[0], b1[1] * sigmoidf_(b1[1]) * g3[1]); w2.w = pk_bf16(b1[2] * sigmoidf_(b1[2]) * g3[2], b1[3] * sigmoidf_(b1[3]) * g3[3]);
                    *(u32x4*)dst = w1; *(u32x4*)(dst + 128) = w2;
                }
            }
    }

    __device__ __forceinline__ int brow(int cg, int fb) const { return 256 * (cg >> 2) + 32 * (cg & 3) + (fb >> 1) * 128 + (fb & 1) * 16; }
    __device__ __forceinline__ void small(int row, int cg, int s4, f32x4 a, f32x4 b) const {
        const int pn = cg >> 2, cl = 32 * (cg & 3) + s4;
        const float rstd = rsqrtf(ssq[row] * (1.0f / D) + EPS);
        a = a * rstd; b = b * rstd;
        if (pn < 4) {
            u32x2 w; w.x = pk_bf16(a[0] * sigmoidf_(b[0]), a[1] * sigmoidf_(b[1])); w.y = pk_bf16(a[2] * sigmoidf_(b[2]), a[3] * sigmoidf_(b[3]));
            *(u32x2*)(glu + (size_t)row * 512 + pn * 128 + cl) = w;
        } else if (pn < 8) {
            const int which = (pn - 4) >> 1, tp = pn & 1, head = 2 * tp + (cl >> 6), dlo = cl & 63;
            const int prow = row < MP ? (row & (SEQ - 1)) : SEQ + ((row - MP) & 3);
            const f32x4* rp = (const f32x4*)(rope + (size_t)prow * 64 + dlo);
            const f32x4 c01 = rp[0], c23 = rp[1];
            const float sc = which ? 0.08838834764831845f : 1.0f;
            const float p0 = a[0] * c01[0] - b[0] * c01[1], r0 = b[0] * c01[0] + a[0] * c01[1];
            const float p1 = a[1] * c01[2] - b[1] * c01[3], r1 = b[1] * c01[2] + a[1] * c01[3];
            const float p2 = a[2] * c23[0] - b[2] * c23[1], r2 = b[2] * c23[0] + a[2] * c23[1];
            const float p3 = a[3] * c23[2] - b[3] * c23[3], r3 = b[3] * c23[2] + a[3] * c23[3];
            bf16* dst = (which ? k : q) + (size_t)row * 512 + head * 128 + dlo;
            u32x2 w1, w2; w1.x = pk_bf16(p0 * sc, p1 * sc); w1.y = pk_bf16(p2 * sc, p3 * sc); w2.x = pk_bf16(r0 * sc, r1 * sc); w2.y = pk_bf16(r2 * sc, r3 * sc);
            *(u32x2*)dst = w1; *(u32x2*)(dst + 64) = w2;
        } else if (pn < 10) {
            bf16* dst = v + (size_t)row * 512 + (pn - 8) * 256 + cl;
            u32x2 w1, w2; w1.x = pk_bf16(a[0], a[1]); w1.y = pk_bf16(a[2], a[3]); w2.x = pk_bf16(b[0], b[1]); w2.y = pk_bf16(b[2], b[3]);
            *(u32x2*)dst = w1; *(u32x2*)(dst + 128) = w2;
        } else {
            const int c0 = (pn - 10) * 256 + cl;
            const f32x4 g0 = *(const f32x4*)(gn_g + c0), g2 = *(const f32x4*)(gn_g + c0 + 128);
            bf16* dst = gate + (size_t)row * 512 + c0;
            u32x2 w1, w2;
            w1.x = pk_bf16(a[0] * sigmoidf_(a[0]) * g0[0], a[1] * sigmoidf_(a[1]) * g0[1]); w1.y = pk_bf16(a[2] * sigmoidf_(a[2]) * g0[2], a[3] * sigmoidf_(a[3]) * g0[3]);
            w2.x = pk_bf16(b[0] * sigmoidf_(b[0]) * g2[0], b[1] * sigmoidf_(b[1]) * g2[1]); w2.y = pk_bf16(b[2] * sigmoidf_(b[2]) * g2[2], b[3] * sigmoidf_(b[3]) * g2[3]);
            *(u32x2*)dst = w1; *(u32x2*)(dst + 128) = w2;
        }
    }
};

struct EpiRes {
    static constexpr bool PERM = true, AFTER_DRAIN = false;
    bf16* xs; float* ssq;
    __device__ __forceinline__ void operator()(const f32x4 (&acc)[2][2][4][2], const pg8::Unit& u, int wr, int wc, int fr, int fq) const {
        const int colb = u.pn * 256 + wc * 32 + fq * 8;
#pragma unroll
        for (int ai = 0; ai < 2; ++ai)
#pragma unroll
            for (int m = 0; m < 4; ++m) {
                const int row = u.pm * 256 + ai * 128 + wr * 64 + m * 16 + fr;
                float ss = 0.f;
#pragma unroll
                for (int bj = 0; bj < 2; ++bj) {
                    bf16* p = xs + (size_t)row * D + colb + bj * 128;
                    const u32x4 rv = *(const u32x4*)p;
                    const f32x4 a0 = acc[ai][bj][m][0], a1 = acc[ai][bj][m][1];
                    const float x0 = bflo(rv.x) + a0[0], x1 = bfhi(rv.x) + a0[1], x2 = bflo(rv.y) + a0[2], x3 = bfhi(rv.y) + a0[3];
                    const float x4 = bflo(rv.z) + a1[0], x5 = bfhi(rv.z) + a1[1], x6 = bflo(rv.w) + a1[2], x7 = bfhi(rv.w) + a1[3];
                    ss += (x0 * x0 + x1 * x1) + (x2 * x2 + x3 * x3) + (x4 * x4 + x5 * x5) + (x6 * x6 + x7 * x7);
                    u32x4 w; w.x = pk_bf16(x0, x1); w.y = pk_bf16(x2, x3); w.z = pk_bf16(x4, x5); w.w = pk_bf16(x6, x7);
                    *(u32x4*)p = w;
                }
                ss += __shfl_xor(ss, 16); ss += __shfl_xor(ss, 32);
                if (fq == 0) unsafeAtomicAdd(ssq + row, ss);
            }
    }
    __device__ __forceinline__ int brow(int cg, int fb) const { return 64 * cg + 16 * fb; }
    __device__ __forceinline__ void small(int row, int cg, int s4, f32x4 a, f32x4 b) const {
        bf16* p = xs + (size_t)row * D + 64 * cg + s4;
        const u32x2 r0 = *(const u32x2*)p, r1 = *(const u32x2*)(p + 32);
        const float x0 = bflo(r0.x) + a[0], x1 = bfhi(r0.x) + a[1], x2 = bflo(r0.y) + a[2], x3 = bfhi(r0.y) + a[3];
        const float x4 = bflo(r1.x) + b[0], x5 = bfhi(r1.x) + b[1], x6 = bflo(r1.y) + b[2], x7 = bfhi(r1.y) + b[3];
        float ss = (x0 * x0 + x1 * x1) + (x2 * x2 + x3 * x3) + (x4 * x4 + x5 * x5) + (x6 * x6 + x7 * x7);
        u32x2 w0, w1; w0.x = pk_bf16(x0, x1); w0.y = pk_bf16(x2, x3); w1.x = pk_bf16(x4, x5); w1.y = pk_bf16(x6, x7);
        *(u32x2*)p = w0; *(u32x2*)(p + 32) = w1;
        ss += __shfl_xor(ss, 1); ss += __shfl_xor(ss, 2); ss += __shfl_xor(ss, 4);
        if ((s4 >> 2) == 0) unsafeAtomicAdd(ssq + row, ss);
    }
};

struct EpiUp {
    static constexpr bool PERM = true, AFTER_DRAIN = false;
    const float* ssq; bf16* h;
    __device__ __forceinline__ void operator()(const f32x4 (&acc)[2][2][4][2], const pg8::Unit& u, int wr, int wc, int fr, int fq) const {
        const int colb = u.pn * 256 + wc * 32 + fq * 8;
#pragma unroll
        for (int ai = 0; ai < 2; ++ai)
#pragma unroll
            for (int m = 0; m < 4; ++m) {
                const int row = u.pm * 256 + ai * 128 + wr * 64 + m * 16 + fr;
                const float rstd = rsqrtf(ssq[row] * (1.0f / D) + EPS);
#pragma unroll
                for (int bj = 0; bj < 2; ++bj) {
                    f32x4 x0 = acc[ai][bj][m][0] * rstd, x1 = acc[ai][bj][m][1] * rstd;
#pragma unroll
                    for (int e = 0; e < 4; ++e) { const float t0 = fmaxf(x0[e], 0.f), t1 = fmaxf(x1[e], 0.f); x0[e] = t0 * t0; x1[e] = t1 * t1; }
                    u32x4 w; w.x = pk_bf16(x0[0], x0[1]); w.y = pk_bf16(x0[2], x0[3]); w.z = pk_bf16(x1[0], x1[1]); w.w = pk_bf16(x1[2], x1[3]);
                    *(u32x4*)(h + (size_t)row * FF + colb + bj * 128) = w;
                }
            }
    }

    __device__ __forceinline__ int brow(int cg, int fb) const { return 64 * cg + 16 * fb; }
    __device__ __forceinline__ void small(int row, int cg, int s4, f32x4 a, f32x4 b) const {
        const float rstd = rsqrtf(ssq[row] * (1.0f / D) + EPS);
        const int col = 64 * cg + s4;
#pragma unroll
        for (int e = 0; e < 4; ++e) { const float t0 = fmaxf(a[e] * rstd, 0.f), t1 = fmaxf(b[e] * rstd, 0.f); a[e] = t0 * t0; b[e] = t1 * t1; }
        u32x2 w0, w1; w0.x = pk_bf16(a[0], a[1]); w0.y = pk_bf16(a[2], a[3]); w1.x = pk_bf16(b[0], b[1]); w1.y = pk_bf16(b[2], b[3]);
        *(u32x2*)(h + (size_t)row * FF + col) = w0; *(u32x2*)(h + (size_t)row * FF + col + 32) = w1;
    }
};

constexpr int SG_LD = 68;
template <class Epi, int RT>
__device__ __forceinline__ void small_gemm(LAS unsigned char* lds, const bf16* A, const bf16* Bt, int K, int ncg, const Epi& E) {
    const int tid = ltid(), lane = tid & 63, wave = __builtin_amdgcn_readfirstlane(tid >> 6), r = lane & 15, q = lane >> 4;
    constexpr int KS = RT == 2 ? 4 : 8;
    const int kw = K / KS, kq = RT == 2 ? (wave & 3) : wave, rh = RT == 2 ? (wave >> 2) : 0;
    for (int it = blockIdx.x; it < (8 / RT) * ncg; it += gridDim.x) {
        const int rt = it / ncg, cg = it % ncg;
        const int rowbase = MP + 64 * RT * rt;
        const bf16* ap = A + (size_t)(rowbase + 64 * rh + r) * K + kq * kw + 8 * q;
        const bf16* bp0 = Bt + (size_t)(E.brow(cg, 0) + r) * K + kq * kw + 8 * q;
        const bf16* bp1 = Bt + (size_t)(E.brow(cg, 1) + r) * K + kq * kw + 8 * q;
        const bf16* bp2 = Bt + (size_t)(E.brow(cg, 2) + r) * K + kq * kw + 8 * q;
        const bf16* bp3 = Bt + (size_t)(E.brow(cg, 3) + r) * K + kq * kw + 8 * q;
        f32x4 acc[4][4];
#pragma unroll
        for (int i = 0; i < 4; ++i)
#pragma unroll
            for (int j = 0; j < 4; ++j) acc[i][j] = (f32x4){0.f, 0.f, 0.f, 0.f};
        {
            LAS unsigned char* st = lds + wave * 9216;
            const int lrow = lane >> 3, lch = lane & 7;
            const bf16* ag = A + (size_t)(rowbase + 64 * rh + lrow) * K + kq * kw + lch * 8;
            const bf16* bg0 = Bt + (size_t)(E.brow(cg, 0) + lrow) * K + kq * kw + lch * 8;
            const bf16* bg1 = Bt + (size_t)(E.brow(cg, 1) + lrow) * K + kq * kw + lch * 8;
            const bf16* bg2 = Bt + (size_t)(E.brow(cg, 2) + lrow) * K + kq * kw + lch * 8;
            const bf16* bg3 = Bt + (size_t)(E.brow(cg, 3) + lrow) * K + kq * kw + lch * 8;
            const int wro = lrow * 144 + lch * 16, fro = r * 144 + q * 16;
            u32x4 ga[8], gb[8];
#define SG_GLOAD_A(kk) do { _Pragma("unroll") for (int i = 0; i < 8; ++i) ga[i] = *(const u32x4*)(ag + (size_t)(8 * i) * K + (kk)); } while (0)
#define SG_GLOAD_B(kk) do { \
            gb[0] = *(const u32x4*)(bg0 + (kk)); gb[1] = *(const u32x4*)(bg0 + (size_t)8 * K + (kk)); gb[2] = *(const u32x4*)(bg1 + (kk)); gb[3] = *(const u32x4*)(bg1 + (size_t)8 * K + (kk)); \
            gb[4] = *(const u32x4*)(bg2 + (kk)); gb[5] = *(const u32x4*)(bg2 + (size_t)8 * K + (kk)); gb[6] = *(const u32x4*)(bg3 + (kk)); gb[7] = *(const u32x4*)(bg3 + (size_t)8 * K + (kk)); } while (0)
            SG_GLOAD_A(0); SG_GLOAD_B(0);
#pragma unroll 1
            for (int kk = 0; kk < kw; kk += 64) {
                bf16x8 a[2][4], b[2][4];
#pragma unroll
                for (int i = 0; i < 8; ++i) *(LAS u32x4*)(st + i * (8 * 144) + wro) = ga[i];
                if (kk + 64 < kw) SG_GLOAD_A(kk + 64);
#pragma unroll
                for (int ks = 0; ks < 2; ++ks)
#pragma unroll
                    for (int fa = 0; fa < 4; ++fa) a[ks][fa] = *(const LAS bf16x8*)(st + fa * (16 * 144) + fro + ks * 64);
                asm volatile("s_waitcnt lgkmcnt(0)" ::: "memory");
#pragma unroll
                for (int i = 0; i < 8; ++i) *(LAS u32x4*)(st + i * (8 * 144) + wro) = gb[i];
                if (kk + 64 < kw) SG_GLOAD_B(kk + 64);
#pragma unroll
                for (int ks = 0; ks < 2; ++ks)
#pragma unroll
                    for (int fb = 0; fb < 4; ++fb) b[ks][fb] = *(const LAS bf16x8*)(st + fb * (16 * 144) + fro + ks * 64);
                asm volatile("s_waitcnt lgkmcnt(0)" ::: "memory");
#pragma unroll
                for (int ks = 0; ks < 2; ++ks)
#pragma unroll
                    for (int fa = 0; fa < 4; ++fa)
#pragma unroll
                        for (int fb = 0; fb < 4; ++fb) acc[fa][fb] = __builtin_amdgcn_mfma_f32_16x16x32_bf16(b[ks][fb], a[ks][fa], acc[fa][fb], 0, 0, 0);
            }
#undef SG_GLOAD_A
#undef SG_GLOAD_B
        }
        __syncthreads();
        LAS float* part = (LAS float*)lds + wave * (64 * SG_LD);
#pragma unroll
        for (int fa = 0; fa < 4; ++fa)
#pragma unroll
            for (int fb = 0; fb < 4; ++fb) *(LAS f32x4*)(part + (16 * fa + r) * SG_LD + 16 * fb + 4 * q) = acc[fa][fb];
        __syncthreads();
        if (RT == 1) {
            const int row = tid >> 3, s4 = (tid & 7) * 4;
            f32x4 va = (f32x4){0.f, 0.f, 0.f, 0.f}, vb = va;
#pragma unroll
            for (int w = 0; w < 8; ++w) { const LAS float* p = (const LAS float*)lds + w * (64 * SG_LD) + row * SG_LD + s4; va += *(const LAS f32x4*)p; vb += *(const LAS f32x4*)(p + 32); }
            E.small(rowbase + row, cg, s4, va, vb);
        } else {
            const int row = tid >> 2, rr = row & 63, hh = row >> 6;
#pragma unroll
            for (int j = 0; j < 2; ++j) {
                const int s4 = (tid & 3) * 4 + 16 * j;
                f32x4 va = (f32x4){0.f, 0.f, 0.f, 0.f}, vb = va;
#pragma unroll
                for (int w = 0; w < 4; ++w) { const LAS float* p = (const LAS float*)lds + (hh * 4 + w) * (64 * SG_LD) + rr * SG_LD + s4; va += *(const LAS f32x4*)p; vb += *(const LAS f32x4*)(p + 32); }
                E.small(rowbase + row, cg, s4, va, vb);
            }
        }
        __syncthreads();
    }
}

__device__ __forceinline__ int win_dest_row(int s) {
    if (s < 512) return ((s >> 7) << 8) + (s & 127);
    if (s < 1024) { const int t = s - 512; return ((t >> 7) << 8) + 128 + (t & 127); }
    if (s < 2048) { const int t = s - 1024; const int which = t >> 9, hd = (t >> 7) & 3, d = t & 127; return 1024 + which * 512 + (hd >> 1) * 256 + (d >> 6) * 128 + (hd & 1) * 64 + (d & 63); }
    return s;
}
__device__ __forceinline__ void p0_transpose_item(const float* W, const float* gk, int K, int N, bf16* WT, bool perm, LAS float* scr, int item, int lane) {
    const int nblk = N / 32, kb = item / nblk, nb = item % nblk, k0 = 64 * kb, n0 = 32 * nb;
#pragma unroll
    for (int i = 0; i < 32; ++i) { const int kk = 2 * i + (lane >> 5); const float gg = gk ? gk[k0 + kk] : 1.0f; scr[kk * 33 + (lane & 31)] = gg * __builtin_nontemporal_load(W + (size_t)(k0 + kk) * N + n0 + (lane & 31)); }
    asm volatile("s_waitcnt lgkmcnt(0)" ::: "memory");
    const int c = lane & 7;
    const int drow0 = perm ? win_dest_row(n0) : n0;
#pragma unroll
    for (int j = 0; j < 4; ++j) { const int n = (lane >> 3) + 8 * j; const LAS float* s = scr + (8 * c) * 33 + n;
        u32x4 o; o.x = pk_bf16(s[0 * 33], s[1 * 33]); o.y = pk_bf16(s[2 * 33], s[3 * 33]); o.z = pk_bf16(s[4 * 33], s[5 * 33]); o.w = pk_bf16(s[6 * 33], s[7 * 33]);
        *(u32x4*)(WT + (size_t)(drow0 + n) * K + k0 + 8 * c) = o; }
    asm volatile("s_waitcnt lgkmcnt(0)" ::: "memory");
}
__device__ __forceinline__ void sincos_acc(float ang, float& c, float& s) {
    const double a = (double)ang;
    const double kd = __builtin_rint(a * 0.63661977236758134308);
    double r = __builtin_fma(-kd, 1.57079632679489655800, a);
    r = __builtin_fma(-kd, 6.12323399573676603587e-17, r);
    const int n = ((int)kd) & 3;
    const double r2 = r * r;
    double sp = -1.0 / 1307674368000.0;
    sp = sp * r2 + 1.0 / 6227020800.0; sp = sp * r2 - 1.0 / 39916800.0; sp = sp * r2 + 1.0 / 362880.0; sp = sp * r2 - 1.0 / 5040.0; sp = sp * r2 + 1.0 / 120.0; sp = sp * r2 - 1.0 / 6.0; sp = sp * r2 + 1.0;
    const double sn = r * sp;
    double cp = 1.0 / 20922789888000.0;
    cp = cp * r2 - 1.0 / 87178291200.0; cp = cp * r2 + 1.0 / 479001600.0; cp = cp * r2 - 1.0 / 3628800.0; cp = cp * r2 + 1.0 / 40320.0; cp = cp * r2 - 1.0 / 720.0; cp = cp * r2 + 1.0 / 24.0; cp = cp * r2 - 0.5; cp = cp * r2 + 1.0;
    const double cs = cp;
    double so, co;
    if (n == 0) { so = sn; co = cs; } else if (n == 1) { so = cs; co = -sn; } else if (n == 2) { so = -sn; co = -cs; } else { so = -cs; co = sn; }
    c = (float)co; s = (float)so;
}

__device__ __forceinline__ void p0_prologue(const Args& a, LAS unsigned char* lds, int wave, int lane) {
    unsigned char* ws = a.ws;
    const int G = gridDim.x, gw = blockIdx.x * NWAVES + wave, NGW = G * NWAVES;
    const int gt = blockIdx.x * NTHREADS + threadIdx.x, NGT = G * NTHREADS;
    float* ssq = (float*)(ws + WS_SSQ);
    for (int i = gt; i < 4 * M; i += NGT) ssq[M + i] = 0.f;
    for (int i = gt; i < 30 * 512 / 2; i += NGT) ((unsigned*)(ws + WS_ZERO))[i] = 0u;
    f32x2* rope = (f32x2*)(ws + WS_ROPE);
    for (int i = gt; i < NPOS * 64; i += NGT) {
        const int p = i >> 6, dd = i & 63;
        const float pos = p < SEQ ? (float)p : (float)(16384 + (p - SEQ));
        const float ang = pos * ROPE_INV[dd];
        float c, s; sincos_acc(ang, c, s);
        rope[i] = (f32x2){c, s};
    }
    LAS float* scr = (LAS float*)(lds + wave * 16384);
    constexpr int I_IN = (D / 64) * (NIN / 32), I_O = (D / 64) * (D / 32), I_UP = (D / 64) * (FF / 32), I_DN = (FF / 64) * (D / 32), I_L = I_IN + I_O + I_UP + I_DN;
    for (int it = gw; it < 2 * I_L; it += NGW) {
        const int l = it / I_L; int r = it % I_L;
        unsigned char* wl = ws + WS_W + (size_t)l * W_LAYER;
        if (r < I_IN) { p0_transpose_item(a.in[5] + (size_t)l * D * NIN, a.in[4] + l * D, D, NIN, (bf16*)(wl + W_IN), true, scr, r, lane); continue; } r -= I_IN;
        if (r < I_O) { p0_transpose_item(a.in[11] + (size_t)l * D * D, nullptr, D, D, (bf16*)(wl + W_OUT), false, scr, r, lane); continue; } r -= I_O;
        if (r < I_UP) { p0_transpose_item(a.in[13] + (size_t)l * D * FF, a.in[12] + l * D, D, FF, (bf16*)(wl + W_UP), false, scr, r, lane); continue; } r -= I_UP;
        p0_transpose_item(a.in[14] + (size_t)l * FF * D, nullptr, FF, D, (bf16*)(wl + W_DN), false, scr, r, lane);
    }
    bf16* XN = (bf16*)(ws + WS_XN);
    for (int m = gw; m < M; m += 2 * NGW) {
        const int m2 = m + NGW; const bool has2 = m2 < M; const int mb = has2 ? m2 : m;
        const float* xa = m < MP ? a.in[0] + (size_t)m * D : a.in[1] + (size_t)(m - MP) * D;
        const float* xb = mb < MP ? a.in[0] + (size_t)mb * D : a.in[1] + (size_t)(mb - MP) * D;
        f32x4 va[4], vb[4];
#pragma unroll
        for (int j = 0; j < 4; ++j) { va[j] = __builtin_nontemporal_load((const f32x4*)(xa + 4 * lane + 256 * j)); vb[j] = __builtin_nontemporal_load((const f32x4*)(xb + 4 * lane + 256 * j)); }
        float sa = 0.f, sb = 0.f;
#pragma unroll
        for (int j = 0; j < 4; ++j) {
            sa += (va[j][0] * va[j][0] + va[j][1] * va[j][1]) + (va[j][2] * va[j][2] + va[j][3] * va[j][3]);
            sb += (vb[j][0] * vb[j][0] + vb[j][1] * vb[j][1]) + (vb[j][2] * vb[j][2] + vb[j][3] * vb[j][3]);
            u32x2 w; w.x = pk_bf16(va[j][0], va[j][1]); w.y = pk_bf16(va[j][2], va[j][3]);
            *(u32x2*)(XN + (size_t)m * D + 4 * lane + 256 * j) = w;
            if (has2) { u32x2 w2; w2.x = pk_bf16(vb[j][0], vb[j][1]); w2.y = pk_bf16(vb[j][2], vb[j][3]); *(u32x2*)(XN + (size_t)mb * D + 4 * lane + 256 * j) = w2; }
        }
        sa = wave_sum(sa); sb = wave_sum(sb);
        if (lane == 0) { ssq[m] = sa; if (has2) ssq[mb] = sb; }
    }
}

template <int NT, bool SAMPLE>
__device__ __forceinline__ void conv_item(LAS unsigned char* lds, int b, int tt, const bf16* glu, const float* cache, const float* cw, const float* cb, const float* lng, const float* lnb,
                                          bf16* mix, float* out_conv, int wave, int lane) {
    const int c = ltid(); lane = c & 63; wave = __builtin_amdgcn_readfirstlane(c >> 6);
    constexpr int NI = NT + 30;
    float in[NI];
    const int t0 = tt * NT;
    if (SAMPLE) {
#pragma unroll
        for (int j = 0; j < 30; ++j) in[j] = __builtin_nontemporal_load(cache + ((size_t)b * 30 + j) * 512 + c);
#pragma unroll
        for (int j = 0; j < NT; ++j) in[30 + j] = bf2f(glu[((size_t)MP + 4 * b + j) * 512 + c]);
    } else {
#pragma unroll
        for (int j = 0; j < NI; ++j) { const int t = t0 - 30 + j; in[j] = t >= 0 ? bf2f(glu[((size_t)b * SEQ + t) * 512 + c]) : 0.f; }
    }
    float w[CW];
#pragma unroll
    for (int k = 0; k < CW; ++k) w[k] = cw[k * 512 + c];
    const float bias = cb[c];
    LAS float* co = (LAS float*)lds;
#pragma unroll
    for (int t = 0; t < NT; ++t) {
        float acc = bias;
#pragma unroll
        for (int k = 0; k < CW; ++k) acc += w[k] * in[t + k];
        co[t * 512 + c] = acc;
    }
    if (SAMPLE) {
#pragma unroll
        for (int jj = 0; jj < 30; ++jj) __builtin_nontemporal_store(in[jj + NT], out_conv + ((size_t)b * 30 + jj) * 512 + c);
    } else if (tt == SEQ / NT - 1) {
#pragma unroll
        for (int jj = 0; jj < 30; ++jj) __builtin_nontemporal_store(in[jj + NT], out_conv + ((size_t)b * 30 + jj) * 512 + c);
    }
    __syncthreads();
    for (int t = wave; t < NT; t += NWAVES) {
        const size_t row = SAMPLE ? (size_t)MP + 4 * b + t : (size_t)b * SEQ + t0 + t;
        f32x4 v0 = *(const LAS f32x4*)(co + t * 512 + lane * 8), v1 = *(const LAS f32x4*)(co + t * 512 + lane * 8 + 4);
        float s = (v0[0] + v0[1]) + (v0[2] + v0[3]) + (v1[0] + v1[1]) + (v1[2] + v1[3]);
        s = wave_sum(s);
        const float mean = s * (1.0f / 512.0f);
        v0 = v0 - mean; v1 = v1 - mean;
        float q = (v0[0] * v0[0] + v0[1] * v0[1]) + (v0[2] * v0[2] + v0[3] * v0[3]) + (v1[0] * v1[0] + v1[1] * v1[1]) + (v1[2] * v1[2] + v1[3] * v1[3]);
        q = wave_sum(q);
        const float rstd = rsqrtf(q * (1.0f / 512.0f) + EPS);
        const f32x4 g0 = *(const f32x4*)(lng + lane * 8), g1 = *(const f32x4*)(lng + lane * 8 + 4), b0 = *(const f32x4*)(lnb + lane * 8), b1 = *(const f32x4*)(lnb + lane * 8 + 4);
        f32x4 y0 = v0 * rstd * g0 + b0, y1 = v1 * rstd * g1 + b1;
#pragma unroll
        for (int e = 0; e < 4; ++e) { y0[e] = y0[e] * sigmoidf_(y0[e]); y1[e] = y1[e] * sigmoidf_(y1[e]); }
        u32x4 o; o.x = pk_bf16(y0[0], y0[1]); o.y = pk_bf16(y0[2], y0[3]); o.z = pk_bf16(y1[0], y1[1]); o.w = pk_bf16(y1[2], y1[3]);
        *(u32x4*)(mix + row * D + lane * 8) = o;
    }
    __syncthreads();
}

__device__ __forceinline__ void conv_pair(LAS unsigned char* lds, int pr, const bf16* glu, const bf16* zrows, const float* cw, const float* cb, const float* lng, const float* lnb, bf16* mix, float* out_conv) {
    const int tid = ltid(), lane = tid & 63, half = __builtin_amdgcn_readfirstlane(tid >> 8), wl = __builtin_amdgcn_readfirstlane((tid >> 6) & 3), t = tid & 255;
    const int itc = pr * 2 + half, b = itc >> 6, tt = itc & 63, t0 = tt * 32;
    constexpr int NT = 32, NI = NT + 30;
    const bf16* halo = tt > 0 ? glu + ((size_t)b * SEQ + t0 - 30) * 512 : zrows;
    f32x2 in2[NI];
#pragma unroll
    for (int j = 0; j < NI; ++j) {
        const unsigned w = j < 30 ? *(const unsigned*)(halo + (size_t)j * 512 + 2 * t) : *(const unsigned*)(glu + ((size_t)b * SEQ + t0 + (j - 30)) * 512 + 2 * t);
        in2[j] = (f32x2){bflo(w), bfhi(w)};
    }
    f32x2 w2[CW];
#pragma unroll
    for (int k = 0; k < CW; ++k) w2[k] = *(const f32x2*)(cw + k * 512 + 2 * t);
    const f32x2 bias2 = *(const f32x2*)(cb + 2 * t);
    LAS float* co = (LAS float*)(lds + half * 65536);
#pragma unroll
    for (int u = 0; u < NT; ++u) {
        f32x2 acc = bias2;
#pragma unroll
        for (int k = 0; k < CW; ++k) acc = w2[k] * in2[u + k] + acc;
        *(LAS f32x2*)(co + u * 512 + 2 * t) = acc;
    }
    if (tt == SEQ / NT - 1) {
#pragma unroll
        for (int jj = 0; jj < 30; ++jj) __builtin_nontemporal_store(in2[jj + NT], (f32x2*)(out_conv + ((size_t)b * 30 + jj) * 512 + 2 * t));
    }
    const f32x4 g0 = *(const f32x4*)(lng + lane * 8), g1 = *(const f32x4*)(lng + lane * 8 + 4), b0 = *(const f32x4*)(lnb + lane * 8), b1 = *(const f32x4*)(lnb + lane * 8 + 4);
    __syncthreads();
    for (int u = wl; u < NT; u += 4) {
        const size_t row = (size_t)b * SEQ + t0 + u;
        f32x4 v0 = *(const LAS f32x4*)(co + u * 512 + lane * 8), v1 = *(const LAS f32x4*)(co + u * 512 + lane * 8 + 4);
        float sm = (v0[0] + v0[1]) + (v0[2] + v0[3]) + (v1[0] + v1[1]) + (v1[2] + v1[3]);
        sm = wave_sum(sm);
        const float mean = sm * (1.0f / 512.0f);
        v0 = v0 - mean; v1 = v1 - mean;
        float qv = (v0[0] * v0[0] + v0[1] * v0[1]) + (v0[2] * v0[2] + v0[3] * v0[3]) + (v1[0] * v1[0] + v1[1] * v1[1]) + (v1[2] * v1[2] + v1[3] * v1[3]);
        qv = wave_sum(qv);
        const float rstd = rsqrtf(qv * (1.0f / 512.0f) + EPS);
        f32x4 y0 = v0 * rstd * g0 + b0, y1 = v1 * rstd * g1 + b1;
#pragma unroll
        for (int e = 0; e < 4; ++e) { y0[e] = y0[e] * sigmoidf_(y0[e]); y1[e] = y1[e] * sigmoidf_(y1[e]); }
        u32x4 o; o.x = pk_bf16(y0[0], y0[1]); o.y = pk_bf16(y0[2], y0[3]); o.z = pk_bf16(y1[0], y1[1]); o.w = pk_bf16(y1[2], y1[3]);
        *(u32x4*)(mix + row * D + lane * 8) = o;
    }
    __syncthreads();
}

constexpr int TS = 272;
__device__ __forceinline__ bf16x8 tr_frag(LAS unsigned char* tile, int rowA, int rowB, int col0, int lane) {
    const int i = lane & 15, qq = i >> 2, p = i & 3;
    const s16x4 lo = __builtin_amdgcn_ds_read_tr16_b64_v4i16((LAS s16x4*)(tile + (rowA + qq) * TS + (col0 + 4 * p) * 2));
    const s16x4 hi = __builtin_amdgcn_ds_read_tr16_b64_v4i16((LAS s16x4*)(tile + (rowB + qq) * TS + (col0 + 4 * p) * 2));
    bf16x8 r; r[0] = lo[0]; r[1] = lo[1]; r[2] = lo[2]; r[3] = lo[3]; r[4] = hi[0]; r[5] = hi[1]; r[6] = hi[2]; r[7] = hi[3];
    return r;
}
__device__ __forceinline__ u32x4 scale_bf16x8(u32x4 v, float s) {
    u32x4 o; o.x = pk_bf16(bflo(v.x) * s, bfhi(v.x) * s); o.y = pk_bf16(bflo(v.y) * s, bfhi(v.y) * s); o.z = pk_bf16(bflo(v.z) * s, bfhi(v.z) * s); o.w = pk_bf16(bflo(v.w) * s, bfhi(v.w) * s);
    return o;
}
__device__ __forceinline__ void kvloc_item(LAS unsigned char* lds, int b, int h, int c, const bf16* K, const bf16* V, float* kvbuf, float lg2, int wave, int lane) {
    LAS unsigned char* Kt = lds; LAS unsigned char* Vt = lds + 128 * TS;
    const int tid = ltid(); lane = tid & 63; wave = __builtin_amdgcn_readfirstlane(tid >> 6); const size_t r0 = (size_t)b * SEQ + c * 128;
#pragma unroll
    for (int i = 0; i < 4; ++i) {
        const int chunk = tid + 512 * i, j = chunk >> 4, cc = chunk & 15;
        u32x4 kv = *(const u32x4*)(K + (r0 + j) * 512 + h * 128 + cc * 8);
        const u32x4 vv = *(const u32x4*)(V + (r0 + j) * 512 + h * 128 + cc * 8);
        kv = scale_bf16x8(kv, exp2f(lg2 * (float)(127 - j)));
        *(LAS u32x4*)(Kt + j * TS + cc * 16) = kv; *(LAS u32x4*)(Vt + j * TS + cc * 16) = vv;
    }
    __syncthreads();
    const int r = lane & 15, q = lane >> 4;
    f32x4 acc[8];
#pragma unroll
    for (int vf = 0; vf < 8; ++vf) acc[vf] = (f32x4){0.f, 0.f, 0.f, 0.f};
#pragma unroll
    for (int ks = 0; ks < 4; ++ks) {
        const bf16x8 bfrag = tr_frag(Kt, 32 * ks + 8 * q, 32 * ks + 8 * q + 4, 16 * wave, lane);
#pragma unroll
        for (int vf = 0; vf < 8; ++vf) {
            const bf16x8 afrag = tr_frag(Vt, 32 * ks + 8 * q, 32 * ks + 8 * q + 4, 16 * vf, lane);
            acc[vf] = __builtin_amdgcn_mfma_f32_16x16x32_bf16(afrag, bfrag, acc[vf], 0, 0, 0);
        }
    }
    float* dst = kvbuf + ((size_t)((b * NH + h) * 16 + c)) * 16384 + (size_t)(16 * wave + r) * 128 + 4 * q;
#pragma unroll
    for (int vf = 0; vf < 8; ++vf) *(f32x4*)(dst + 16 * vf) = acc[vf];
    __syncthreads();
}

__device__ __forceinline__ void kvloc_pair(LAS unsigned char* lds, int pr, const bf16* K, const bf16* V, bf16* kvbuf) {
    const int tid = ltid(), lane = tid & 63, half = __builtin_amdgcn_readfirstlane(tid >> 8), wl = __builtin_amdgcn_readfirstlane((tid >> 6) & 3), t = tid & 255;
    const int k = pr * 2 + half, b = k >> 6, h = (k >> 4) & 3, c = k & 15;
    const float lg2 = __log2f(1.0f - exp2f(-5.0f - (float)h));
    LAS unsigned char* Kt = lds + half * (256 * TS); LAS unsigned char* Vt = Kt + 128 * TS;
    const size_t r0 = (size_t)b * SEQ + c * 128;
#pragma unroll
    for (int i = 0; i < 8; ++i) {
        const int chunk = t + 256 * i, j = chunk >> 4, cc = chunk & 15;
        u32x4 kv = *(const u32x4*)(K + (r0 + j) * 512 + h * 128 + cc * 8);
        const u32x4 vv = *(const u32x4*)(V + (r0 + j) * 512 + h * 128 + cc * 8);
        kv = scale_bf16x8(kv, exp2f(lg2 * (float)(127 - j)));
        *(LAS u32x4*)(Kt + j * TS + cc * 16) = kv; *(LAS u32x4*)(Vt + j * TS + cc * 16) = vv;
    }
    __syncthreads();
    const int r = lane & 15, q = lane >> 4;
    f32x4 acc[2][8];
#pragma unroll
    for (int u = 0; u < 2; ++u)
#pragma unroll
        for (int vf = 0; vf < 8; ++vf) acc[u][vf] = (f32x4){0.f, 0.f, 0.f, 0.f};
#pragma unroll
    for (int ks = 0; ks < 4; ++ks) {
        const bf16x8 b0 = tr_frag(Kt, 32 * ks + 8 * q, 32 * ks + 8 * q + 4, 32 * wl, lane);
        const bf16x8 b1 = tr_frag(Kt, 32 * ks + 8 * q, 32 * ks + 8 * q + 4, 32 * wl + 16, lane);
#pragma unroll
        for (int vf = 0; vf < 8; ++vf) {
            const bf16x8 afrag = tr_frag(Vt, 32 * ks + 8 * q, 32 * ks + 8 * q + 4, 16 * vf, lane);
            acc[0][vf] = __builtin_amdgcn_mfma_f32_16x16x32_bf16(afrag, b0, acc[0][vf], 0, 0, 0);
            acc[1][vf] = __builtin_amdgcn_mfma_f32_16x16x32_bf16(afrag, b1, acc[1][vf], 0, 0, 0);
        }
    }
    bf16* dst = kvbuf + ((size_t)((b * NH + h) * 16 + c)) * 16384 + (size_t)(32 * wl + r) * 128 + 4 * q;
#pragma unroll
    for (int u = 0; u < 2; ++u)
#pragma unroll
        for (int vf = 0; vf < 8; ++vf) { u32x2 w; w.x = pk_bf16(acc[u][vf][0], acc[u][vf][1]); w.y = pk_bf16(acc[u][vf][2], acc[u][vf][3]); *(u32x2*)(dst + (size_t)u * 16 * 128 + 16 * vf) = w; }
    __syncthreads();
}

__device__ __forceinline__ void retout_item(LAS unsigned char* lds, int b, int h, int c, const bf16* Q, const bf16* K, const bf16* V, const bf16* GATE, const bf16* sb, bf16* mix,
                                            float lg2, int wave, int lane) {
    LAS unsigned char* Kt = lds; LAS unsigned char* Vt = lds + 128 * TS; LAS unsigned char* St = lds + 256 * TS;
    const int tid = ltid(); lane = tid & 63; wave = __builtin_amdgcn_readfirstlane(tid >> 6); const size_t r0 = (size_t)b * SEQ + c * 128;
    {
        u32x4 kv[4], vv[4], sv[4];
        const bf16* sp = sb + ((size_t)((b * NH + h) * 16 + (c > 0 ? c : 1))) * 16384;
#pragma unroll
        for (int i = 0; i < 4; ++i) {
            const int chunk = tid + 512 * i, j = chunk >> 4, cc = chunk & 15;
            kv[i] = *(const u32x4*)(K + (r0 + j) * 512 + h * 128 + cc * 8);
            vv[i] = *(const u32x4*)(V + (r0 + j) * 512 + h * 128 + cc * 8);
            sv[i] = *(const u32x4*)(sp + j * 128 + cc * 8);
        }
#pragma unroll
        for (int i = 0; i < 4; ++i) {
            const int chunk = tid + 512 * i, j = chunk >> 4, cc = chunk & 15;
            *(LAS u32x4*)(Kt + j * TS + cc * 16) = kv[i]; *(LAS u32x4*)(Vt + j * TS + cc * 16) = vv[i]; *(LAS u32x4*)(St + j * TS + cc * 16) = sv[i];
        }
    }
    __syncthreads();
    const int r = lane & 15, q = lane >> 4;
    const size_t rowi = r0 + 16 * wave + r;
    bf16x8 qf[4];
#pragma unroll
    for (int ks = 0; ks < 4; ++ks) qf[ks] = *(const bf16x8*)(Q + rowi * 512 + h * 128 + 32 * ks + 8 * q);
    f32x4 sc[8];
#pragma unroll
    for (int jf = 0; jf < 8; ++jf) {
        sc[jf] = (f32x4){0.f, 0.f, 0.f, 0.f};
        if (jf <= wave) {
#pragma unroll
            for (int ks = 0; ks < 4; ++ks) {
                const bf16x8 kf = *(const LAS bf16x8*)(Kt + (16 * jf + r) * TS + (32 * ks + 8 * q) * 2);
                sc[jf] = __builtin_amdgcn_mfma_f32_16x16x32_bf16(kf, qf[ks], sc[jf], 0, 0, 0);
            }
#pragma unroll
            for (int e = 0; e < 4; ++e) { const int dlt = (16 * wave + r) - (16 * jf + 4 * q + e); sc[jf][e] = dlt >= 0 ? sc[jf][e] * exp2f(lg2 * (float)dlt) : 0.f; }
        }
    }
    f32x4 ao[8], ac[8];
#pragma unroll
    for (int vf = 0; vf < 8; ++vf) { ao[vf] = (f32x4){0.f, 0.f, 0.f, 0.f}; ac[vf] = (f32x4){0.f, 0.f, 0.f, 0.f}; }
#pragma unroll
    for (int k2 = 0; k2 < 4; ++k2) {
        if (2 * k2 <= wave) {
            union { u32x4 u; bf16x8 v; } pf;
            pf.u.x = pk_bf16(sc[2 * k2][0], sc[2 * k2][1]); pf.u.y = pk_bf16(sc[2 * k2][2], sc[2 * k2][3]); pf.u.z = pk_bf16(sc[2 * k2 + 1][0], sc[2 * k2 + 1][1]); pf.u.w = pk_bf16(sc[2 * k2 + 1][2], sc[2 * k2 + 1][3]);
#pragma unroll
            for (int vf = 0; vf < 8; ++vf) {
                const bf16x8 af = tr_frag(Vt, 32 * k2 + 4 * q, 32 * k2 + 16 + 4 * q, 16 * vf, lane);
                ao[vf] = __builtin_amdgcn_mfma_f32_16x16x32_bf16(af, pf.v, ao[vf], 0, 0, 0);
            }
        }
    }
    if (c > 0) {
#pragma unroll
        for (int ks = 0; ks < 4; ++ks) {
#pragma unroll
            for (int vf = 0; vf < 8; ++vf) {
                const bf16x8 af = tr_frag(St, 32 * ks + 8 * q, 32 * ks + 8 * q + 4, 16 * vf, lane);
                ac[vf] = __builtin_amdgcn_mfma_f32_16x16x32_bf16(af, qf[ks], ac[vf], 0, 0, 0);
            }
        }
    }
    const float gi = exp2f(lg2 * (float)(16 * wave + r + 1));
    float s = 0.f;
#pragma unroll
    for (int vf = 0; vf < 8; ++vf) { ao[vf] = ao[vf] + ac[vf] * gi; s += (ao[vf][0] + ao[vf][1]) + (ao[vf][2] + ao[vf][3]); }
    s += __shfl_xor(s, 16); s += __shfl_xor(s, 32);
    const float mean = s * (1.0f / 128.0f);
    float qv = 0.f;
#pragma unroll
    for (int vf = 0; vf < 8; ++vf) { ao[vf] = ao[vf] - mean; qv += (ao[vf][0] * ao[vf][0] + ao[vf][1] * ao[vf][1]) + (ao[vf][2] * ao[vf][2] + ao[vf][3] * ao[vf][3]); }
    qv += __shfl_xor(qv, 16); qv += __shfl_xor(qv, 32);
    const float rstd = rsqrtf(qv * (1.0f / 128.0f) + EPS);
#pragma unroll
    for (int vf = 0; vf < 8; ++vf) {
        const u32x2 gw = *(const u32x2*)(GATE + rowi * 512 + h * 128 + 16 * vf + 4 * q);
        u32x2 o; o.x = pk_bf16(ao[vf][0] * rstd * bflo(gw.x), ao[vf][1] * rstd * bfhi(gw.x)); o.y = pk_bf16(ao[vf][2] * rstd * bflo(gw.y), ao[vf][3] * rstd * bfhi(gw.y));
        *(u32x2*)(mix + rowi * D + 512 + h * 128 + 16 * vf + 4 * q) = o;
    }
    __syncthreads();
}

__device__ __forceinline__ void scan_phase(const bf16* kvbuf, bf16* sb, float* out_state) {
    const int tid = ltid();
    for (int idx = blockIdx.x * NTHREADS + tid; idx < 32 * 4096; idx += gridDim.x * NTHREADS) {
        const int bh = idx >> 12, e4 = idx & 4095, h = bh & 3;
        const float g128 = exp2f(128.0f * __log2f(1.0f - exp2f(-5.0f - (float)h)));
        const bf16* base = kvbuf + (size_t)bh * 16 * 16384 + e4 * 4;
        u32x2 kvr[16];
#pragma unroll
        for (int c = 0; c < 16; ++c) kvr[c] = *(const u32x2*)(base + (size_t)c * 16384);
        f32x4 s = (f32x4){0.f, 0.f, 0.f, 0.f};
#pragma unroll
        for (int c = 0; c < 16; ++c) {
            if (c > 0) { u32x2 w; w.x = pk_bf16(s[0], s[1]); w.y = pk_bf16(s[2], s[3]); *(u32x2*)(sb + ((size_t)(bh * 16 + c)) * 16384 + e4 * 4) = w; }
            s = s * g128 + (f32x4){bflo(kvr[c].x), bfhi(kvr[c].x), bflo(kvr[c].y), bfhi(kvr[c].y)};
        }
        __builtin_nontemporal_store(s, (f32x4*)(out_state + (size_t)bh * 16384 + e4 * 4));
    }
}

__device__ __forceinline__ void ret_sample_item(LAS unsigned char* lds, int b, int h, const bf16* Q, const bf16* K, const bf16* V, const bf16* GATE, const float* state_in, float* out_state,
                                                bf16* mix, float lg2, int wave, int lane) {
    LAS float* qs = (LAS float*)lds; LAS float* ks = qs + 512; LAS float* vs = ks + 512; LAS float* scs = vs + 512;
    LAS float* red = (LAS float*)(lds + 8192); LAS float* wsum = (LAS float*)(lds + 8192 + 32768);
    const int tid = ltid(); lane = tid & 63; wave = __builtin_amdgcn_readfirstlane(tid >> 6); const size_t row0 = (size_t)MP + 4 * b;
    { const int i = tid >> 7, d = tid & 127; const size_t o = (row0 + i) * 512 + h * 128 + d; qs[tid] = bf2f(Q[o]); ks[tid] = bf2f(K[o]); vs[tid] = bf2f(V[o]); }
    __syncthreads();
    { const int i = wave >> 1;
#pragma unroll
      for (int jj = 0; jj < 2; ++jj) { const int j = (wave & 1) * 2 + jj; float p = qs[i * 128 + lane] * ks[j * 128 + lane] + qs[i * 128 + 64 + lane] * ks[j * 128 + 64 + lane]; p = wave_sum(p);
          if (lane == 0) scs[i * 4 + j] = (j <= i) ? p * exp2f(lg2 * (float)(i - j)) : 0.f; } }
    const int v4 = (tid & 31) * 4, dg = tid >> 5;
    const float g4 = exp2f(lg2 * 4.0f), gk0 = exp2f(lg2 * 3.0f), gk1 = exp2f(lg2 * 2.0f), gk2 = exp2f(lg2), gk3 = 1.0f;
    const float* sin_ = state_in + ((size_t)(b * NH + h) * 128) * 128; float* sout = out_state + ((size_t)(b * NH + h) * 128) * 128;
    const f32x4 vv0 = *(const LAS f32x4*)(vs + v4), vv1 = *(const LAS f32x4*)(vs + 128 + v4), vv2 = *(const LAS f32x4*)(vs + 256 + v4), vv3 = *(const LAS f32x4*)(vs + 384 + v4);
    f32x4 p0 = (f32x4){0.f, 0.f, 0.f, 0.f}, p1 = p0, p2 = p0, p3 = p0;
#pragma unroll
    for (int dd = 0; dd < 8; ++dd) {
        const int d = dg * 8 + dd;
        const f32x4 s4 = *(const f32x4*)(sin_ + (size_t)d * 128 + v4);
        p0 += s4 * qs[d]; p1 += s4 * qs[128 + d]; p2 += s4 * qs[256 + d]; p3 += s4 * qs[384 + d];
        f32x4 ns = s4 * g4 + vv0 * (gk0 * ks[d]) + vv1 * (gk1 * ks[128 + d]) + vv2 * (gk2 * ks[256 + d]) + vv3 * (gk3 * ks[384 + d]);
        *(f32x4*)(sout + (size_t)d * 128 + v4) = ns;
    }
    *(LAS f32x4*)(red + (dg * 4 + 0) * 128 + v4) = p0; *(LAS f32x4*)(red + (dg * 4 + 1) * 128 + v4) = p1; *(LAS f32x4*)(red + (dg * 4 + 2) * 128 + v4) = p2; *(LAS f32x4*)(red + (dg * 4 + 3) * 128 + v4) = p3;
    __syncthreads();
    const int i = tid >> 7, v = tid & 127;
    float cross = 0.f;
#pragma unroll
    for (int g = 0; g < 16; ++g) cross += red[(g * 4 + i) * 128 + v];
    float o = exp2f(lg2 * (float)(i + 1)) * cross;
#pragma unroll
    for (int j = 0; j < 4; ++j) o += scs[i * 4 + j] * vs[j * 128 + v];
    float s = wave_sum(o);
    if (lane == 0) wsum[wave] = s;
    __syncthreads();
    const float mean = (wsum[2 * i] + wsum[2 * i + 1]) * (1.0f / 128.0f);
    const float dv = o - mean;
    float qv = wave_sum(dv * dv);
    if (lane == 0) wsum[8 + wave] = qv;
    __syncthreads();
    const float rstd = rsqrtf((wsum[8 + 2 * i] + wsum[8 + 2 * i + 1]) * (1.0f / 128.0f) + EPS);
    const float gt = bf2f(GATE[(row0 + i) * 512 + h * 128 + v]);
    const unsigned pk = pk_bf16(dv * rstd * gt, 0.f);
    mix[(row0 + i) * D + 512 + h * 128 + v] = (bf16)(pk & 0xffffu);
    __syncthreads();
}

__device__ __forceinline__ void ret_sample_pair(LAS unsigned char* lds, int pair, const bf16* Q, const bf16* K, const bf16* V, const bf16* GATE, const float* state_in, float* out_state, bf16* mix) {
    const int tid = ltid(), half = __builtin_amdgcn_readfirstlane(tid >> 8), t = tid & 255, lane = tid & 63, wl = __builtin_amdgcn_readfirstlane((tid >> 6) & 3);
    const int item = pair * 2 + half, b = item >> 2, h = item & 3;
    const float lg2 = __log2f(1.0f - exp2f(-5.0f - (float)h));
    LAS float* base = (LAS float*)(lds + half * 32768);
    LAS float* qs = base; LAS float* ks = base + 512; LAS float* vs = base + 1024; LAS float* red = base + 2048;
    const size_t row0 = (size_t)MP + 4 * b;
    unsigned short rq[2], rk[2], rv[2];
#pragma unroll
    for (int u = 0; u < 2; ++u) { const int e = t + 256 * u, i = e >> 7, d = e & 127; const size_t o = (row0 + i) * 512 + h * 128 + d; rq[u] = Q[o]; rk[u] = K[o]; rv[u] = V[o]; }
    asm volatile("" : "+v"(rq[0]), "+v"(rq[1]), "+v"(rk[0]), "+v"(rk[1]), "+v"(rv[0]), "+v"(rv[1]));
#pragma unroll
    for (int u = 0; u < 2; ++u) { const int e = t + 256 * u; qs[e] = bf2f(rq[u]); ks[e] = bf2f(rk[u]); vs[e] = bf2f(rv[u]); }
    const float gt0 = bf2f(GATE[(row0 + wl) * 512 + h * 128 + lane]), gt1 = bf2f(GATE[(row0 + wl) * 512 + h * 128 + 64 + lane]);
    __syncthreads();
    {
        const int v4 = (t & 31) * 4, dg = t >> 5;
        const float g4 = exp2f(lg2 * 4.0f), gk0 = exp2f(lg2 * 3.0f), gk1 = exp2f(lg2 * 2.0f), gk2 = exp2f(lg2);
        const float* sin_ = state_in + ((size_t)(b * NH + h) * 128) * 128; float* sout = out_state + ((size_t)(b * NH + h) * 128) * 128;
        const f32x4 vv0 = *(const LAS f32x4*)(vs + v4), vv1 = *(const LAS f32x4*)(vs + 128 + v4), vv2 = *(const LAS f32x4*)(vs + 256 + v4), vv3 = *(const LAS f32x4*)(vs + 384 + v4);
        f32x4 p0 = (f32x4){0.f, 0.f, 0.f, 0.f}, p1 = p0, p2 = p0, p3 = p0;
        f32x4 s4[16];
#pragma unroll
        for (int dd = 0; dd < 16; ++dd) s4[dd] = __builtin_nontemporal_load((const f32x4*)(sin_ + (size_t)(dg * 16 + dd) * 128 + v4));
#pragma unroll
        for (int dd = 0; dd < 16; ++dd) {
            const int d = dg * 16 + dd;
            p0 += s4[dd] * qs[d]; p1 += s4[dd] * qs[128 + d]; p2 += s4[dd] * qs[256 + d]; p3 += s4[dd] * qs[384 + d];
            const f32x4 ns = s4[dd] * g4 + vv0 * (gk0 * ks[d]) + vv1 * (gk1 * ks[128 + d]) + vv2 * (gk2 * ks[256 + d]) + vv3 * ks[384 + d];
            __builtin_nontemporal_store(ns, (f32x4*)(sout + (size_t)d * 128 + v4));
        }
        *(LAS f32x4*)(red + (dg * 4 + 0) * 128 + v4) = p0; *(LAS f32x4*)(red + (dg * 4 + 1) * 128 + v4) = p1; *(LAS f32x4*)(red + (dg * 4 + 2) * 128 + v4) = p2; *(LAS f32x4*)(red + (dg * 4 + 3) * 128 + v4) = p3;
    }
    __syncthreads();
    {
        const int i = wl;
        float o0 = 0.f, o1 = 0.f;
#pragma unroll
        for (int g = 0; g < 8; ++g) { o0 += red[(g * 4 + i) * 128 + lane]; o1 += red[(g * 4 + i) * 128 + 64 + lane]; }
        const float gi = exp2f(lg2 * (float)(i + 1));
        o0 *= gi; o1 *= gi;
#pragma unroll
        for (int j = 0; j < 4; ++j) {
            if (j <= i) {
                float p = qs[i * 128 + lane] * ks[j * 128 + lane] + qs[i * 128 + 64 + lane] * ks[j * 128 + 64 + lane];
                p = wave_sum(p) * exp2f(lg2 * (float)(i - j));
                o0 += p * vs[j * 128 + lane]; o1 += p * vs[j * 128 + 64 + lane];
            }
        }
        const float mean = wave_sum(o0 + o1) * (1.0f / 128.0f);
        const float d0 = o0 - mean, d1 = o1 - mean;
        const float rstd = rsqrtf(wave_sum(d0 * d0 + d1 * d1) * (1.0f / 128.0f) + EPS);
        const unsigned pk = pk_bf16(d0 * rstd * gt0, d1 * rstd * gt1);
        bf16* mo = mix + (row0 + i) * D + 512 + h * 128 + lane;
        mo[0] = (bf16)(pk & 0xffffu); mo[64] = (bf16)(pk >> 16);
    }
    __syncthreads();
}

#define XB_TMO      128
#define XB_XCNT(j)  (256  + 64 * (j))
#define XB_XSUB(j)  (1280 + 64 * (j))
#define XB_XGEN(j)  (2304 + 64 * (j))
#define XB_TOP      3328
#define XB_TOPGEN   3392
#define XCD_BAR_WORDS 3456
#define XB_SPIN_CAP (1u << 18)

__device__ __forceinline__ unsigned xb_ld(unsigned* p)              { return __hip_atomic_load(p, __ATOMIC_RELAXED, __HIP_MEMORY_SCOPE_AGENT); }
__device__ __forceinline__ unsigned xb_add(unsigned* p, unsigned v) { return __hip_atomic_fetch_add(p, v, __ATOMIC_RELAXED, __HIP_MEMORY_SCOPE_AGENT); }
__device__ __forceinline__ unsigned xb_xcc_id() { return (unsigned)__builtin_amdgcn_s_getreg((3 << 11) | 20) & 0xFu; }
#define XB_SPIN(cond, bar) do { unsigned _sp = 0; while (cond) { __builtin_amdgcn_s_sleep(1); \
    if ((++_sp & 255u) == 0u) { if (xb_ld(&(bar)[XB_TMO])) break; if (_sp > XB_SPIN_CAP) { atomicAdd(&(bar)[XB_TMO], 1u); break; } } } } while (0)

struct XcdBarrier {
    unsigned* bar; unsigned x;
    volatile LAS unsigned* st;
};

__device__ __forceinline__ XcdBarrier xcd_barrier_post(unsigned* bar, volatile LAS unsigned* st) {
    XcdBarrier b; b.bar = bar; b.x = xb_xcc_id(); b.st = st;
    if (threadIdx.x == 0) (void)xb_add(&bar[XB_XCNT(b.x)], 1u);
    return b;
}
__device__ __forceinline__ void xcd_barrier_complete(unsigned* bar, unsigned x, unsigned& nloc, unsigned& nx) {
    const unsigned G = gridDim.x * gridDim.y * gridDim.z;
    unsigned sum, cnt, mine, sp = 0u;
    for (;;) {
        sum = 0u; cnt = 0u; mine = 0u;
#pragma unroll
        for (unsigned j = 0; j < 16; ++j) { const unsigned c = xb_ld(&bar[XB_XCNT(j)]); sum += c; cnt += (c > 0u) ? 1u : 0u; mine = (j == x) ? c : mine; }
        if (sum == G) break;
        __builtin_amdgcn_s_sleep(1);
        if ((++sp & 255u) == 0u) { if (xb_ld(&bar[XB_TMO])) break; if (sp > XB_SPIN_CAP) { atomicAdd(&bar[XB_TMO], 1u); break; } }
    }
    nloc = mine > 0u ? mine : 1u; nx = cnt > 0u ? cnt : 1u;
}

__device__ __forceinline__ void xcd_barrier(const XcdBarrier& b) {
    asm volatile("s_waitcnt vmcnt(0)" ::: "memory");
    __syncthreads();
    if (threadIdx.x == 0) {
        unsigned* bar = b.bar;
        __builtin_amdgcn_s_waitcnt(0);
        unsigned nloc = b.st[0], nx = b.st[1];
        if (nloc == 0u) { xcd_barrier_complete(bar, b.x, nloc, nx); b.st[0] = nloc; b.st[1] = nx; }
        const unsigned old = xb_add(&bar[XB_XSUB(b.x)], 1u);
        const unsigned gen = old / nloc;
        if (old + 1u == (gen + 1u) * nloc) {
            __builtin_amdgcn_fence(__ATOMIC_RELEASE, "agent");
            asm volatile("s_waitcnt vmcnt(0)" ::: "memory");
            const unsigned og = xb_add(&bar[XB_TOP], 1u);
            const unsigned tg = og / nx;
            if (og + 1u == (tg + 1u) * nx) xb_add(&bar[XB_TOPGEN], 1u);
            else XB_SPIN(xb_ld(&bar[XB_TOPGEN]) == tg, bar);
            __builtin_amdgcn_fence(__ATOMIC_ACQUIRE, "agent");
            xb_add(&bar[XB_XGEN(b.x)], 1u);
            asm volatile("s_waitcnt vmcnt(0)" ::: "memory");
        } else {
            XB_SPIN(xb_ld(&bar[XB_XGEN(b.x)]) == gen, bar);
            __builtin_amdgcn_fence(__ATOMIC_ACQUIRE, "agent");
            asm volatile("s_waitcnt vmcnt(0)" ::: "memory");
        }
    }
    __syncthreads();
}

#define GRID_SYNC() do { XcdBarrier b_ = bar; unsigned* p_ = (unsigned*)(a.ws + WS_CTL) + 4096; asm volatile("" : "+s"(p_)); b_.bar = p_; unsigned x_ = bar.x; asm volatile("" : "+s"(x_)); b_.x = x_; xcd_barrier(b_); } while (0)

__global__ void __launch_bounds__(NTHREADS, 2) mega_fwd(Args a) {
    extern __shared__ __attribute__((aligned(16))) unsigned char lds_raw[];
    LAS unsigned char* lds = (LAS unsigned char*)lds_raw;
    cg::grid_group grid = cg::this_grid();
    const int tid = threadIdx.x, lane = tid & 63, wave = __builtin_amdgcn_readfirstlane(tid >> 6);
    const int G = gridDim.x, bid = blockIdx.x;
    unsigned char* ws = a.ws;
    float* ssq = (float*)(ws + WS_SSQ);
    const f32x2* rope = (const f32x2*)(ws + WS_ROPE);
    bf16* XN = (bf16*)(ws + WS_XN);
    bf16 *GLU = (bf16*)(ws + WS_GLU), *Qb = (bf16*)(ws + WS_Q), *Kb = (bf16*)(ws + WS_K), *Vb = (bf16*)(ws + WS_V), *GATE = (bf16*)(ws + WS_GATE), *MIX = (bf16*)(ws + WS_MIX), *Hb = (bf16*)(ws + WS_H);
    bf16* KVB = (bf16*)(ws + WS_KV);
    bf16* SB = (bf16*)(ws + WS_SB);
    float* XR = a.out + O_Y;
    volatile LAS unsigned* MISC = (volatile LAS unsigned*)(lds + LDS_BYTES - 256);
    if (tid < 64) MISC[tid] = 0u;
    __syncthreads();
    XcdBarrier bar = xcd_barrier_post((unsigned*)(ws + WS_CTL) + 4096, MISC + 8);

#ifndef SKIP_P0
    for (int rep = 0; rep < REP_P0; ++rep) p0_prologue(a, lds, wave, lane);
#endif
    if (a.ws == nullptr) grid.sync();
    GRID_SYNC();

    for (int l = 0; l < 2; ++l) {
        const unsigned char* wl = ws + WS_W + (size_t)l * W_LAYER;
        {
            pg8::Gemm g{XN, (const bf16*)(wl + W_IN), MP, NIN, D}; pg8::StaticOrder S; S.init(MP, NIN, G, bid);
            EpiIn E{ssq + (size_t)(2 * l) * M, GLU, Qb, Kb, Vb, GATE, rope, a.in[10] + l * 512};
#ifndef SKIP_IN
            for (int rep = 0; rep < REP_BIG; ++rep) pg8::gemm_phase<EpiIn, pg8::StaticOrder, true, true>(lds, g, S, E);
#endif
            for (int rep = 0; rep < REP_SMALL; ++rep) small_gemm<EpiIn, 2>(lds, XN, (const bf16*)(wl + W_IN), D, 48, E);
        }
        GRID_SYNC();
        {
            const float* cw = a.in[6] + (size_t)l * CW * 512; const float* cb = a.in[7] + l * 512; const float* lng = a.in[8] + l * 512; const float* lnb = a.in[9] + l * 512;
            const float* cache = a.in[2] + (size_t)l * 128 * 30 * 512;
            float* ocp = a.out + O_CP + (size_t)l * 8 * 30 * 512; float* ocs = a.out + O_CS + (size_t)l * 128 * 30 * 512;
            const float* st_in = a.in[3] + (size_t)l * 128 * NH * 16384; float* ors = a.out + O_RS + (size_t)l * 128 * NH * 16384;
            for (int rep = 0; rep < REP_P2; ++rep)
            for (int it = bid; it < 896; it += G) {
#ifndef SKIP_P2
                if (it < 256) { conv_pair(lds, it, GLU, (const bf16*)(ws + WS_ZERO), cw, cb, lng, lnb, MIX, ocp); }
                else if (it < 384) { conv_item<4, true>(lds, it - 256, 0, GLU, cache, cw, cb, lng, lnb, MIX, ocs, wave, lane); }
                else if (it < 640) { kvloc_pair(lds, it - 384, Kb, Vb, KVB); }
                else { ret_sample_pair(lds, it - 640, Qb, Kb, Vb, GATE, st_in, ors, MIX); }
#endif
            }
        }
        GRID_SYNC();
        scan_phase(KVB, SB, a.out + O_RP + (size_t)l * 8 * NH * 16384);
        GRID_SYNC();
        {
#ifndef SKIP_P3
            for (int rep = 0; rep < REP_P3; ++rep)
            for (int it = bid; it < 512; it += G) { const int h = (it >> 4) & 3; retout_item(lds, it >> 6, h, it & 15, Qb, Kb, Vb, GATE, SB, MIX, __log2f(1.0f - exp2f(-5.0f - (float)h)), wave, lane); }
#endif
        }
        GRID_SYNC();
        {
            pg8::Gemm g{MIX, (const bf16*)(wl + W_OUT), MP, D, D}; pg8::StaticOrder S; S.init(MP, D, G, bid);
            EpiRes E{XN, ssq + (size_t)(2 * l + 1) * M};
#ifndef SKIP_RES
            pg8::gemm_phase<EpiRes, pg8::StaticOrder, true, true>(lds, g, S, E);
#endif
            small_gemm<EpiRes, 1>(lds, MIX, (const bf16*)(wl + W_OUT), D, 16, E);
        }
        GRID_SYNC();
        {
            pg8::Gemm g{XN, (const bf16*)(wl + W_UP), MP, FF, D}; pg8::StaticOrder S; S.init(MP, FF, G, bid);
            EpiUp E{ssq + (size_t)(2 * l + 1) * M, Hb};
#ifndef SKIP_UP
            for (int rep = 0; rep < REP_BIG; ++rep) pg8::gemm_phase<EpiUp, pg8::StaticOrder, true, true>(lds, g, S, E);
#endif
            for (int rep = 0; rep < REP_SMALL; ++rep) small_gemm<EpiUp, 2>(lds, XN, (const bf16*)(wl + W_UP), D, 64, E);
        }
        GRID_SYNC();
        {
            pg8::Gemm g{Hb, (const bf16*)(wl + W_DN), MP, D, FF}; pg8::StaticOrder S; S.init(MP, D, G, bid);
            EpiRes E{XN, ssq + (size_t)(2 * l + 2) * M};
#ifndef SKIP_RES
            pg8::gemm_phase<EpiRes, pg8::StaticOrder, true, true>(lds, g, S, E);
#endif
            small_gemm<EpiRes, 1>(lds, Hb, (const bf16*)(wl + W_DN), FF, 16, E);
        }
        GRID_SYNC();
    }
    {
        const float* gf = a.in[15]; const float* sq = ssq + (size_t)4 * M;
        const int gw = bid * NWAVES + wave, NGW = G * NWAVES;
        for (int m0 = gw; m0 < M; m0 += 4 * NGW) {
            u32x4 v[4][2]; float rs[4];
#pragma unroll
            for (int u = 0; u < 4; ++u) {
                const int m = (m0 + u * NGW) < M ? (m0 + u * NGW) : m0;
                rs[u] = sq[m];
                v[u][0] = *(const u32x4*)(XN + (size_t)m * D + 8 * lane); v[u][1] = *(const u32x4*)(XN + (size_t)m * D + 8 * lane + 512);
            }
#pragma unroll
            for (int u = 0; u < 4; ++u) {
                const int m = m0 + u * NGW;
                if (m < M) {
                    const float rstd = rsqrtf(rs[u] * (1.0f / D) + EPS);
                    float* yrow = XR + (size_t)m * D;
#pragma unroll
                    for (int j = 0; j < 2; ++j) {
                        const u32x4 w = v[u][j];
                        const f32x4 g0 = *(const f32x4*)(gf + 8 * lane + 512 * j), g1 = *(const f32x4*)(gf + 8 * lane + 512 * j + 4);
                        f32x4 y0, y1;
                        y0[0] = bflo(w.x) * rstd * g0[0]; y0[1] = bfhi(w.x) * rstd * g0[1]; y0[2] = bflo(w.y) * rstd * g0[2]; y0[3] = bfhi(w.y) * rstd * g0[3];
                        y1[0] = bflo(w.z) * rstd * g1[0]; y1[1] = bfhi(w.z) * rstd * g1[1]; y1[2] = bflo(w.w) * rstd * g1[2]; y1[3] = bfhi(w.w) * rstd * g1[3];
                        __builtin_nontemporal_store(y0, (f32x4*)(yrow + 8 * lane + 512 * j)); __builtin_nontemporal_store(y1, (f32x4*)(yrow + 8 * lane + 512 * j + 4));
                    }
                }
            }
        }
    }
}

extern "C" void kernel_launch(void* const* d_in, const int* in_sizes, int n_in, void* d_out, int out_size, void* d_ws, size_t ws_size, hipStream_t stream) {
    static int grid = 0;
    if (grid == 0) {
        int dev = 0, cus = 0, per_cu = 0;
        (void)hipGetDevice(&dev);
        (void)hipDeviceGetAttribute(&cus, hipDeviceAttributeMultiprocessorCount, dev);
        (void)hipFuncSetAttribute((const void*)mega_fwd, hipFuncAttributeMaxDynamicSharedMemorySize, LDS_BYTES);
        (void)hipOccupancyMaxActiveBlocksPerMultiprocessor(&per_cu, (const void*)mega_fwd, NTHREADS, LDS_BYTES);
        if (per_cu < 1) per_cu = 1;
        if (per_cu > 1) per_cu = 1;
        grid = cus * per_cu;
        if (n_in != 16 || ws_size < WS_END) { fprintf(stderr, "kernel_launch: unexpected n_in %d / ws %zu\n", n_in, ws_size); }
    }
    (void)hipMemsetAsync((char*)d_ws + WS_CTL, 0, CTL_BYTES, stream);
    Args a{};
    for (int i = 0; i < 16; ++i) a.in[i] = (const float*)d_in[i];
    a.out = (float*)d_out; a.ws = (unsigned char*)d_ws;
    void* args[] = {&a};
    hipError_t e = hipLaunchCooperativeKernel((const void*)mega_fwd, dim3(grid), dim3(NTHREADS), args, LDS_BYTES, stream);
    if (e != hipSuccess) fprintf(stderr, "cooperative launch failed: %s (grid %d)\n", hipGetErrorString(e), grid);
}
```

```cpp
#include <hip/hip_runtime.h>
#include <hip/hip_cooperative_groups.h>
#include <cstdio>
#include <cstdint>
namespace cg = cooperative_groups;
namespace pg8 {
#define PG8_LAS __attribute__((address_space(3)))
typedef unsigned short bf16_t;
typedef short bf16x8 __attribute__((ext_vector_type(8)));
typedef float f32x4 __attribute__((ext_vector_type(4)));
typedef unsigned u32x4 __attribute__((ext_vector_type(4)));
constexpr int BM = 256, BK = 64, HALF = 128, HTB = HALF * BK * 2  , STAGE_BYTES = 8 * HTB, NXCD = 8, WGM = 8;

__host__ __device__ __forceinline__ int lds_byte(int r, int c) { const int st = (r >> 4) * 2 + (c >> 5), rr = r & 15, cc = c & 31, ob = rr * 64 + cc * 2; return st * 1024 + (ob ^ (((ob >> 9) & 1) << 5)); }
__host__ __device__ __forceinline__ void stage_rc(int b, int& R, int& C) { const int st = b / 1024, sb = b % 1024, swz = sb ^ (((sb >> 9) & 1) << 5); R = (st >> 1) * 16 + swz / 64; C = (st & 1) * 32 + (swz % 64) / 2; }
__host__ __device__ __forceinline__ int perm32(int rho) { const int n = rho >> 4, i = rho & 15; return 8 * (i >> 2) + 4 * n + (i & 3); }

struct Unit { int pm, pn; };
struct Gemm { const bf16_t* A; const bf16_t* Bt; int M, N, K; };

struct StaticOrder {
    int nM, nN, nwg, G, c;
    __host__ __device__ void init(int M, int N, int G_, int c_) { nM = M / BM; nN = N / BM; nwg = nM * nN; G = G_; c = c_; }
    __host__ __device__ bool next(int i, Unit& u) const {
        const long L = (long)i * G + c; if (L >= nwg) return false;
        int wgid = (int)L; { const int q = nwg / NXCD, r = nwg % NXCD, xcd = wgid % NXCD, off = wgid / NXCD; wgid = (xcd < r ? xcd * (q + 1) : r * (q + 1) + (xcd - r) * q) + off; }
        const int nig = WGM * nN, gid = wgid / nig, fm = gid * WGM, gsz = (nM - fm) < WGM ? (nM - fm) : WGM;
        u.pm = fm + ((wgid % nig) % gsz); u.pn = (wgid % nig) / gsz; return true;
    }
    __device__ __forceinline__ void a_ready(const Unit&) const {}
    __device__ __forceinline__ void done(const Unit&) const {}
};
__device__ __forceinline__ unsigned cvt_pk_bf16(float lo, float hi) { unsigned r; asm volatile("v_cvt_pk_bf16_f32 %0, %1, %2" : "=v"(r) : "v"(lo), "v"(hi)); return r; }
typedef float f32x2 __attribute__((ext_vector_type(2)));
template <class Epi, class Sched, bool ALIGN_EPI = false, bool SP2 = false>
__device__ __forceinline__ void gemm_phase(PG8_LAS unsigned char* lds, const Gemm g, const Sched& S, const Epi& E) {
    int tid_ = threadIdx.x; asm volatile("" : "+v"(tid_)); const int tid = tid_, wid = __builtin_amdgcn_readfirstlane(tid >> 6), lane = tid & 63, wr = wid >> 2, wc = wid & 3, fr = lane & 15, fq = lane >> 4;
    const int K = g.K, nt = K / BK;
    unsigned voffA[2], voffB[2];
#pragma unroll
    for (int i = 0; i < 2; ++i) { int R, C; stage_rc(tid * 16 + i * 8192, R, C); const int Rb = Epi::PERM ? ((R & ~31) + perm32(R & 31)) : R;
        voffA[i] = (unsigned)(R * K + C) * 2u; voffB[i] = (unsigned)(Rb * K + C) * 2u; }
    const size_t kstep = (size_t)(BK * 2);
    const size_t hstep = (size_t)HALF * K * 2;
    const size_t tstep = 2 * hstep;
    const unsigned ldsw = (unsigned)wid * 1024u;
    const int aoff = lds_byte(wr * 64 + fr, fq * 8), boff = lds_byte(wc * 32 + fr, fq * 8);
#define PG8_SA(b, h) (((b) * 2 + (h)) * HTB)
#define PG8_SB(b, h) ((4 + (b) * 2 + (h)) * HTB)
#define PG8_STAGE(bufoff, gbase, voff) do { _Pragma("unroll") for (int _i = 0; _i < 2; ++_i) \
        __builtin_amdgcn_global_load_lds((const unsigned*)((const char*)(gbase) + (voff)[_i]), (PG8_LAS unsigned*)(lds + (bufoff) + ldsw + _i * 8192), 16, 0, 0); } while (0)
#define PG8_LDA(dst, b, h) do { _Pragma("unroll") for (int m = 0; m < 4; ++m) _Pragma("unroll") for (int k = 0; k < 2; ++k) dst[m][k] = *(const PG8_LAS bf16x8*)(lds + PG8_SA(b, h) + aoff + m * 2048 + k * 1024); } while (0)
#define PG8_LDB(dst, b, h) do { _Pragma("unroll") for (int n = 0; n < 2; ++n) _Pragma("unroll") for (int k = 0; k < 2; ++k) dst[n][k] = *(const PG8_LAS bf16x8*)(lds + PG8_SB(b, h) + boff + n * 2048 + k * 1024); } while (0)
#define PG8_MMA(ai, bj, At, Bt) do { __builtin_amdgcn_s_setprio(1); _Pragma("unroll") for (int m = 0; m < 4; ++m) _Pragma("unroll") for (int n = 0; n < 2; ++n) _Pragma("unroll") for (int k = 0; k < 2; ++k) \
        acc[ai][bj][m][n] = __builtin_amdgcn_mfma_f32_16x16x32_bf16(Bt[n][k], At[m][k], acc[ai][bj][m][n], 0, 0, 0); __builtin_amdgcn_s_setprio(0); } while (0)
#define PG8_WAIT_V(n) asm volatile("s_waitcnt vmcnt(" #n ")" ::: "memory")
#define PG8_WAIT_L(n) asm volatile("s_waitcnt lgkmcnt(" #n ")" ::: "memory")
#define PG8_BAR __builtin_amdgcn_s_barrier()
#define PG8_SCHED __builtin_amdgcn_sched_barrier(0)
    Unit cur, nxt; int ui = 0;
    if (!S.next(0, cur)) return;
    f32x4 acc[2][2][4][2];
#pragma unroll
    for (int a = 0; a < 2; ++a)
#pragma unroll
        for (int b = 0; b < 2; ++b)
#pragma unroll
            for (int m = 0; m < 4; ++m)
#pragma unroll
                for (int n = 0; n < 2; ++n) acc[a][b][m][n] = (f32x4){0.f, 0.f, 0.f, 0.f};
    bf16x8 At[4][2], B0[2][2], B1[2][2];
    const char* cA = (const char*)g.A + (size_t)cur.pm * tstep; const char* cB = (const char*)g.Bt + (size_t)cur.pn * tstep;
    S.a_ready(cur);
    if constexpr (SP2) {
        PG8_STAGE(PG8_SB(0, 0), cB, voffB); PG8_STAGE(PG8_SB(0, 1), cB + hstep, voffB); PG8_STAGE(PG8_SA(0, 0), cA, voffA); PG8_STAGE(PG8_SA(0, 1), cA + hstep, voffA);
        if (wr == 1) PG8_BAR;
        PG8_WAIT_V(2); PG8_BAR;
        PG8_STAGE(PG8_SB(1, 0), cB + kstep, voffB); PG8_STAGE(PG8_SA(1, 0), cA + kstep, voffA); PG8_STAGE(PG8_SB(1, 1), cB + hstep + kstep, voffB);
        PG8_WAIT_V(6); PG8_BAR;
    } else {
        PG8_STAGE(PG8_SB(0, 0), cB, voffB); PG8_STAGE(PG8_SA(0, 0), cA, voffA); PG8_STAGE(PG8_SB(0, 1), cB + hstep, voffB); PG8_STAGE(PG8_SA(0, 1), cA + hstep, voffA);
        if (wr == 1) PG8_BAR;
        PG8_WAIT_V(4); PG8_BAR;
        PG8_STAGE(PG8_SB(1, 0), cB + kstep, voffB); PG8_STAGE(PG8_SA(1, 0), cA + kstep, voffA); PG8_STAGE(PG8_SB(1, 1), cB + hstep + kstep, voffB);
        PG8_WAIT_V(6); PG8_BAR;
    }
    for (;;) {
        const bool has_next = S.next(ui + 1, nxt);
        const char* nA = has_next ? (const char*)g.A + (size_t)nxt.pm * tstep : cA; const char* nB = has_next ? (const char*)g.Bt + (size_t)nxt.pn * tstep : cB;
        for (int t = 0; t < nt; t += 2) {
            const bool last = (t == nt - 2);
            const char* a1 = cA + (size_t)(t + 1) * kstep;
            const char* a2 = last ? nA : cA + (size_t)(t + 2) * kstep; const char* b2 = last ? nB : cB + (size_t)(t + 2) * kstep;
            const char* a3 = a2 + kstep; const char* b3 = b2 + kstep;
            if (last && has_next) S.a_ready(nxt);
            if constexpr (SP2) {
            PG8_LDB(B0, 0, 0); PG8_LDB(B1, 0, 1); PG8_SCHED; PG8_LDA(At, 0, 0); PG8_STAGE(PG8_SA(1, 1), a1 + hstep, voffA);
            PG8_WAIT_V(8); PG8_WAIT_L(0); PG8_BAR; PG8_MMA(0, 0, At, B0); PG8_MMA(0, 1, At, B1); PG8_BAR; PG8_SCHED;
            PG8_LDA(At, 0, 1); PG8_STAGE(PG8_SB(0, 0), b2, voffB); PG8_STAGE(PG8_SB(0, 1), b2 + hstep, voffB); PG8_STAGE(PG8_SA(0, 0), a2, voffA);
            PG8_WAIT_V(8); PG8_WAIT_L(0); PG8_BAR; PG8_MMA(1, 0, At, B0); PG8_MMA(1, 1, At, B1); PG8_BAR; PG8_SCHED;
            PG8_LDB(B0, 1, 0); PG8_LDB(B1, 1, 1); PG8_SCHED; PG8_LDA(At, 1, 0); PG8_STAGE(PG8_SA(0, 1), a2 + hstep, voffA);
            PG8_WAIT_V(8); PG8_WAIT_L(0); PG8_BAR; PG8_MMA(0, 0, At, B0); PG8_MMA(0, 1, At, B1); PG8_BAR; PG8_SCHED;
            PG8_LDA(At, 1, 1); PG8_STAGE(PG8_SB(1, 0), b3, voffB); PG8_STAGE(PG8_SB(1, 1), b3 + hstep, voffB); PG8_STAGE(PG8_SA(1, 0), a3, voffA);
            PG8_WAIT_V(8); PG8_WAIT_L(0); PG8_BAR; PG8_MMA(1, 0, At, B0); PG8_MMA(1, 1, At, B1); PG8_BAR; PG8_SCHED;
            } else {
            PG8_LDB(B0, 0, 0); PG8_SCHED; PG8_LDA(At, 0, 0); PG8_STAGE(PG8_SA(1, 1), a1 + hstep, voffA);
            PG8_WAIT_L(8); PG8_BAR; PG8_WAIT_L(0); PG8_MMA(0, 0, At, B0); PG8_BAR; PG8_SCHED;
            PG8_LDB(B1, 0, 1); PG8_STAGE(PG8_SB(0, 0), b2, voffB);
            PG8_BAR; PG8_WAIT_L(0); PG8_MMA(0, 1, At, B1); PG8_BAR;
            PG8_LDA(At, 0, 1); PG8_STAGE(PG8_SA(0, 0), a2, voffA);
            PG8_BAR; PG8_WAIT_L(0); PG8_MMA(1, 0, At, B0); PG8_BAR; PG8_SCHED;
            PG8_STAGE(PG8_SB(0, 1), b2 + hstep, voffB);
            PG8_WAIT_V(6); PG8_BAR; PG8_MMA(1, 1, At, B1); PG8_BAR;
            PG8_LDB(B0, 1, 0); PG8_SCHED; PG8_LDA(At, 1, 0); PG8_STAGE(PG8_SA(0, 1), a2 + hstep, voffA);
            PG8_WAIT_L(8); PG8_BAR; PG8_WAIT_L(0); PG8_MMA(0, 0, At, B0); PG8_BAR; PG8_SCHED;
            PG8_LDB(B1, 1, 1); PG8_STAGE(PG8_SB(1, 0), b3, voffB);
            PG8_BAR; PG8_WAIT_L(0); PG8_MMA(0, 1, At, B1); PG8_BAR;
            PG8_LDA(At, 1, 1); PG8_STAGE(PG8_SA(1, 0), a3, voffA);
            PG8_BAR; PG8_WAIT_L(0); PG8_MMA(1, 0, At, B0); PG8_BAR; PG8_SCHED;
            PG8_STAGE(PG8_SB(1, 1), b3 + hstep, voffB);
            PG8_WAIT_V(6); PG8_BAR; PG8_MMA(1, 1, At, B1); PG8_BAR;
            }
        }
        if constexpr (ALIGN_EPI) { if (wr == 0) PG8_BAR; }
        if constexpr (!Epi::AFTER_DRAIN) { E(acc, cur, wr, wc, fr, fq); S.done(cur); }
        if (!has_next) break;
#pragma unroll
        for (int a = 0; a < 2; ++a)
#pragma unroll
            for (int b = 0; b < 2; ++b)
#pragma unroll
                for (int m = 0; m < 4; ++m)
#pragma unroll
                    for (int n = 0; n < 2; ++n) acc[a][b][m][n] = (f32x4){0.f, 0.f, 0.f, 0.f};
        cur = nxt; cA = nA; cB = nB; ++ui;
        if constexpr (ALIGN_EPI) { if (wr == 1) PG8_BAR; }
    }
    PG8_WAIT_V(0);
    if constexpr (!ALIGN_EPI) { if (wr == 0) PG8_BAR; }
    PG8_BAR;
    if constexpr (Epi::AFTER_DRAIN) { E.fused(acc, cur, wr, wc, fr, fq, lds, wid, lane); S.done(cur); }
#undef PG8_SA
#undef PG8_SB
#undef PG8_STAGE
#undef PG8_LDA
#undef PG8_LDB
#undef PG8_MMA
#undef PG8_WAIT_V
#undef PG8_WAIT_L
#undef PG8_BAR
#undef PG8_SCHED
}
}

#ifndef REP_P0
#define REP_P0 1
#endif
#ifndef REP_BIG
#define REP_BIG 1
#endif
#ifndef REP_SMALL
#define REP_SMALL 1
#endif
#ifndef REP_P2
#define REP_P2 1
#endif
#ifndef REP_P3
#define REP_P3 1
#endif
#define LAS __attribute__((address_space(3)))
typedef unsigned short bf16;
typedef float f32x4 __attribute__((ext_vector_type(4)));
typedef float f32x2 __attribute__((ext_vector_type(2)));
typedef unsigned u32x4 __attribute__((ext_vector_type(4)));
typedef unsigned u32x2 __attribute__((ext_vector_type(2)));
typedef short bf16x8 __attribute__((ext_vector_type(8)));
typedef short s16x4 __attribute__((ext_vector_type(4)));

constexpr int D = 1024, MP = 16384, MS = 512, M = MP + MS, SEQ = 2048, NIN = 3072, FF = 4096, CD = 512, NH = 4, HD = 128, CW = 31, NPOS = 2052;
constexpr float EPS = 1e-6f;
constexpr int NWAVES = 8, NTHREADS = 512;
constexpr int LDS_BYTES = 147456;
constexpr size_t MiB = 1u << 20;
constexpr size_t WS_CTL = 0, CTL_BYTES = 65536;
constexpr size_t WS_ROPE = 1 * MiB;
constexpr size_t WS_SSQ = 3 * MiB;
constexpr size_t WS_W = 4 * MiB, W_LAYER = 24 * MiB;
constexpr size_t W_IN = 0, W_OUT = 6 * MiB, W_UP = 8 * MiB, W_DN = 16 * MiB;
constexpr size_t WS_XN = 52 * MiB;
constexpr size_t WS_R1 = 85 * MiB;
constexpr size_t WS_H = WS_R1;
constexpr size_t ACT512 = (size_t)M * 512 * 2;
constexpr size_t WS_GLU = WS_R1, WS_Q = WS_GLU + ACT512, WS_K = WS_Q + ACT512, WS_V = WS_K + ACT512, WS_GATE = WS_V + ACT512;
constexpr size_t WS_MIX = WS_GATE + ACT512;
constexpr size_t WS_KV = WS_MIX + (size_t)M * 1024 * 2;
constexpr size_t WS_SB = WS_KV + 32 * MiB;
constexpr size_t WS_END = WS_SB + 16 * MiB;
static_assert(WS_END <= 256 * MiB, "ws map");
static_assert(WS_H + (size_t)M * FF * 2 <= WS_END, "ws map H");
constexpr size_t O_Y = 0, O_CP = (size_t)M * D, O_RP = O_CP + 2 * 8 * 30 * 512, O_CS = O_RP + 2 * 8 * 4 * 128 * 128, O_RS = O_CS + 2 * 128 * 30 * 512;

__device__ const float ROPE_INV[64] = {
1.0f, 0.865964353f, 0.749894202f, 0.649381638f, 0.562341332f, 0.486967534f, 0.421696514f, 0.365174115f, 0.316227764f, 0.273841977f, 0.237137377f, 0.2053525f, 0.177827939f, 0.153992653f, 0.133352146f, 0.115478195f, 0.100000001f, 0.0865964293f, 0.0749894232f, 0.0649381652f, 0.0562341325f, 0.0486967526f, 0.0421696492f, 0.0365174115f, 0.0316227749f, 0.0273841955f, 0.0237137377f, 0.0205352511f, 0.0177827943f, 0.0153992651f, 0.013335214f, 0.0115478197f, 0.00999999978f, 0.00865964312f, 0.00749894232f, 0.00649381615f, 0.00562341325f, 0.00486967526f, 0.00421696482f, 0.00365174119f, 0.00316227763f, 0.00273841969f, 0.00237137382f, 0.00205352507f, 0.00177827943f, 0.00153992651f, 0.00133352145f, 0.00115478202f, 0.00100000005f, 0.000865964335f, 0.000749894185f, 0.000649381604f, 0.000562341302f, 0.000486967532f, 0.000421696517f, 0.000365174114f, 0.000316227757f, 0.000273841957f, 0.00023713737f, 0.00020535251f, 0.00017782794f, 0.00015399266f, 0.00013335215f, 0.0001154782f
};

struct Args { const float* in[16]; float* out; unsigned char* ws; };

__device__ __forceinline__ float bf2f(unsigned short x) { return __uint_as_float(((unsigned)x) << 16); }
__device__ __forceinline__ float bflo(unsigned w) { return __uint_as_float(w << 16); }
__device__ __forceinline__ float bfhi(unsigned w) { return __uint_as_float(w & 0xffff0000u); }
typedef __bf16 bf16x2_t __attribute__((ext_vector_type(2)));
__device__ __forceinline__ unsigned pk_bf16(float lo, float hi) { const f32x2 v = {lo, hi}; return __builtin_bit_cast(unsigned, __builtin_convertvector(v, bf16x2_t)); }
__device__ __forceinline__ float wave_sum(float v) {
#pragma unroll
    for (int o = 1; o < 64; o <<= 1) v += __shfl_xor(v, o);
    return v;
}
__device__ __forceinline__ int ltid() { int t = threadIdx.x; asm volatile("" : "+v"(t)); return t; }
__device__ __forceinline__ float fast_rcp(float x) { return __builtin_amdgcn_rcpf(x); }
__device__ __forceinline__ float sigmoidf_(float x) { return fast_rcp(1.0f + __expf(-x)); }

struct EpiIn {
    static constexpr bool PERM = true, AFTER_DRAIN = false;
    const float* ssq; bf16 *glu, *q, *k, *v, *gate; const f32x2* rope; const float* gn_g;
    __device__ __forceinline__ void operator()(const f32x4 (&acc)[2][2][4][2], const pg8::Unit& u, int wr, int wc, int fr, int fq) const {
        const int pn = u.pn, cl = wc * 32 + fq * 8;
#pragma unroll
        for (int ai = 0; ai < 2; ++ai)
#pragma unroll
            for (int m = 0; m < 4; ++m) {
                const int row = u.pm * 256 + ai * 128 + wr * 64 + m * 16 + fr;
                const float rstd = rsqrtf(ssq[row] * (1.0f / D) + EPS);
                const f32x4 a0 = acc[ai][0][m][0] * rstd, a1 = acc[ai][0][m][1] * rstd, b0 = acc[ai][1][m][0] * rstd, b1 = acc[ai][1][m][1] * rstd;
                if (pn < 4) {
                    u32x4 w;
                    w.x = pk_bf16(a0[0] * sigmoidf_(b0[0]), a0[1] * sigmoidf_(b0[1])); w.y = pk_bf16(a0[2] * sigmoidf_(b0[2]), a0[3] * sigmoidf_(b0[3]));
                    w.z = pk_bf16(a1[0] * sigmoidf_(b1[0]), a1[1] * sigmoidf_(b1[1])); w.w = pk_bf16(a1[2] * sigmoidf_(b1[2]), a1[3] * sigmoidf_(b1[3]));
                    *(u32x4*)(glu + (size_t)row * 512 + pn * 128 + cl) = w;
                } else if (pn < 8) {
                    const int which = (pn - 4) >> 1, tp = pn & 1, head = 2 * tp + (wc >> 1), dlo = (wc & 1) * 32 + fq * 8;
                    const int prow = row < MP ? (row & (SEQ - 1)) : SEQ + ((row - MP) & 3);
                    const f32x4* rp = (const f32x4*)(rope + (size_t)prow * 64 + dlo);
                    const f32x4 c01 = rp[0], c23 = rp[1], c45 = rp[2], c67 = rp[3];
                    const float sc = which ? 0.08838834764831845f : 1.0f;
                    float o1[8], o2[8];
                    o1[0] = a0[0] * c01[0] - b0[0] * c01[1]; o2[0] = b0[0] * c01[0] + a0[0] * c01[1];
                    o1[1] = a0[1] * c01[2] - b0[1] * c01[3]; o2[1] = b0[1] * c01[2] + a0[1] * c01[3];
                    o1[2] = a0[2] * c23[0] - b0[2] * c23[1]; o2[2] = b0[2] * c23[0] + a0[2] * c23[1];
                    o1[3] = a0[3] * c23[2] - b0[3] * c23[3]; o2[3] = b0[3] * c23[2] + a0[3] * c23[3];
                    o1[4] = a1[0] * c45[0] - b1[0] * c45[1]; o2[4] = b1[0] * c45[0] + a1[0] * c45[1];
                    o1[5] = a1[1] * c45[2] - b1[1] * c45[3]; o2[5] = b1[1] * c45[2] + a1[1] * c45[3];
                    o1[6] = a1[2] * c67[0] - b1[2] * c67[1]; o2[6] = b1[2] * c67[0] + a1[2] * c67[1];
                    o1[7] = a1[3] * c67[2] - b1[3] * c67[3]; o2[7] = b1[3] * c67[2] + a1[3] * c67[3];
                    bf16* dst = (which ? k : q) + (size_t)row * 512 + head * 128 + dlo;
                    u32x4 w1, w2;
                    w1.x = pk_bf16(o1[0] * sc, o1[1] * sc); w1.y = pk_bf16(o1[2] * sc, o1[3] * sc); w1.z = pk_bf16(o1[4] * sc, o1[5] * sc); w1.w = pk_bf16(o1[6] * sc, o1[7] * sc);
                    w2.x = pk_bf16(o2[0] * sc, o2[1] * sc); w2.y = pk_bf16(o2[2] * sc, o2[3] * sc); w2.z = pk_bf16(o2[4] * sc, o2[5] * sc); w2.w = pk_bf16(o2[6] * sc, o2[7] * sc);
                    *(u32x4*)dst = w1; *(u32x4*)(dst + 64) = w2;
                } else if (pn < 10) {
                    bf16* dst = v + (size_t)row * 512 + (pn - 8) * 256 + cl;
                    u32x4 w1, w2;
                    w1.x = pk_bf16(a0[0], a0[1]); w1.y = pk_bf16(a0[2], a0[3]); w1.z = pk_bf16(a1[0], a1[1]); w1.w = pk_bf16(a1[2], a1[3]);
                    w2.x = pk_bf16(b0[0], b0[1]); w2.y = pk_bf16(b0[2], b0[3]); w2.z = pk_bf16(b1[0], b1[1]); w2.w = pk_bf16(b1[2], b1[3]);
                    *(u32x4*)dst = w1; *(u32x4*)(dst + 128) = w2;
                } else {
                    const int c0 = (pn - 10) * 256 + cl;
                    const f32x4 g0 = *(const f32x4*)(gn_g + c0), g1 = *(const f32x4*)(gn_g + c0 + 4), g2 = *(const f32x4*)(gn_g + c0 + 128), g3 = *(const f32x4*)(gn_g + c0 + 132);
                    bf16* dst = gate + (size_t)row * 512 + c0;
                    u32x4 w1, w2;
                    w1.x = pk_bf16(a0[0] * sigmoidf_(a0[0]) * g0[0], a0[1] * sigmoidf_(a0[1]) * g0[1]); w1.y = pk_bf16(a0[2] * sigmoidf_(a0[2]) * g0[2], a0[3] * sigmoidf_(a0[3]) * g0[3]);
                    w1.z = pk_bf16(a1[0] * sigmoidf_(a1[0]) * g1[0], a1[1] * sigmoidf_(a1[1]) * g1[1]); w1.w = pk_bf16(a1[2] * sigmoidf_(a1[2]) * g1[2], a1[3] * sigmoidf_(a1[3]) * g1[3]);
                    w2.x = pk_bf16(b0[0] * sigmoidf_(b0[0]) * g2[0], b0[1] * sigmoidf_(b0[1]) * g2[1]); w2.y = pk_bf16(b0[2] * sigmoidf_(b0[2]) * g2[2], b0[3] * sigmoidf_(b0[3]) * g2[3]);
                    w2.z = pk_bf16(b1[0] * sigmoidf_(b1[0]) * g3[0], b1[1] * sigmoidf_(b1[1]) * g3[1]); w2.w = pk_bf16(b1[2] * sigmoidf_(b1[2]) * g3[2], b1[3] * sigmoidf_(b1[3]) * g3[3]);
                    *(u32x4*)dst = w1; *(u32x4*)(dst + 128) = w2;
                }
            }
    }

    __device__ __forceinline__ int brow(int cg, int fb) const { return 256 * (cg >> 2) + 32 * (cg & 3) + (fb >> 1) * 128 + (fb & 1) * 16; }
    __device__ __forceinline__ void small(int row, int cg, int s4, f32x4 a, f32x4 b) const {
        const int pn = cg >> 2, cl = 32 * (cg & 3) + s4;
        const float rstd = rsqrtf(ssq[row] * (1.0f / D) + EPS);
        a = a * rstd; b = b * rstd;
        if (pn < 4) {
            u32x2 w; w.x = pk_bf16(a[0] * sigmoidf_(b[0]), a[1] * sigmoidf_(b[1])); w.y = pk_bf16(a[2] * sigmoidf_(b[2]), a[3] * sigmoidf_(b[3]));
            *(u32x2*)(glu + (size_t)row * 512 + pn * 128 + cl) = w;
        } else if (pn < 8) {
            const int which = (pn - 4) >> 1, tp = pn & 1, head = 2 * tp + (cl >> 6), dlo = cl & 63;
            const int prow = row < MP ? (row & (SEQ - 1)) : SEQ + ((row - MP) & 3);
            const f32x4* rp = (const f32x4*)(rope + (size_t)prow * 64 + dlo);
            const f32x4 c01 = rp[0], c23 = rp[1];
            const float sc = which ? 0.08838834764831845f : 1.0f;
            const float p0 = a[0] * c01[0] - b[0] * c01[1], r0 = b[0] * c01[0] + a[0] * c01[1];
            const float p1 = a[1] * c01[2] - b[1] * c01[3], r1 = b[1] * c01[2] + a[1] * c01[3];
            const float p2 = a[2] * c23[0] - b[2] * c23[1], r2 = b[2] * c23[0] + a[2] * c23[1];
            const float p3 = a[3] * c23[2] - b[3] * c23[3], r3 = b[3] * c23[2] + a[3] * c23[3];
            bf16* dst = (which ? k : q) + (size_t)row * 512 + head * 128 + dlo;
            u32x2 w1, w2; w1.x = pk_bf16(p0 * sc, p1 * sc); w1.y = pk_bf16(p2 * sc, p3 * sc); w2.x = pk_bf16(r0 * sc, r1 * sc); w2.y = pk_bf16(r2 * sc, r3 * sc);
            *(u32x2*)dst = w1; *(u32x2*)(dst + 64) = w2;
        } else if (pn < 10) {
            bf16* dst = v + (size_t)row * 512 + (pn - 8) * 256 + cl;
            u32x2 w1, w2; w1.x = pk_bf16(a[0], a[1]); w1.y = pk_bf16(a[2], a[3]); w2.x = pk_bf16(b[0], b[1]); w2.y = pk_bf16(b[2], b[3]);
            *(u32x2*)dst = w1; *(u32x2*)(dst + 128) = w2;
        } else {
            const int c0 = (pn - 10) * 256 + cl;
            const f32x4 g0 = *(const f32x4*)(gn_g + c0), g2 = *(const f32x4*)(gn_g + c0 + 128);
            bf16* dst = gate + (size_t)row * 512 + c0;
            u32x2 w1, w2;
            w1.x = pk_bf16(a[0] * sigmoidf_(a[0]) * g0[0], a[1] * sigmoidf_(a[1]) * g0[1]); w1.y = pk_bf16(a[2] * sigmoidf_(a[2]) * g0[2], a[3] * sigmoidf_(a[3]) * g0[3]);
            w2.x = pk_bf16(b[0] * sigmoidf_(b[0]) * g2[0], b[1] * sigmoidf_(b[1]) * g2[1]); w2.y = pk_bf16(b[2] * sigmoidf_(b[2]) * g2[2], b[3] * sigmoidf_(b[3]) * g2[3]);
            *(u32x2*)dst = w1; *(u32x2*)(dst + 128) = w2;
        }
    }
};

struct EpiRes {
    static constexpr bool PERM = true, AFTER_DRAIN = false;
    bf16* xs; float* ssq;
    __device__ __forceinline__ void operator()(const f32x4 (&acc)[2][2][4][2], const pg8::Unit& u, int wr, int wc, int fr, int fq) const {
        const int colb = u.pn * 256 + wc * 32 + fq * 8;
#pragma unroll
        for (int ai = 0; ai < 2; ++ai)
#pragma unroll
            for (int m = 0; m < 4; ++m) {
                const int row = u.pm * 256 + ai * 128 + wr * 64 + m * 16 + fr;
                float ss = 0.f;
#pragma unroll
                for (int bj = 0; bj < 2; ++bj) {
                    bf16* p = xs + (size_t)row * D + colb + bj * 128;
                    const u32x4 rv = *(const u32x4*)p;
                    const f32x4 a0 = acc[ai][bj][m][0], a1 = acc[ai][bj][m][1];
                    const float x0 = bflo(rv.x) + a0[0], x1 = bfhi(rv.x) + a0[1], x2 = bflo(rv.y) + a0[2], x3 = bfhi(rv.y) + a0[3];
                    const float x4 = bflo(rv.z) + a1[0], x5 = bfhi(rv.z) + a1[1], x6 = bflo(rv.w) + a1[2], x7 = bfhi(rv.w) + a1[3];
                    ss += (x0 * x0 + x1 * x1) + (x2 * x2 + x3 * x3) + (x4 * x4 + x5 * x5) + (x6 * x6 + x7 * x7);
                    u32x4 w; w.x = pk_bf16(x0, x1); w.y = pk_bf16(x2, x3); w.z = pk_bf16(x4, x5); w.w = pk_bf16(x6, x7);
                    *(u32x4*)p = w;
                }
                ss += __shfl_xor(ss, 16); ss += __shfl_xor(ss, 32);
                if (fq == 0) unsafeAtomicAdd(ssq + row, ss);
            }
    }
    __device__ __forceinline__ int brow(int cg, int fb) const { return 64 * cg + 16 * fb; }
    __device__ __forceinline__ void small(int row, int cg, int s4, f32x4 a, f32x4 b) const {
        bf16* p = xs + (size_t)row * D + 64 * cg + s4;
        const u32x2 r0 = *(const u32x2*)p, r1 = *(const u32x2*)(p + 32);
        const float x0 = bflo(r0.x) + a[0], x1 = bfhi(r0.x) + a[1], x2 = bflo(r0.y) + a[2], x3 = bfhi(r0.y) + a[3];
        const float x4 = bflo(r1.x) + b[0], x5 = bfhi(r1.x) + b[1], x6 = bflo(r1.y) + b[2], x7 = bfhi(r1.y) + b[3];
        float ss = (x0 * x0 + x1 * x1) + (x2 * x2 + x3 * x3) + (x4 * x4 + x5 * x5) + (x6 * x6 + x7 * x7);
        u32x2 w0, w1; w0.x = pk_bf16(x0, x1); w0.y = pk_bf16(x2, x3); w1.x = pk_bf16(x4, x5); w1.y = pk_bf16(x6, x7);
        *(u32x2*)p = w0; *(u32x2*)(p + 32) = w1;
        ss += __shfl_xor(ss, 1); ss += __shfl_xor(ss, 2); ss += __shfl_xor(ss, 4);
        if ((s4 >> 2) == 0) unsafeAtomicAdd(ssq + row, ss);
    }
};

struct EpiUp {
    static constexpr bool PERM = true, AFTER_DRAIN = false;
    const float* ssq; bf16* h;
    __device__ __forceinline__ void operator()(const f32x4 (&acc)[2][2][4][2], const pg8::Unit& u, int wr, int wc, int fr, int fq) const {
        const int colb = u.pn * 256 + wc * 32 + fq * 8;
#pragma unroll
        for (int ai = 0; ai < 2; ++ai)
#pragma unroll
            for (int m = 0; m < 4; ++m) {
                const int row = u.pm * 256 + ai * 128 + wr * 64 + m * 16 + fr;
                const float rstd = rsqrtf(ssq[row] * (1.0f / D) + EPS);
#pragma unroll
                for (int bj = 0; bj < 2; ++bj) {
                    f32x4 x0 = acc[ai][bj][m][0] * rstd, x1 = acc[ai][bj][m][1] * rstd;
#pragma unroll
                    for (int e = 0; e < 4; ++e) { const float t0 = fmaxf(x0[e], 0.f), t1 = fmaxf(x1[e], 0.f); x0[e] = t0 * t0; x1[e] = t1 * t1; }
                    u32x4 w; w.x = pk_bf16(x0[0], x0[1]); w.y = pk_bf16(x0[2], x0[3]); w.z = pk_bf16(x1[0], x1[1]); w.w = pk_bf16(x1[2], x1[3]);
                    *(u32x4*)(h + (size_t)row * FF + colb + bj * 128) = w;
                }
            }
    }

    __device__ __forceinline__ int brow(int cg, int fb) const { return 64 * cg + 16 * fb; }
    __device__ __forceinline__ void small(int row, int cg, int s4, f32x4 a, f32x4 b) const {
        const float rstd = rsqrtf(ssq[row] * (1.0f / D) + EPS);
        const int col = 64 * cg + s4;
#pragma unroll
        for (int e = 0; e < 4; ++e) { const float t0 = fmaxf(a[e] * rstd, 0.f), t1 = fmaxf(b[e] * rstd, 0.f); a[e] = t0 * t0; b[e] = t1 * t1; }
        u32x2 w0, w1; w0.x = pk_bf16(a[0], a[1]); w0.y = pk_bf16(a[2], a[3]); w1.x = pk_bf16(b[0], b[1]); w1.y = pk_bf16(b[2], b[3]);
        *(u32x2*)(h + (size_t)row * FF + col) = w0; *(u32x2*)(h + (size_t)row * FF + col + 32) = w1;
    }
};

constexpr int SG_LD = 68;
template <class Epi, int RT>
__device__ __forceinline__ void small_gemm(LAS unsigned char* lds, const bf16* A, const bf16* Bt, int K, int ncg, const Epi& E) {
    const int tid = ltid(), lane = tid & 63, wave = __builtin_amdgcn_readfirstlane(tid >> 6), r = lane & 15, q = lane >> 4;
    constexpr int KS = RT == 2 ? 4 : 8;
    const int kw = K / KS, kq = RT == 2 ? (wave & 3) : wave, rh = RT == 2 ? (wave >> 2) : 0;
    for (int it = blockIdx.x; it < (8 / RT) * ncg; it += gridDim.x) {
        const int rt = it / ncg, cg = it % ncg;
        const int rowbase = MP + 64 * RT * rt;
        const bf16* ap = A + (size_t)(rowbase + 64 * rh + r) * K + kq * kw + 8 * q;
        const bf16* bp0 = Bt + (size_t)(E.brow(cg, 0) + r) * K + kq * kw + 8 * q;
        const bf16* bp1 = Bt + (size_t)(E.brow(cg, 1) + r) * K + kq * kw + 8 * q;
        const bf16* bp2 = Bt + (size_t)(E.brow(cg, 2) + r) * K + kq * kw + 8 * q;
        const bf16* bp3 = Bt + (size_t)(E.brow(cg, 3) + r) * K + kq * kw + 8 * q;
        f32x4 acc[4][4];
#pragma unroll
        for (int i = 0; i < 4; ++i)
#pragma unroll
            for (int j = 0; j < 4; ++j) acc[i][j] = (f32x4){0.f, 0.f, 0.f, 0.f};
        {
            LAS unsigned char* st = lds + wave * 9216;
            const int lrow = lane >> 3, lch = lane & 7;
            const bf16* ag = A + (size_t)(rowbase + 64 * rh + lrow) * K + kq * kw + lch * 8;
            const bf16* bg0 = Bt + (size_t)(E.brow(cg, 0) + lrow) * K + kq * kw + lch * 8;
            const bf16* bg1 = Bt + (size_t)(E.brow(cg, 1) + lrow) * K + kq * kw + lch * 8;
            const bf16* bg2 = Bt + (size_t)(E.brow(cg, 2) + lrow) * K + kq * kw + lch * 8;
            const bf16* bg3 = Bt + (size_t)(E.brow(cg, 3) + lrow) * K + kq * kw + lch * 8;
            const int wro = lrow * 144 + lch * 16, fro = r * 144 + q * 16;
            u32x4 ga[8], gb[8];
#define SG_GLOAD_A(kk) do { _Pragma("unroll") for (int i = 0; i < 8; ++i) ga[i] = *(const u32x4*)(ag + (size_t)(8 * i) * K + (kk)); } while (0)
#define SG_GLOAD_B(kk) do { \
            gb[0] = *(const u32x4*)(bg0 + (kk)); gb[1] = *(const u32x4*)(bg0 + (size_t)8 * K + (kk)); gb[2] = *(const u32x4*)(bg1 + (kk)); gb[3] = *(const u32x4*)(bg1 + (size_t)8 * K + (kk)); \
            gb[4] = *(const u32x4*)(bg2 + (kk)); gb[5] = *(const u32x4*)(bg2 + (size_t)8 * K + (kk)); gb[6] = *(const u32x4*)(bg3 + (kk)); gb[7] = *(const u32x4*)(bg3 + (size_t)8 * K + (kk)); } while (0)
            SG_GLOAD_A(0); SG_GLOAD_B(0);
#pragma unroll 1
            for (int kk = 0; kk < kw; kk += 64) {
                bf16x8 a[2][4], b[2][4];
#pragma unroll
                for (int i = 0; i < 8; ++i) *(LAS u32x4*)(st + i * (8 * 144) + wro) = ga[i];
                if (kk + 64 < kw) SG_GLOAD_A(kk + 64);
#pragma unroll
                for (int ks = 0; ks < 2; ++ks)
#pragma unroll
                    for (int fa = 0; fa < 4; ++fa) a[ks][fa] = *(const LAS bf16x8*)(st + fa * (16 * 144) + fro + ks * 64);
                asm volatile("s_waitcnt lgkmcnt(0)" ::: "memory");
#pragma unroll
                for (int i = 0; i < 8; ++i) *(LAS u32x4*)(st + i * (8 * 144) + wro) = gb[i];
                if (kk + 64 < kw) SG_GLOAD_B(kk + 64);
#pragma unroll
                for (int ks = 0; ks < 2; ++ks)
#pragma unroll
                    for (int fb = 0; fb < 4; ++fb) b[ks][fb] = *(const LAS bf16x8*)(st + fb * (16 * 144) + fro + ks * 64);
                asm volatile("s_waitcnt lgkmcnt(0)" ::: "memory");
#pragma unroll
                for (int ks = 0; ks < 2; ++ks)
#pragma unroll
                    for (int fa = 0; fa < 4; ++fa)
#pragma unroll
                        for (int fb = 0; fb < 4; ++fb) acc[fa][fb] = __builtin_amdgcn_mfma_f32_16x16x32_bf16(b[ks][fb], a[ks][fa], acc[fa][fb], 0, 0, 0);
            }
#undef SG_GLOAD_A
#undef SG_GLOAD_B
        }
        __syncthreads();
        LAS float* part = (LAS float*)lds + wave * (64 * SG_LD);
#pragma unroll
        for (int fa = 0; fa < 4; ++fa)
#pragma unroll
            for (int fb = 0; fb < 4; ++fb) *(LAS f32x4*)(part + (16 * fa + r) * SG_LD + 16 * fb + 4 * q) = acc[fa][fb];
        __syncthreads();
        if (RT == 1) {
            const int row = tid >> 3, s4 = (tid & 7) * 4;
            f32x4 va = (f32x4){0.f, 0.f, 0.f, 0.f}, vb = va;
#pragma unroll
            for (int w = 0; w < 8; ++w) { const LAS float* p = (const LAS float*)lds + w * (64 * SG_LD) + row * SG_LD + s4; va += *(const LAS f32x4*)p; vb += *(const LAS f32x4*)(p + 32); }
            E.small(rowbase + row, cg, s4, va, vb);
        } else {
            const int row = tid >> 2, rr = row & 63, hh = row >> 6;
#pragma unroll
            for (int j = 0; j < 2; ++j) {
                const int s4 = (tid & 3) * 4 + 16 * j;
                f32x4 va = (f32x4){0.f, 0.f, 0.f, 0.f}, vb = va;
#pragma unroll
                for (int w = 0; w < 4; ++w) { const LAS float* p = (const LAS float*)lds + (hh * 4 + w) * (64 * SG_LD) + rr * SG_LD + s4; va += *(const LAS f32x4*)p; vb += *(const LAS f32x4*)(p + 32); }
                E.small(rowbase + row, cg, s4, va, vb);
            }
        }
        __syncthreads();
    }
}

__device__ __forceinline__ void small_gemm32(LAS unsigned char* lds, const bf16* A, const bf16* Bt, int K, const EpiRes& E) {
    const int tid = ltid(), lane = tid & 63, wave = __builtin_amdgcn_readfirstlane(tid >> 6), r = lane & 15, q = lane >> 4;
    const int kw = K >> 3;
    for (int it = blockIdx.x; it < 256; it += gridDim.x) {
        const int rt = it >> 5, cg = it & 31;
        const int rowbase = MP + 64 * rt;
        f32x4 acc[4][2];
#pragma unroll
        for (int i = 0; i < 4; ++i) { acc[i][0] = (f32x4){0.f, 0.f, 0.f, 0.f}; acc[i][1] = (f32x4){0.f, 0.f, 0.f, 0.f}; }
        {
            LAS unsigned char* st = lds + wave * 9216;
            const int lrow = lane >> 3, lch = lane & 7;
            const bf16* ag = A + (size_t)(rowbase + lrow) * K + wave * kw + lch * 8;
            const bf16* bg = Bt + (size_t)(32 * cg + lrow) * K + wave * kw + lch * 8;
            const int wro = lrow * 144 + lch * 16, fro = r * 144 + q * 16;
            u32x4 ga0[8], gb0[4], ga1[8], gb1[4];
#define SG_GLOAD(ga, gb, kk) do { _Pragma("unroll") for (int i = 0; i < 8; ++i) ga[i] = *(const u32x4*)(ag + (size_t)(8 * i) * K + (kk)); \
            _Pragma("unroll") for (int i = 0; i < 4; ++i) gb[i] = *(const u32x4*)(bg + (size_t)(8 * i) * K + (kk)); } while (0)
#define SG_STEP(ga, gb, knext) do { bf16x8 a[2][4], b[2][2]; \
            _Pragma("unroll") for (int i = 0; i < 8; ++i) *(LAS u32x4*)(st + i * (8 * 144) + wro) = ga[i]; \
            _Pragma("unroll") for (int ks = 0; ks < 2; ++ks) _Pragma("unroll") for (int fa = 0; fa < 4; ++fa) a[ks][fa] = *(const LAS bf16x8*)(st + fa * (16 * 144) + fro + ks * 64); \
            asm volatile("s_waitcnt lgkmcnt(0)" ::: "memory"); \
            _Pragma("unroll") for (int i = 0; i < 4; ++i) *(LAS u32x4*)(st + i * (8 * 144) + wro) = gb[i]; \
            _Pragma("unroll") for (int ks = 0; ks < 2; ++ks) _Pragma("unroll") for (int fb = 0; fb < 2; ++fb) b[ks][fb] = *(const LAS bf16x8*)(st + fb * (16 * 144) + fro + ks * 64); \
            asm volatile("s_waitcnt lgkmcnt(0)" ::: "memory"); \
            if ((knext) < kw) SG_GLOAD(ga, gb, (knext)); \
            _Pragma("unroll") for (int ks = 0; ks < 2; ++ks) _Pragma("unroll") for (int fa = 0; fa < 4; ++fa) _Pragma("unroll") for (int fb = 0; fb < 2; ++fb) \
                acc[fa][fb] = __builtin_amdgcn_mfma_f32_16x16x32_bf16(b[ks][fb], a[ks][fa], acc[fa][fb], 0, 0, 0); } while (0)
            SG_GLOAD(ga0, gb0, 0); SG_GLOAD(ga1, gb1, 64);
#pragma unroll 1
            for (int kk = 0; kk < kw; kk += 128) {
                SG_STEP(ga0, gb0, kk + 128);
                SG_STEP(ga1, gb1, kk + 192);
            }
#undef SG_GLOAD
#undef SG_STEP
        }
        __syncthreads();
        LAS float* part = (LAS float*)lds + wave * (64 * 36);
#pragma unroll
        for (int fa = 0; fa < 4; ++fa)
#pragma unroll
            for (int fb = 0; fb < 2; ++fb) *(LAS f32x4*)(part + (16 * fa + r) * 36 + 16 * fb + 4 * q) = acc[fa][fb];
        __syncthreads();
        const int row = tid >> 3, s4 = (tid & 7) * 4;
        f32x4 va = (f32x4){0.f, 0.f, 0.f, 0.f};
#pragma unroll
        for (int w = 0; w < 8; ++w) va += *(const LAS f32x4*)((const LAS float*)lds + w * (64 * 36) + row * 36 + s4);
        {
            const int grow = rowbase + row;
            bf16* p = E.xs + (size_t)grow * D + 32 * cg + s4;
            const u32x2 r0 = *(const u32x2*)p;
            const float x0 = bflo(r0.x) + va[0], x1 = bfhi(r0.x) + va[1], x2 = bflo(r0.y) + va[2], x3 = bfhi(r0.y) + va[3];
            float ss = (x0 * x0 + x1 * x1) + (x2 * x2 + x3 * x3);
            u32x2 w0; w0.x = pk_bf16(x0, x1); w0.y = pk_bf16(x2, x3);
            *(u32x2*)p = w0;
            ss += __shfl_xor(ss, 1); ss += __shfl_xor(ss, 2); ss += __shfl_xor(ss, 4);
            if ((tid & 7) == 0) unsafeAtomicAdd(E.ssq + grow, ss);
        }
        __syncthreads();
    }
}

__device__ __forceinline__ int win_dest_row(int s) {
    if (s < 512) return ((s >> 7) << 8) + (s & 127);
    if (s < 1024) { const int t = s - 512; return ((t >> 7) << 8) + 128 + (t & 127); }
    if (s < 2048) { const int t = s - 1024; const int which = t >> 9, hd = (t >> 7) & 3, d = t & 127; return 1024 + which * 512 + (hd >> 1) * 256 + (d >> 6) * 128 + (hd & 1) * 64 + (d & 63); }
    return s;
}
__device__ __forceinline__ void p0_transpose_item(const float* W, const float* gk, int K, int N, bf16* WT, bool perm, LAS float* scr, int item, int lane) {
    const int nblk = N / 32, kb = item / nblk, nb = item % nblk, k0 = 64 * kb, n0 = 32 * nb;
#pragma unroll
    for (int i = 0; i < 32; ++i) { const int kk = 2 * i + (lane >> 5); const float gg = gk ? gk[k0 + kk] : 1.0f; scr[kk * 33 + (lane & 31)] = gg * __builtin_nontemporal_load(W + (size_t)(k0 + kk) * N + n0 + (lane & 31)); }
    asm volatile("s_waitcnt lgkmcnt(0)" ::: "memory");
    const int c = lane & 7;
    const int drow0 = perm ? win_dest_row(n0) : n0;
#pragma unroll
    for (int j = 0; j < 4; ++j) { const int n = (lane >> 3) + 8 * j; const LAS float* s = scr + (8 * c) * 33 + n;
        u32x4 o; o.x = pk_bf16(s[0 * 33], s[1 * 33]); o.y = pk_bf16(s[2 * 33], s[3 * 33]); o.z = pk_bf16(s[4 * 33], s[5 * 33]); o.w = pk_bf16(s[6 * 33], s[7 * 33]);
        *(u32x4*)(WT + (size_t)(drow0 + n) * K + k0 + 8 * c) = o; }
    asm volatile("s_waitcnt lgkmcnt(0)" ::: "memory");
}
__device__ __forceinline__ void sincos_acc(float ang, float& c, float& s) {
    const double a = (double)ang;
    const double kd = __builtin_rint(a * 0.63661977236758134308);
    double r = __builtin_fma(-kd, 1.57079632679489655800, a);
    r = __builtin_fma(-kd, 6.12323399573676603587e-17, r);
    const int n = ((int)kd) & 3;
    const double r2 = r * r;
    double sp = -1.0 / 1307674368000.0;
    sp = sp * r2 + 1.0 / 6227020800.0; sp = sp * r2 - 1.0 / 39916800.0; sp = sp * r2 + 1.0 / 362880.0; sp = sp * r2 - 1.0 / 5040.0; sp = sp * r2 + 1.0 / 120.0; sp = sp * r2 - 1.0 / 6.0; sp = sp * r2 + 1.0;
    const double sn = r * sp;
    double cp = 1.0 / 20922789888000.0;
    cp = cp * r2 - 1.0 / 87178291200.0; cp = cp * r2 + 1.0 / 479001600.0; cp = cp * r2 - 1.0 / 3628800.0; cp = cp * r2 + 1.0 / 40320.0; cp = cp * r2 - 1.0 / 720.0; cp = cp * r2 + 1.0 / 24.0; cp = cp * r2 - 0.5; cp = cp * r2 + 1.0;
    const double cs = cp;
    double so, co;
    if (n == 0) { so = sn; co = cs; } else if (n == 1) { so = cs; co = -sn; } else if (n == 2) { so = -sn; co = -cs; } else { so = -cs; co = sn; }
    c = (float)co; s = (float)so;
}

__device__ __forceinline__ void p0_prologue(const Args& a, LAS unsigned char* lds, int wave, int lane) {
    unsigned char* ws = a.ws;
    const int G = gridDim.x, gw = blockIdx.x * NWAVES + wave, NGW = G * NWAVES;
    const int gt = blockIdx.x * NTHREADS + threadIdx.x, NGT = G * NTHREADS;
    float* ssq = (float*)(ws + WS_SSQ);
    for (int i = gt; i < 4 * M; i += NGT) ssq[M + i] = 0.f;
    f32x2* rope = (f32x2*)(ws + WS_ROPE);
    for (int i = gt; i < NPOS * 64; i += NGT) {
        const int p = i >> 6, dd = i & 63;
        const float pos = p < SEQ ? (float)p : (float)(16384 + (p - SEQ));
        const float ang = pos * ROPE_INV[dd];
        float c, s; sincos_acc(ang, c, s);
        rope[i] = (f32x2){c, s};
    }
    LAS float* scr = (LAS float*)(lds + wave * 16384);
    constexpr int I_IN = (D / 64) * (NIN / 32), I_O = (D / 64) * (D / 32), I_UP = (D / 64) * (FF / 32), I_DN = (FF / 64) * (D / 32), I_L = I_IN + I_O + I_UP + I_DN;
    for (int it = gw; it < 2 * I_L; it += NGW) {
        const int l = it / I_L; int r = it % I_L;
        unsigned char* wl = ws + WS_W + (size_t)l * W_LAYER;
        if (r < I_IN) { p0_transpose_item(a.in[5] + (size_t)l * D * NIN, a.in[4] + l * D, D, NIN, (bf16*)(wl + W_IN), true, scr, r, lane); continue; } r -= I_IN;
        if (r < I_O) { p0_transpose_item(a.in[11] + (size_t)l * D * D, nullptr, D, D, (bf16*)(wl + W_OUT), false, scr, r, lane); continue; } r -= I_O;
        if (r < I_UP) { p0_transpose_item(a.in[13] + (size_t)l * D * FF, a.in[12] + l * D, D, FF, (bf16*)(wl + W_UP), false, scr, r, lane); continue; } r -= I_UP;
        p0_transpose_item(a.in[14] + (size_t)l * FF * D, nullptr, FF, D, (bf16*)(wl + W_DN), false, scr, r, lane);
    }
    bf16* XN = (bf16*)(ws + WS_XN);
    for (int m = gw; m < M; m += 2 * NGW) {
        const int m2 = m + NGW; const bool has2 = m2 < M; const int mb = has2 ? m2 : m;
        const float* xa = m < MP ? a.in[0] + (size_t)m * D : a.in[1] + (size_t)(m - MP) * D;
        const float* xb = mb < MP ? a.in[0] + (size_t)mb * D : a.in[1] + (size_t)(mb - MP) * D;
        f32x4 va[4], vb[4];
#pragma unroll
        for (int j = 0; j < 4; ++j) { va[j] = __builtin_nontemporal_load((const f32x4*)(xa + 4 * lane + 256 * j)); vb[j] = __builtin_nontemporal_load((const f32x4*)(xb + 4 * lane + 256 * j)); }
        float sa = 0.f, sb = 0.f;
#pragma unroll
        for (int j = 0; j < 4; ++j) {
            sa += (va[j][0] * va[j][0] + va[j][1] * va[j][1]) + (va[j][2] * va[j][2] + va[j][3] * va[j][3]);
            sb += (vb[j][0] * vb[j][0] + vb[j][1] * vb[j][1]) + (vb[j][2] * vb[j][2] + vb[j][3] * vb[j][3]);
            u32x2 w; w.x = pk_bf16(va[j][0], va[j][1]); w.y = pk_bf16(va[j][2], va[j][3]);
            *(u32x2*)(XN + (size_t)m * D + 4 * lane + 256 * j) = w;
            if (has2) { u32x2 w2; w2.x = pk_bf16(vb[j][0], vb[j][1]); w2.y = pk_bf16(vb[j][2], vb[j][3]); *(u32x2*)(XN + (size_t)mb * D + 4 * lane + 256 * j) = w2; }
        }
        sa = wave_sum(sa); sb = wave_sum(sb);
        if (lane == 0) { ssq[m] = sa; if (has2) ssq[mb] = sb; }
    }
}

template <int NT, bool SAMPLE>
__device__ __forceinline__ void conv_item(LAS unsigned char* lds, int b, int tt, const bf16* glu, const float* cache, const float* cw, const float* cb, const float* lng, const float* lnb,
                                          bf16* mix, float* out_conv, int wave, int lane) {
    const int c = ltid(); lane = c & 63; wave = __builtin_amdgcn_readfirstlane(c >> 6);
    constexpr int NI = NT + 30;
    float in[NI];
    const int t0 = tt * NT;
    if (SAMPLE) {
#pragma unroll
        for (int j = 0; j < 30; ++j) in[j] = __builtin_nontemporal_load(cache + ((size_t)b * 30 + j) * 512 + c);
#pragma unroll
        for (int j = 0; j < NT; ++j) in[30 + j] = bf2f(glu[((size_t)MP + 4 * b + j) * 512 + c]);
    } else {
#pragma unroll
        for (int j = 0; j < NI; ++j) { const int t = t0 - 30 + j; in[j] = t >= 0 ? bf2f(glu[((size_t)b * SEQ + t) * 512 + c]) : 0.f; }
    }
    float w[CW];
#pragma unroll
    for (int k = 0; k < CW; ++k) w[k] = cw[k * 512 + c];
    const float bias = cb[c];
    LAS float* co = (LAS float*)lds;
#pragma unroll
    for (int t = 0; t < NT; ++t) {
        float acc = bias;
#pragma unroll
        for (int k = 0; k < CW; ++k) acc += w[k] * in[t + k];
        co[t * 512 + c] = acc;
    }
    if (SAMPLE) {
#pragma unroll
        for (int jj = 0; jj < 30; ++jj) __builtin_nontemporal_store(in[jj + NT], out_conv + ((size_t)b * 30 + jj) * 512 + c);
    } else if (tt == SEQ / NT - 1) {
#pragma unroll
        for (int jj = 0; jj < 30; ++jj) __builtin_nontemporal_store(in[jj + NT], out_conv + ((size_t)b * 30 + jj) * 512 + c);
    }
    __syncthreads();
    for (int t = wave; t < NT; t += NWAVES) {
        const size_t row = SAMPLE ? (size_t)MP + 4 * b + t : (size_t)b * SEQ + t0 + t;
        f32x4 v0 = *(const LAS f32x4*)(co + t * 512 + lane * 8), v1 = *(const LAS f32x4*)(co + t * 512 + lane * 8 + 4);
        float s = (v0[0] + v0[1]) + (v0[2] + v0[3]) + (v1[0] + v1[1]) + (v1[2] + v1[3]);
        s = wave_sum(s);
        const float mean = s * (1.0f / 512.0f);
        v0 = v0 - mean; v1 = v1 - mean;
        float q = (v0[0] * v0[0] + v0[1] * v0[1]) + (v0[2] * v0[2] + v0[3] * v0[3]) + (v1[0] * v1[0] + v1[1] * v1[1]) + (v1[2] * v1[2] + v1[3] * v1[3]);
        q = wave_sum(q);
        const float rstd = rsqrtf(q * (1.0f / 512.0f) + EPS);
        const f32x4 g0 = *(const f32x4*)(lng + lane * 8), g1 = *(const f32x4*)(lng + lane * 8 + 4), b0 = *(const f32x4*)(lnb + lane * 8), b1 = *(const f32x4*)(lnb + lane * 8 + 4);
        f32x4 y0 = v0 * rstd * g0 + b0, y1 = v1 * rstd * g1 + b1;
#pragma unroll
        for (int e = 0; e < 4; ++e) { y0[e] = y0[e] * sigmoidf_(y0[e]); y1[e] = y1[e] * sigmoidf_(y1[e]); }
        u32x4 o; o.x = pk_bf16(y0[0], y0[1]); o.y = pk_bf16(y0[2], y0[3]); o.z = pk_bf16(y1[0], y1[1]); o.w = pk_bf16(y1[2], y1[3]);
        *(u32x4*)(mix + row * D + lane * 8) = o;
    }
    __syncthreads();
}

__device__ __forceinline__ void conv_pair(LAS unsigned char* lds, int pr, const bf16* glu, const float* cw, const float* cb, const float* lng, const float* lnb, bf16* mix, float* out_conv) {
    const int tid = ltid(), lane = tid & 63, half = __builtin_amdgcn_readfirstlane(tid >> 8), wl = __builtin_amdgcn_readfirstlane((tid >> 6) & 3), t = tid & 255;
    const int itc = pr * 2 + half, b = itc >> 6, tt = itc & 63, t0 = tt * 32;
    constexpr int NT = 32, NI = NT + 30;
    f32x2 in2[NI];
#pragma unroll
    for (int j = 0; j < NI; ++j) {
        const int tk = t0 - 30 + j;
        unsigned w = 0u;
        if (tk >= 0) w = *(const unsigned*)(glu + ((size_t)b * SEQ + tk) * 512 + 2 * t);
        in2[j] = (f32x2){bflo(w), bfhi(w)};
    }
    f32x2 w2[CW];
#pragma unroll
    for (int k = 0; k < CW; ++k) w2[k] = *(const f32x2*)(cw + k * 512 + 2 * t);
    const f32x2 bias2 = *(const f32x2*)(cb + 2 * t);
    LAS float* co = (LAS float*)(lds + half * 65536);
#pragma unroll
    for (int u = 0; u < NT; ++u) {
        f32x2 acc = bias2;
#pragma unroll
        for (int k = 0; k < CW; ++k) acc = w2[k] * in2[u + k] + acc;
        *(LAS f32x2*)(co + u * 512 + 2 * t) = acc;
    }
    if (tt == SEQ / NT - 1) {
#pragma unroll
        for (int jj = 0; jj < 30; ++jj) __builtin_nontemporal_store(in2[jj + NT], (f32x2*)(out_conv + ((size_t)b * 30 + jj) * 512 + 2 * t));
    }
    const f32x4 g0 = *(const f32x4*)(lng + lane * 8), g1 = *(const f32x4*)(lng + lane * 8 + 4), b0 = *(const f32x4*)(lnb + lane * 8), b1 = *(const f32x4*)(lnb + lane * 8 + 4);
    __syncthreads();
    for (int u = wl; u < NT; u += 4) {
        const size_t row = (size_t)b * SEQ + t0 + u;
        f32x4 v0 = *(const LAS f32x4*)(co + u * 512 + lane * 8), v1 = *(const LAS f32x4*)(co + u * 512 + lane * 8 + 4);
        float sm = (v0[0] + v0[1]) + (v0[2] + v0[3]) + (v1[0] + v1[1]) + (v1[2] + v1[3]);
        sm = wave_sum(sm);
        const float mean = sm * (1.0f / 512.0f);
        v0 = v0 - mean; v1 = v1 - mean;
        float qv = (v0[0] * v0[0] + v0[1] * v0[1]) + (v0[2] * v0[2] + v0[3] * v0[3]) + (v1[0] * v1[0] + v1[1] * v1[1]) + (v1[2] * v1[2] + v1[3] * v1[3]);
        qv = wave_sum(qv);
        const float rstd = rsqrtf(qv * (1.0f / 512.0f) + EPS);
        f32x4 y0 = v0 * rstd * g0 + b0, y1 = v1 * rstd * g1 + b1;
#pragma unroll
        for (int e = 0; e < 4; ++e) { y0[e] = y0[e] * sigmoidf_(y0[e]); y1[e] = y1[e] * sigmoidf_(y1[e]); }
        u32x4 o; o.x = pk_bf16(y0[0], y0[1]); o.y = pk_bf16(y0[2], y0[3]); o.z = pk_bf16(y1[0], y1[1]); o.w = pk_bf16(y1[2], y1[3]);
        *(u32x4*)(mix + row * D + lane * 8) = o;
    }
    __syncthreads();
}

constexpr int TS = 272;
__device__ __forceinline__ bf16x8 tr_frag(LAS unsigned char* tile, int rowA, int rowB, int col0, int lane) {
    const int i = lane & 15, qq = i >> 2, p = i & 3;
    const s16x4 lo = __builtin_amdgcn_ds_read_tr16_b64_v4i16((LAS s16x4*)(tile + (rowA + qq) * TS + (col0 + 4 * p) * 2));
    const s16x4 hi = __builtin_amdgcn_ds_read_tr16_b64_v4i16((LAS s16x4*)(tile + (rowB + qq) * TS + (col0 + 4 * p) * 2));
    bf16x8 r; r[0] = lo[0]; r[1] = lo[1]; r[2] = lo[2]; r[3] = lo[3]; r[4] = hi[0]; r[5] = hi[1]; r[6] = hi[2]; r[7] = hi[3];
    return r;
}
__device__ __forceinline__ u32x4 scale_bf16x8(u32x4 v, float s) {
    u32x4 o; o.x = pk_bf16(bflo(v.x) * s, bfhi(v.x) * s); o.y = pk_bf16(bflo(v.y) * s, bfhi(v.y) * s); o.z = pk_bf16(bflo(v.z) * s, bfhi(v.z) * s); o.w = pk_bf16(bflo(v.w) * s, bfhi(v.w) * s);
    return o;
}
__device__ __forceinline__ void kvloc_item(LAS unsigned char* lds, int b, int h, int c, const bf16* K, const bf16* V, float* kvbuf, float lg2, int wave, int lane) {
    LAS unsigned char* Kt = lds; LAS unsigned char* Vt = lds + 128 * TS;
    const int tid = ltid(); lane = tid & 63; wave = __builtin_amdgcn_readfirstlane(tid >> 6); const size_t r0 = (size_t)b * SEQ + c * 128;
#pragma unroll
    for (int i = 0; i < 4; ++i) {
        const int chunk = tid + 512 * i, j = chunk >> 4, cc = chunk & 15;
        u32x4 kv = *(const u32x4*)(K + (r0 + j) * 512 + h * 128 + cc * 8);
        const u32x4 vv = *(const u32x4*)(V + (r0 + j) * 512 + h * 128 + cc * 8);
        kv = scale_bf16x8(kv, exp2f(lg2 * (float)(127 - j)));
        *(LAS u32x4*)(Kt + j * TS + cc * 16) = kv; *(LAS u32x4*)(Vt + j * TS + cc * 16) = vv;
    }
    __syncthreads();
    const int r = lane & 15, q = lane >> 4;
    f32x4 acc[8];
#pragma unroll
    for (int vf = 0; vf < 8; ++vf) acc[vf] = (f32x4){0.f, 0.f, 0.f, 0.f};
#pragma unroll
    for (int ks = 0; ks < 4; ++ks) {
        const bf16x8 bfrag = tr_frag(Kt, 32 * ks + 8 * q, 32 * ks + 8 * q + 4, 16 * wave, lane);
#pragma unroll
        for (int vf = 0; vf < 8; ++vf) {
            const bf16x8 afrag = tr_frag(Vt, 32 * ks + 8 * q, 32 * ks + 8 * q + 4, 16 * vf, lane);
            acc[vf] = __builtin_amdgcn_mfma_f32_16x16x32_bf16(afrag, bfrag, acc[vf], 0, 0, 0);
        }
    }
    float* dst = kvbuf + ((size_t)((b * NH + h) * 16 + c)) * 16384 + (size_t)(16 * wave + r) * 128 + 4 * q;
#pragma unroll
    for (int vf = 0; vf < 8; ++vf) *(f32x4*)(dst + 16 * vf) = acc[vf];
    __syncthreads();
}

__device__ __forceinline__ void kvloc_pair(LAS unsigned char* lds, int pr, const bf16* K, const bf16* V, bf16* kvbuf) {
    const int tid = ltid(), lane = tid & 63, half = __builtin_amdgcn_readfirstlane(tid >> 8), wl = __builtin_amdgcn_readfirstlane((tid >> 6) & 3), t = tid & 255;
    const int k = pr * 2 + half, b = k >> 6, h = (k >> 4) & 3, c = k & 15;
    const float lg2 = __log2f(1.0f - exp2f(-5.0f - (float)h));
    LAS unsigned char* Kt = lds + half * (256 * TS); LAS unsigned char* Vt = Kt + 128 * TS;
    const size_t r0 = (size_t)b * SEQ + c * 128;
#pragma unroll
    for (int i = 0; i < 8; ++i) {
        const int chunk = t + 256 * i, j = chunk >> 4, cc = chunk & 15;
        u32x4 kv = *(const u32x4*)(K + (r0 + j) * 512 + h * 128 + cc * 8);
        const u32x4 vv = *(const u32x4*)(V + (r0 + j) * 512 + h * 128 + cc * 8);
        kv = scale_bf16x8(kv, exp2f(lg2 * (float)(127 - j)));
        *(LAS u32x4*)(Kt + j * TS + cc * 16) = kv; *(LAS u32x4*)(Vt + j * TS + cc * 16) = vv;
    }
    __syncthreads();
    const int r = lane & 15, q = lane >> 4;
    f32x4 acc[2][8];
#pragma unroll
    for (int u = 0; u < 2; ++u)
#pragma unroll
        for (int vf = 0; vf < 8; ++vf) acc[u][vf] = (f32x4){0.f, 0.f, 0.f, 0.f};
#pragma unroll
    for (int ks = 0; ks < 4; ++ks) {
        const bf16x8 b0 = tr_frag(Kt, 32 * ks + 8 * q, 32 * ks + 8 * q + 4, 32 * wl, lane);
        const bf16x8 b1 = tr_frag(Kt, 32 * ks + 8 * q, 32 * ks + 8 * q + 4, 32 * wl + 16, lane);
#pragma unroll
        for (int vf = 0; vf < 8; ++vf) {
            const bf16x8 afrag = tr_frag(Vt, 32 * ks + 8 * q, 32 * ks + 8 * q + 4, 16 * vf, lane);
            acc[0][vf] = __builtin_amdgcn_mfma_f32_16x16x32_bf16(afrag, b0, acc[0][vf], 0, 0, 0);
            acc[1][vf] = __builtin_amdgcn_mfma_f32_16x16x32_bf16(afrag, b1, acc[1][vf], 0, 0, 0);
        }
    }
    bf16* dst = kvbuf + ((size_t)((b * NH + h) * 16 + c)) * 16384 + (size_t)(32 * wl + r) * 128 + 4 * q;
#pragma unroll
    for (int u = 0; u < 2; ++u)
#pragma unroll
        for (int vf = 0; vf < 8; ++vf) { u32x2 w; w.x = pk_bf16(acc[u][vf][0], acc[u][vf][1]); w.y = pk_bf16(acc[u][vf][2], acc[u][vf][3]); *(u32x2*)(dst + (size_t)u * 16 * 128 + 16 * vf) = w; }
    __syncthreads();
}

__device__ __forceinline__ void retout_item(LAS unsigned char* lds, int b, int h, int c, const bf16* Q, const bf16* K, const bf16* V, const bf16* GATE, const bf16* sb, bf16* mix,
                                            float lg2, int wave, int lane) {
    LAS unsigned char* Kt = lds; LAS unsigned char* Vt = lds + 128 * TS; LAS unsigned char* St = lds + 256 * TS;
    const int tid = ltid(); lane = tid & 63; wave = __builtin_amdgcn_readfirstlane(tid >> 6); const size_t r0 = (size_t)b * SEQ + c * 128;
#pragma unroll
    for (int i = 0; i < 4; ++i) {
        const int chunk = tid + 512 * i, j = chunk >> 4, cc = chunk & 15;
        const u32x4 kv = *(const u32x4*)(K + (r0 + j) * 512 + h * 128 + cc * 8);
        const u32x4 vv = *(const u32x4*)(V + (r0 + j) * 512 + h * 128 + cc * 8);
        *(LAS u32x4*)(Kt + j * TS + cc * 16) = kv; *(LAS u32x4*)(Vt + j * TS + cc * 16) = vv;
    }
    if (c > 0) {
        const bf16* sp = sb + ((size_t)((b * NH + h) * 16 + c)) * 16384;
#pragma unroll
        for (int i = 0; i < 4; ++i) {
            const int chunk = tid + 512 * i, j = chunk >> 4, cc = chunk & 15;
            *(LAS u32x4*)(St + j * TS + cc * 16) = *(const u32x4*)(sp + j * 128 + cc * 8);
        }
    }
    __syncthreads();
    const int r = lane & 15, q = lane >> 4;
    const size_t rowi = r0 + 16 * wave + r;
    bf16x8 qf[4];
#pragma unroll
    for (int ks = 0; ks < 4; ++ks) qf[ks] = *(const bf16x8*)(Q + rowi * 512 + h * 128 + 32 * ks + 8 * q);
    f32x4 sc[8];
#pragma unroll
    for (int jf = 0; jf < 8; ++jf) {
        sc[jf] = (f32x4){0.f, 0.f, 0.f, 0.f};
        if (jf <= wave) {
#pragma unroll
            for (int ks = 0; ks < 4; ++ks) {
                const bf16x8 kf = *(const LAS bf16x8*)(Kt + (16 * jf + r) * TS + (32 * ks + 8 * q) * 2);
                sc[jf] = __builtin_amdgcn_mfma_f32_16x16x32_bf16(kf, qf[ks], sc[jf], 0, 0, 0);
            }
#pragma unroll
            for (int e = 0; e < 4; ++e) { const int dlt = (16 * wave + r) - (16 * jf + 4 * q + e); sc[jf][e] = dlt >= 0 ? sc[jf][e] * exp2f(lg2 * (float)dlt) : 0.f; }
        }
    }
    f32x4 ao[8], ac[8];
#pragma unroll
    for (int vf = 0; vf < 8; ++vf) { ao[vf] = (f32x4){0.f, 0.f, 0.f, 0.f}; ac[vf] = (f32x4){0.f, 0.f, 0.f, 0.f}; }
#pragma unroll
    for (int k2 = 0; k2 < 4; ++k2) {
        if (2 * k2 <= wave) {
            union { u32x4 u; bf16x8 v; } pf;
            pf.u.x = pk_bf16(sc[2 * k2][0], sc[2 * k2][1]); pf.u.y = pk_bf16(sc[2 * k2][2], sc[2 * k2][3]); pf.u.z = pk_bf16(sc[2 * k2 + 1][0], sc[2 * k2 + 1][1]); pf.u.w = pk_bf16(sc[2 * k2 + 1][2], sc[2 * k2 + 1][3]);
#pragma unroll
            for (int vf = 0; vf < 8; ++vf) {
                const bf16x8 af = tr_frag(Vt, 32 * k2 + 4 * q, 32 * k2 + 16 + 4 * q, 16 * vf, lane);
                ao[vf] = __builtin_amdgcn_mfma_f32_16x16x32_bf16(af, pf.v, ao[vf], 0, 0, 0);
            }
        }
    }
    if (c > 0) {
#pragma unroll
        for (int ks = 0; ks < 4; ++ks) {
#pragma unroll
            for (int vf = 0; vf < 8; ++vf) {
                const bf16x8 af = tr_frag(St, 32 * ks + 8 * q, 32 * ks + 8 * q + 4, 16 * vf, lane);
                ac[vf] = __builtin_amdgcn_mfma_f32_16x16x32_bf16(af, qf[ks], ac[vf], 0, 0, 0);
            }
        }
    }
    const float gi = exp2f(lg2 * (float)(16 * wave + r + 1));
    float s = 0.f;
#pragma unroll
    for (int vf = 0; vf < 8; ++vf) { ao[vf] = ao[vf] + ac[vf] * gi; s += (ao[vf][0] + ao[vf][1]) + (ao[vf][2] + ao[vf][3]); }
    s += __shfl_xor(s, 16); s += __shfl_xor(s, 32);
    const float mean = s * (1.0f / 128.0f);
    float qv = 0.f;
#pragma unroll
    for (int vf = 0; vf < 8; ++vf) { ao[vf] = ao[vf] - mean; qv += (ao[vf][0] * ao[vf][0] + ao[vf][1] * ao[vf][1]) + (ao[vf][2] * ao[vf][2] + ao[vf][3] * ao[vf][3]); }
    qv += __shfl_xor(qv, 16); qv += __shfl_xor(qv, 32);
    const float rstd = rsqrtf(qv * (1.0f / 128.0f) + EPS);
#pragma unroll
    for (int vf = 0; vf < 8; ++vf) {
        const u32x2 gw = *(const u32x2*)(GATE + rowi * 512 + h * 128 + 16 * vf + 4 * q);
        u32x2 o; o.x = pk_bf16(ao[vf][0] * rstd * bflo(gw.x), ao[vf][1] * rstd * bfhi(gw.x)); o.y = pk_bf16(ao[vf][2] * rstd * bflo(gw.y), ao[vf][3] * rstd * bfhi(gw.y));
        *(u32x2*)(mix + rowi * D + 512 + h * 128 + 16 * vf + 4 * q) = o;
    }
    __syncthreads();
}

__device__ __forceinline__ void scan_phase(const bf16* kvbuf, bf16* sb, float* out_state) {
    const int tid = ltid();
    for (int idx = blockIdx.x * NTHREADS + tid; idx < 32 * 4096; idx += gridDim.x * NTHREADS) {
        const int bh = idx >> 12, e4 = idx & 4095, h = bh & 3;
        const float g128 = exp2f(128.0f * __log2f(1.0f - exp2f(-5.0f - (float)h)));
        const bf16* base = kvbuf + (size_t)bh * 16 * 16384 + e4 * 4;
        u32x2 kvr[16];
#pragma unroll
        for (int c = 0; c < 16; ++c) kvr[c] = *(const u32x2*)(base + (size_t)c * 16384);
        f32x4 s = (f32x4){0.f, 0.f, 0.f, 0.f};
#pragma unroll
        for (int c = 0; c < 16; ++c) {
            if (c > 0) { u32x2 w; w.x = pk_bf16(s[0], s[1]); w.y = pk_bf16(s[2], s[3]); *(u32x2*)(sb + ((size_t)(bh * 16 + c)) * 16384 + e4 * 4) = w; }
            s = s * g128 + (f32x4){bflo(kvr[c].x), bfhi(kvr[c].x), bflo(kvr[c].y), bfhi(kvr[c].y)};
        }
        __builtin_nontemporal_store(s, (f32x4*)(out_state + (size_t)bh * 16384 + e4 * 4));
    }
}

__device__ __forceinline__ void ret_sample_item(LAS unsigned char* lds, int b, int h, const bf16* Q, const bf16* K, const bf16* V, const bf16* GATE, const float* state_in, float* out_state,
                                                bf16* mix, float lg2, int wave, int lane) {
    LAS float* qs = (LAS float*)lds; LAS float* ks = qs + 512; LAS float* vs = ks + 512; LAS float* scs = vs + 512;
    LAS float* red = (LAS float*)(lds + 8192); LAS float* wsum = (LAS float*)(lds + 8192 + 32768);
    const int tid = ltid(); lane = tid & 63; wave = __builtin_amdgcn_readfirstlane(tid >> 6); const size_t row0 = (size_t)MP + 4 * b;
    { const int i = tid >> 7, d = tid & 127; const size_t o = (row0 + i) * 512 + h * 128 + d; qs[tid] = bf2f(Q[o]); ks[tid] = bf2f(K[o]); vs[tid] = bf2f(V[o]); }
    __syncthreads();
    { const int i = wave >> 1;
#pragma unroll
      for (int jj = 0; jj < 2; ++jj) { const int j = (wave & 1) * 2 + jj; float p = qs[i * 128 + lane] * ks[j * 128 + lane] + qs[i * 128 + 64 + lane] * ks[j * 128 + 64 + lane]; p = wave_sum(p);
          if (lane == 0) scs[i * 4 + j] = (j <= i) ? p * exp2f(lg2 * (float)(i - j)) : 0.f; } }
    const int v4 = (tid & 31) * 4, dg = tid >> 5;
    const float g4 = exp2f(lg2 * 4.0f), gk0 = exp2f(lg2 * 3.0f), gk1 = exp2f(lg2 * 2.0f), gk2 = exp2f(lg2), gk3 = 1.0f;
    const float* sin_ = state_in + ((size_t)(b * NH + h) * 128) * 128; float* sout = out_state + ((size_t)(b * NH + h) * 128) * 128;
    const f32x4 vv0 = *(const LAS f32x4*)(vs + v4), vv1 = *(const LAS f32x4*)(vs + 128 + v4), vv2 = *(const LAS f32x4*)(vs + 256 + v4), vv3 = *(const LAS f32x4*)(vs + 384 + v4);
    f32x4 p0 = (f32x4){0.f, 0.f, 0.f, 0.f}, p1 = p0, p2 = p0, p3 = p0;
#pragma unroll
    for (int dd = 0; dd < 8; ++dd) {
        const int d = dg * 8 + dd;
        const f32x4 s4 = *(const f32x4*)(sin_ + (size_t)d * 128 + v4);
        p0 += s4 * qs[d]; p1 += s4 * qs[128 + d]; p2 += s4 * qs[256 + d]; p3 += s4 * qs[384 + d];
        f32x4 ns = s4 * g4 + vv0 * (gk0 * ks[d]) + vv1 * (gk1 * ks[128 + d]) + vv2 * (gk2 * ks[256 + d]) + vv3 * (gk3 * ks[384 + d]);
        *(f32x4*)(sout + (size_t)d * 128 + v4) = ns;
    }
    *(LAS f32x4*)(red + (dg * 4 + 0) * 128 + v4) = p0; *(LAS f32x4*)(red + (dg * 4 + 1) * 128 + v4) = p1; *(LAS f32x4*)(red + (dg * 4 + 2) * 128 + v4) = p2; *(LAS f32x4*)(red + (dg * 4 + 3) * 128 + v4) = p3;
    __syncthreads();
    const int i = tid >> 7, v = tid & 127;
    float cross = 0.f;
#pragma unroll
    for (int g = 0; g < 16; ++g) cross += red[(g * 4 + i) * 128 + v];
    float o = exp2f(lg2 * (float)(i + 1)) * cross;
#pragma unroll
    for (int j = 0; j < 4; ++j) o += scs[i * 4 + j] * vs[j * 128 + v];
    float s = wave_sum(o);
    if (lane == 0) wsum[wave] = s;
    __syncthreads();
    const float mean = (wsum[2 * i] + wsum[2 * i + 1]) * (1.0f / 128.0f);
    const float dv = o - mean;
    float qv = wave_sum(dv * dv);
    if (lane == 0) wsum[8 + wave] = qv;
    __syncthreads();
    const float rstd = rsqrtf((wsum[8 + 2 * i] + wsum[8 + 2 * i + 1]) * (1.0f / 128.0f) + EPS);
    const float gt = bf2f(GATE[(row0 + i) * 512 + h * 128 + v]);
    const unsigned pk = pk_bf16(dv * rstd * gt, 0.f);
    mix[(row0 + i) * D + 512 + h * 128 + v] = (bf16)(pk & 0xffffu);
    __syncthreads();
}

__device__ __forceinline__ void ret_sample_pair(LAS unsigned char* lds, int pair, const bf16* Q, const bf16* K, const bf16* V, const bf16* GATE, const float* state_in, float* out_state, bf16* mix) {
    const int tid = ltid(), half = __builtin_amdgcn_readfirstlane(tid >> 8), t = tid & 255, lane = tid & 63, wl = __builtin_amdgcn_readfirstlane((tid >> 6) & 3);
    const int item = pair * 2 + half, b = item >> 2, h = item & 3;
    const float lg2 = __log2f(1.0f - exp2f(-5.0f - (float)h));
    LAS float* base = (LAS float*)(lds + half * 32768);
    LAS float* qs = base; LAS float* ks = base + 512; LAS float* vs = base + 1024; LAS float* red = base + 2048;
    const size_t row0 = (size_t)MP + 4 * b;
#pragma unroll
    for (int u = 0; u < 2; ++u) { const int e = t + 256 * u, i = e >> 7, d = e & 127; const size_t o = (row0 + i) * 512 + h * 128 + d; qs[e] = bf2f(Q[o]); ks[e] = bf2f(K[o]); vs[e] = bf2f(V[o]); }
    const float gt0 = bf2f(GATE[(row0 + wl) * 512 + h * 128 + lane]), gt1 = bf2f(GATE[(row0 + wl) * 512 + h * 128 + 64 + lane]);
    __syncthreads();
    {
        const int v4 = (t & 31) * 4, dg = t >> 5;
        const float g4 = exp2f(lg2 * 4.0f), gk0 = exp2f(lg2 * 3.0f), gk1 = exp2f(lg2 * 2.0f), gk2 = exp2f(lg2);
        const float* sin_ = state_in + ((size_t)(b * NH + h) * 128) * 128; float* sout = out_state + ((size_t)(b * NH + h) * 128) * 128;
        const f32x4 vv0 = *(const LAS f32x4*)(vs + v4), vv1 = *(const LAS f32x4*)(vs + 128 + v4), vv2 = *(const LAS f32x4*)(vs + 256 + v4), vv3 = *(const LAS f32x4*)(vs + 384 + v4);
        f32x4 p0 = (f32x4){0.f, 0.f, 0.f, 0.f}, p1 = p0, p2 = p0, p3 = p0;
        f32x4 s4[16];
#pragma unroll
        for (int dd = 0; dd < 16; ++dd) s4[dd] = __builtin_nontemporal_load((const f32x4*)(sin_ + (size_t)(dg * 16 + dd) * 128 + v4));
#pragma unroll
        for (int dd = 0; dd < 16; ++dd) {
            const int d = dg * 16 + dd;
            p0 += s4[dd] * qs[d]; p1 += s4[dd] * qs[128 + d]; p2 += s4[dd] * qs[256 + d]; p3 += s4[dd] * qs[384 + d];
            const f32x4 ns = s4[dd] * g4 + vv0 * (gk0 * ks[d]) + vv1 * (gk1 * ks[128 + d]) + vv2 * (gk2 * ks[256 + d]) + vv3 * ks[384 + d];
            __builtin_nontemporal_store(ns, (f32x4*)(sout + (size_t)d * 128 + v4));
        }
        *(LAS f32x4*)(red + (dg * 4 + 0) * 128 + v4) = p0; *(LAS f32x4*)(red + (dg * 4 + 1) * 128 + v4) = p1; *(LAS f32x4*)(red + (dg * 4 + 2) * 128 + v4) = p2; *(LAS f32x4*)(red + (dg * 4 + 3) * 128 + v4) = p3;
    }
    __syncthreads();
    {
        const int i = wl;
        float o0 = 0.f, o1 = 0.f;
#pragma unroll
        for (int g = 0; g < 8; ++g) { o0 += red[(g * 4 + i) * 128 + lane]; o1 += red[(g * 4 + i) * 128 + 64 + lane]; }
        const float gi = exp2f(lg2 * (float)(i + 1));
        o0 *= gi; o1 *= gi;
#pragma unroll
        for (int j = 0; j < 4; ++j) {
            if (j <= i) {
                float p = qs[i * 128 + lane] * ks[j * 128 + lane] + qs[i * 128 + 64 + lane] * ks[j * 128 + 64 + lane];
                p = wave_sum(p) * exp2f(lg2 * (float)(i - j));
                o0 += p * vs[j * 128 + lane]; o1 += p * vs[j * 128 + 64 + lane];
            }
        }
        const float mean = wave_sum(o0 + o1) * (1.0f / 128.0f);
        const float d0 = o0 - mean, d1 = o1 - mean;
        const float rstd = rsqrtf(wave_sum(d0 * d0 + d1 * d1) * (1.0f / 128.0f) + EPS);
        const unsigned pk = pk_bf16(d0 * rstd * gt0, d1 * rstd * gt1);
        bf16* mo = mix + (row0 + i) * D + 512 + h * 128 + lane;
        mo[0] = (bf16)(pk & 0xffffu); mo[64] = (bf16)(pk >> 16);
    }
    __syncthreads();
}

#define XB_TMO      128
#define XB_XCNT(j)  (256  + 64 * (j))
#define XB_XSUB(j)  (1280 + 64 * (j))
#define XB_XGEN(j)  (2304 + 64 * (j))
#define XB_TOP      3328
#define XB_TOPGEN   3392
#define XCD_BAR_WORDS 3456
#define XB_SPIN_CAP (1u << 18)

__device__ __forceinline__ unsigned xb_ld(unsigned* p)              { return __hip_atomic_load(p, __ATOMIC_RELAXED, __HIP_MEMORY_SCOPE_AGENT); }
__device__ __forceinline__ unsigned xb_add(unsigned* p, unsigned v) { return __hip_atomic_fetch_add(p, v, __ATOMIC_RELAXED, __HIP_MEMORY_SCOPE_AGENT); }
__device__ __forceinline__ unsigned xb_xcc_id() { return (unsigned)__builtin_amdgcn_s_getreg((3 << 11) | 20) & 0xFu; }
#define XB_SPIN(cond, bar) do { unsigned _sp = 0; while (cond) { __builtin_amdgcn_s_sleep(1); \
    if ((++_sp & 255u) == 0u) { if (xb_ld(&(bar)[XB_TMO])) break; if (_sp > XB_SPIN_CAP) { atomicAdd(&(bar)[XB_TMO], 1u); break; } } } } while (0)

struct XcdBarrier {
    unsigned* bar; unsigned x;
    volatile LAS unsigned* st;
};

__device__ __forceinline__ XcdBarrier xcd_barrier_post(unsigned* bar, volatile LAS unsigned* st) {
    XcdBarrier b; b.bar = bar; b.x = xb_xcc_id(); b.st = st;
    if (threadIdx.x == 0) (void)xb_add(&bar[XB_XCNT(b.x)], 1u);
    return b;
}
__device__ __forceinline__ void xcd_barrier_complete(unsigned* bar, unsigned x, unsigned& nloc, unsigned& nx) {
    const unsigned G = gridDim.x * gridDim.y * gridDim.z;
    unsigned sum, cnt, mine, sp = 0u;
    for (;;) {
        sum = 0u; cnt = 0u; mine = 0u;
#pragma unroll
        for (unsigned j = 0; j < 16; ++j) { const unsigned c = xb_ld(&bar[XB_XCNT(j)]); sum += c; cnt += (c > 0u) ? 1u : 0u; mine = (j == x) ? c : mine; }
        if (sum == G) break;
        __builtin_amdgcn_s_sleep(1);
        if ((++sp & 255u) == 0u) { if (xb_ld(&bar[XB_TMO])) break; if (sp > XB_SPIN_CAP) { atomicAdd(&bar[XB_TMO], 1u); break; } }
    }
    nloc = mine > 0u ? mine : 1u; nx = cnt > 0u ? cnt : 1u;
}

__device__ __forceinline__ void xcd_barrier(const XcdBarrier& b) {
    asm volatile("s_waitcnt vmcnt(0)" ::: "memory");
    __syncthreads();
    if (threadIdx.x == 0) {
        unsigned* bar = b.bar;
        __builtin_amdgcn_s_waitcnt(0);
        unsigned nloc = b.st[0], nx = b.st[1];
        if (nloc == 0u) { xcd_barrier_complete(bar, b.x, nloc, nx); b.st[0] = nloc; b.st[1] = nx; }
        const unsigned old = xb_add(&bar[XB_XSUB(b.x)], 1u);
        const unsigned gen = old / nloc;
        if (old + 1u == (gen + 1u) * nloc) {
            __builtin_amdgcn_fence(__ATOMIC_RELEASE, "agent");
            asm volatile("s_waitcnt vmcnt(0)" ::: "memory");
            const unsigned og = xb_add(&bar[XB_TOP], 1u);
            const unsigned tg = og / nx;
            if (og + 1u == (tg + 1u) * nx) xb_add(&bar[XB_TOPGEN], 1u);
            else XB_SPIN(xb_ld(&bar[XB_TOPGEN]) == tg, bar);
            __builtin_amdgcn_fence(__ATOMIC_ACQUIRE, "agent");
            xb_add(&bar[XB_XGEN(b.x)], 1u);
            asm volatile("s_waitcnt vmcnt(0)" ::: "memory");
        } else {
            XB_SPIN(xb_ld(&bar[XB_XGEN(b.x)]) == gen, bar);
            __builtin_amdgcn_fence(__ATOMIC_ACQUIRE, "agent");
            asm volatile("s_waitcnt vmcnt(0)" ::: "memory");
        }
    }
    __syncthreads();
}

#define GRID_SYNC() do { XcdBarrier b_ = bar; unsigned* p_ = (unsigned*)(a.ws + WS_CTL) + 4096; asm volatile("" : "+s"(p_)); b_.bar = p_; unsigned x_ = bar.x; asm volatile("" : "+s"(x_)); b_.x = x_; xcd_barrier(b_); } while (0)

__global__ void __launch_bounds__(NTHREADS, 2) mega_fwd(Args a) {
    extern __shared__ __attribute__((aligned(16))) unsigned char lds_raw[];
    LAS unsigned char* lds = (LAS unsigned char*)lds_raw;
    cg::grid_group grid = cg::this_grid();
    const int tid = threadIdx.x, lane = tid & 63, wave = __builtin_amdgcn_readfirstlane(tid >> 6);
    const int G = gridDim.x, bid = blockIdx.x;
    unsigned char* ws = a.ws;
    float* ssq = (float*)(ws + WS_SSQ);
    const f32x2* rope = (const f32x2*)(ws + WS_ROPE);
    bf16* XN = (bf16*)(ws + WS_XN);
    bf16 *GLU = (bf16*)(ws + WS_GLU), *Qb = (bf16*)(ws + WS_Q), *Kb = (bf16*)(ws + WS_K), *Vb = (bf16*)(ws + WS_V), *GATE = (bf16*)(ws + WS_GATE), *MIX = (bf16*)(ws + WS_MIX), *Hb = (bf16*)(ws + WS_H);
    bf16* KVB = (bf16*)(ws + WS_KV);
    bf16* SB = (bf16*)(ws + WS_SB);
    float* XR = a.out + O_Y;
    volatile LAS unsigned* MISC = (volatile LAS unsigned*)(lds + LDS_BYTES - 256);
    if (tid < 64) MISC[tid] = 0u;
    __syncthreads();
    XcdBarrier bar = xcd_barrier_post((unsigned*)(ws + WS_CTL) + 4096, MISC + 8);

#ifndef SKIP_P0
    for (int rep = 0; rep < REP_P0; ++rep) p0_prologue(a, lds, wave, lane);
#endif
    if (a.ws == nullptr) grid.sync();
    GRID_SYNC();

    for (int l = 0; l < 2; ++l) {
        const unsigned char* wl = ws + WS_W + (size_t)l * W_LAYER;
        {
            pg8::Gemm g{XN, (const bf16*)(wl + W_IN), MP, NIN, D}; pg8::StaticOrder S; S.init(MP, NIN, G, bid);
            EpiIn E{ssq + (size_t)(2 * l) * M, GLU, Qb, Kb, Vb, GATE, rope, a.in[10] + l * 512};
#ifndef SKIP_IN
            for (int rep = 0; rep < REP_BIG; ++rep) pg8::gemm_phase<EpiIn, pg8::StaticOrder, true, true>(lds, g, S, E);
#endif
            for (int rep = 0; rep < REP_SMALL; ++rep) small_gemm<EpiIn, 2>(lds, XN, (const bf16*)(wl + W_IN), D, 48, E);
        }
        GRID_SYNC();
        {
            const float* cw = a.in[6] + (size_t)l * CW * 512; const float* cb = a.in[7] + l * 512; const float* lng = a.in[8] + l * 512; const float* lnb = a.in[9] + l * 512;
            const float* cache = a.in[2] + (size_t)l * 128 * 30 * 512;
            float* ocp = a.out + O_CP + (size_t)l * 8 * 30 * 512; float* ocs = a.out + O_CS + (size_t)l * 128 * 30 * 512;
            const float* st_in = a.in[3] + (size_t)l * 128 * NH * 16384; float* ors = a.out + O_RS + (size_t)l * 128 * NH * 16384;
            for (int rep = 0; rep < REP_P2; ++rep)
            for (int it = bid; it < 896; it += G) {
#ifndef SKIP_P2
                if (it < 256) { conv_pair(lds, it, GLU, cw, cb, lng, lnb, MIX, ocp); }
                else if (it < 384) { conv_item<4, true>(lds, it - 256, 0, GLU, cache, cw, cb, lng, lnb, MIX, ocs, wave, lane); }
                else if (it < 640) { kvloc_pair(lds, it - 384, Kb, Vb, KVB); }
                else { ret_sample_pair(lds, it - 640, Qb, Kb, Vb, GATE, st_in, ors, MIX); }
#endif
            }
        }
        GRID_SYNC();
        scan_phase(KVB, SB, a.out + O_RP + (size_t)l * 8 * NH * 16384);
        GRID_SYNC();
        {
#ifndef SKIP_P3
            for (int rep = 0; rep < REP_P3; ++rep)
            for (int it = bid; it < 512; it += G) { const int h = (it >> 4) & 3; retout_item(lds, it >> 6, h, it & 15, Qb, Kb, Vb, GATE, SB, MIX, __log2f(1.0f - exp2f(-5.0f - (float)h)), wave, lane); }
#endif
        }
        GRID_SYNC();
        {
            pg8::Gemm g{MIX, (const bf16*)(wl + W_OUT), MP, D, D}; pg8::StaticOrder S; S.init(MP, D, G, bid);
            EpiRes E{XN, ssq + (size_t)(2 * l + 1) * M};
#ifndef SKIP_RES
            pg8::gemm_phase<EpiRes, pg8::StaticOrder, true, true>(lds, g, S, E);
#endif
            small_gemm32(lds, MIX, (const bf16*)(wl + W_OUT), D, E);
        }
        GRID_SYNC();
        {
            pg8::Gemm g{XN, (const bf16*)(wl + W_UP), MP, FF, D}; pg8::StaticOrder S; S.init(MP, FF, G, bid);
            EpiUp E{ssq + (size_t)(2 * l + 1) * M, Hb};
#ifndef SKIP_UP
            for (int rep = 0; rep < REP_BIG; ++rep) pg8::gemm_phase<EpiUp, pg8::StaticOrder, true, true>(lds, g, S, E);
#endif
            for (int rep = 0; rep < REP_SMALL; ++rep) small_gemm<EpiUp, 2>(lds, XN, (const bf16*)(wl + W_UP), D, 64, E);
        }
        GRID_SYNC();
        {
            pg8::Gemm g{Hb, (const bf16*)(wl + W_DN), MP, D, FF}; pg8::StaticOrder S; S.init(MP, D, G, bid);
            EpiRes E{XN, ssq + (size_t)(2 * l + 2) * M};
#ifndef SKIP_RES
            pg8::gemm_phase<EpiRes, pg8::StaticOrder, true, true>(lds, g, S, E);
#endif
            small_gemm32(lds, Hb, (const bf16*)(wl + W_DN), FF, E);
        }
        GRID_SYNC();
    }
    {
        const float* gf = a.in[15]; const float* sq = ssq + (size_t)4 * M;
        const int gw = bid * NWAVES + wave, NGW = G * NWAVES;
        for (int m0 = gw; m0 < M; m0 += 4 * NGW) {
            u32x4 v[4][2]; float rs[4];
#pragma unroll
            for (int u = 0; u < 4; ++u) {
                const int m = (m0 + u * NGW) < M ? (m0 + u * NGW) : m0;
                rs[u] = sq[m];
                v[u][0] = *(const u32x4*)(XN + (size_t)m * D + 8 * lane); v[u][1] = *(const u32x4*)(XN + (size_t)m * D + 8 * lane + 512);
            }
#pragma unroll
            for (int u = 0; u < 4; ++u) {
                const int m = m0 + u * NGW;
                if (m < M) {
                    const float rstd = rsqrtf(rs[u] * (1.0f / D) + EPS);
                    float* yrow = XR + (size_t)m * D;
#pragma unroll
                    for (int j = 0; j < 2; ++j) {
                        const u32x4 w = v[u][j];
                        const f32x4 g0 = *(const f32x4*)(gf + 8 * lane + 512 * j), g1 = *(const f32x4*)(gf + 8 * lane + 512 * j + 4);
                        f32x4 y0, y1;
                        y0[0] = bflo(w.x) * rstd * g0[0]; y0[1] = bfhi(w.x) * rstd * g0[1]; y0[2] = bflo(w.y) * rstd * g0[2]; y0[3] = bfhi(w.y) * rstd * g0[3];
                        y1[0] = bflo(w.z) * rstd * g1[0]; y1[1] = bfhi(w.z) * rstd * g1[1]; y1[2] = bflo(w.w) * rstd * g1[2]; y1[3] = bfhi(w.w) * rstd * g1[3];
                        __builtin_nontemporal_store(y0, (f32x4*)(yrow + 8 * lane + 512 * j)); __builtin_nontemporal_store(y1, (f32x4*)(yrow + 8 * lane + 512 * j + 4));
                    }
                }
            }
        }
    }
}

extern "C" void kernel_launch(void* const* d_in, const int* in_sizes, int n_in, void* d_out, int out_size, void* d_ws, size_t ws_size, hipStream_t stream) {
    static int grid = 0;
    if (grid == 0) {
        int dev = 0, cus = 0, per_cu = 0;
        (void)hipGetDevice(&dev);
        (void)hipDeviceGetAttribute(&cus, hipDeviceAttributeMultiprocessorCount, dev);
        (void)hipFuncSetAttribute((const void*)mega_fwd, hipFuncAttributeMaxDynamicSharedMemorySize, LDS_BYTES);
        (void)hipOccupancyMaxActiveBlocksPerMultiprocessor(&per_cu, (const void*)mega_fwd, NTHREADS, LDS_BYTES);
        if (per_cu < 1) per_cu = 1;
        if (per_cu > 1) per_cu = 1;
        grid = cus * per_cu;
        if (n_in != 16 || ws_size < WS_END) { fprintf(stderr, "kernel_launch: unexpected n_in %d / ws %zu\n", n_in, ws_size); }
    }
    (void)hipMemsetAsync((char*)d_ws + WS_CTL, 0, CTL_BYTES, stream);
    Args a{};
    for (int i = 0; i < 16; ++i) a.in[i] = (const float*)d_in[i];
    a.out = (float*)d_out; a.ws = (unsigned char*)d_ws;
    void* args[] = {&a};
    hipError_t e = hipLaunchCooperativeKernel((const void*)mega_fwd, dim3(grid), dim3(NTHREADS), args, LDS_BYTES, stream);
    if (e != hipSuccess) fprintf(stderr, "cooperative launch failed: %s (grid %d)\n", hipGetErrorString(e), grid);
}
```

```cpp
#include <hip/hip_runtime.h>
#include <hip/hip_cooperative_groups.h>
#include <cstdio>
#include <cstdint>
namespace cg = cooperative_groups;
namespace pg8 {
#define PG8_LAS __attribute__((address_space(3)))
typedef unsigned short bf16_t;
typedef short bf16x8 __attribute__((ext_vector_type(8)));
typedef float f32x4 __attribute__((ext_vector_type(4)));
typedef unsigned u32x4 __attribute__((ext_vector_type(4)));
constexpr int BM = 256, BK = 64, HALF = 128, HTB = HALF * BK * 2  , STAGE_BYTES = 8 * HTB, NXCD = 8, WGM = 8;

__host__ __device__ __forceinline__ int lds_byte(int r, int c) { const int st = (r >> 4) * 2 + (c >> 5), rr = r & 15, cc = c & 31, ob = rr * 64 + cc * 2; return st * 1024 + (ob ^ (((ob >> 9) & 1) << 5)); }
__host__ __device__ __forceinline__ void stage_rc(int b, int& R, int& C) { const int st = b / 1024, sb = b % 1024, swz = sb ^ (((sb >> 9) & 1) << 5); R = (st >> 1) * 16 + swz / 64; C = (st & 1) * 32 + (swz % 64) / 2; }
__host__ __device__ __forceinline__ int perm32(int rho) { const int n = rho >> 4, i = rho & 15; return 8 * (i >> 2) + 4 * n + (i & 3); }

struct Unit { int pm, pn; };
struct Gemm { const bf16_t* A; const bf16_t* Bt; int M, N, K; };

struct StaticOrder {
    int nM, nN, nwg, G, c;
    __host__ __device__ void init(int M, int N, int G_, int c_) { nM = M / BM; nN = N / BM; nwg = nM * nN; G = G_; c = c_; }
    __host__ __device__ bool next(int i, Unit& u) const {
        const long L = (long)i * G + c; if (L >= nwg) return false;
        int wgid = (int)L; { const int q = nwg / NXCD, r = nwg % NXCD, xcd = wgid % NXCD, off = wgid / NXCD; wgid = (xcd < r ? xcd * (q + 1) : r * (q + 1) + (xcd - r) * q) + off; }
        const int nig = WGM * nN, gid = wgid / nig, fm = gid * WGM, gsz = (nM - fm) < WGM ? (nM - fm) : WGM;
        u.pm = fm + ((wgid % nig) % gsz); u.pn = (wgid % nig) / gsz; return true;
    }
    __device__ __forceinline__ void a_ready(const Unit&) const {}
    __device__ __forceinline__ void done(const Unit&) const {}
};
__device__ __forceinline__ unsigned cvt_pk_bf16(float lo, float hi) { unsigned r; asm volatile("v_cvt_pk_bf16_f32 %0, %1, %2" : "=v"(r) : "v"(lo), "v"(hi)); return r; }
typedef float f32x2 __attribute__((ext_vector_type(2)));
template <class Epi, class Sched, bool ALIGN_EPI = false, bool SP2 = false>
__device__ __forceinline__ void gemm_phase(PG8_LAS unsigned char* lds, const Gemm g, const Sched& S, const Epi& E) {
    int tid_ = threadIdx.x; asm volatile("" : "+v"(tid_)); const int tid = tid_, wid = __builtin_amdgcn_readfirstlane(tid >> 6), lane = tid & 63, wr = wid >> 2, wc = wid & 3, fr = lane & 15, fq = lane >> 4;
    const int K = g.K, nt = K / BK;
    unsigned voffA[2], voffB[2];
#pragma unroll
    for (int i = 0; i < 2; ++i) { int R, C; stage_rc(tid * 16 + i * 8192, R, C); const int Rb = Epi::PERM ? ((R & ~31) + perm32(R & 31)) : R;
        voffA[i] = (unsigned)(R * K + C) * 2u; voffB[i] = (unsigned)(Rb * K + C) * 2u; }
    const size_t kstep = (size_t)(BK * 2);
    const size_t hstep = (size_t)HALF * K * 2;
    const size_t tstep = 2 * hstep;
    const unsigned ldsw = (unsigned)wid * 1024u;
    const int aoff = lds_byte(wr * 64 + fr, fq * 8), boff = lds_byte(wc * 32 + fr, fq * 8);
#define PG8_SA(b, h) (((b) * 2 + (h)) * HTB)
#define PG8_SB(b, h) ((4 + (b) * 2 + (h)) * HTB)
#define PG8_STAGE(bufoff, gbase, voff) do { _Pragma("unroll") for (int _i = 0; _i < 2; ++_i) \
        __builtin_amdgcn_global_load_lds((const unsigned*)((const char*)(gbase) + (voff)[_i]), (PG8_LAS unsigned*)(lds + (bufoff) + ldsw + _i * 8192), 16, 0, 0); } while (0)
#define PG8_LDA(dst, b, h) do { _Pragma("unroll") for (int m = 0; m < 4; ++m) _Pragma("unroll") for (int k = 0; k < 2; ++k) dst[m][k] = *(const PG8_LAS bf16x8*)(lds + PG8_SA(b, h) + aoff + m * 2048 + k * 1024); } while (0)
#define PG8_LDB(dst, b, h) do { _Pragma("unroll") for (int n = 0; n < 2; ++n) _Pragma("unroll") for (int k = 0; k < 2; ++k) dst[n][k] = *(const PG8_LAS bf16x8*)(lds + PG8_SB(b, h) + boff + n * 2048 + k * 1024); } while (0)
#define PG8_MMA(ai, bj, At, Bt) do { __builtin_amdgcn_s_setprio(1); _Pragma("unroll") for (int m = 0; m < 4; ++m) _Pragma("unroll") for (int n = 0; n < 2; ++n) _Pragma("unroll") for (int k = 0; k < 2; ++k) \
        acc[ai][bj][m][n] = __builtin_amdgcn_mfma_f32_16x16x32_bf16(Bt[n][k], At[m][k], acc[ai][bj][m][n], 0, 0, 0); __builtin_amdgcn_s_setprio(0); } while (0)
#define PG8_WAIT_V(n) asm volatile("s_waitcnt vmcnt(" #n ")" ::: "memory")
#define PG8_WAIT_L(n) asm volatile("s_waitcnt lgkmcnt(" #n ")" ::: "memory")
#define PG8_BAR __builtin_amdgcn_s_barrier()
#define PG8_SCHED __builtin_amdgcn_sched_barrier(0)
    Unit cur, nxt; int ui = 0;
    if (!S.next(0, cur)) return;
    f32x4 acc[2][2][4][2];
#pragma unroll
    for (int a = 0; a < 2; ++a)
#pragma unroll
        for (int b = 0; b < 2; ++b)
#pragma unroll
            for (int m = 0; m < 4; ++m)
#pragma unroll
                for (int n = 0; n < 2; ++n) acc[a][b][m][n] = (f32x4){0.f, 0.f, 0.f, 0.f};
    bf16x8 At[4][2], B0[2][2], B1[2][2];
    const char* cA = (const char*)g.A + (size_t)cur.pm * tstep; const char* cB = (const char*)g.Bt + (size_t)cur.pn * tstep;
    S.a_ready(cur);
    if constexpr (SP2) {
        PG8_STAGE(PG8_SB(0, 0), cB, voffB); PG8_STAGE(PG8_SB(0, 1), cB + hstep, voffB); PG8_STAGE(PG8_SA(0, 0), cA, voffA); PG8_STAGE(PG8_SA(0, 1), cA + hstep, voffA);
        if (wr == 1) PG8_BAR;
        PG8_WAIT_V(2); PG8_BAR;
        PG8_STAGE(PG8_SB(1, 0), cB + kstep, voffB); PG8_STAGE(PG8_SA(1, 0), cA + kstep, voffA); PG8_STAGE(PG8_SB(1, 1), cB + hstep + kstep, voffB);
        PG8_WAIT_V(6); PG8_BAR;
    } else {
        PG8_STAGE(PG8_SB(0, 0), cB, voffB); PG8_STAGE(PG8_SA(0, 0), cA, voffA); PG8_STAGE(PG8_SB(0, 1), cB + hstep, voffB); PG8_STAGE(PG8_SA(0, 1), cA + hstep, voffA);
        if (wr == 1) PG8_BAR;
        PG8_WAIT_V(4); PG8_BAR;
        PG8_STAGE(PG8_SB(1, 0), cB + kstep, voffB); PG8_STAGE(PG8_SA(1, 0), cA + kstep, voffA); PG8_STAGE(PG8_SB(1, 1), cB + hstep + kstep, voffB);
        PG8_WAIT_V(6); PG8_BAR;
    }
    for (;;) {
        const bool has_next = S.next(ui + 1, nxt);
        const char* nA = has_next ? (const char*)g.A + (size_t)nxt.pm * tstep : cA; const char* nB = has_next ? (const char*)g.Bt + (size_t)nxt.pn * tstep : cB;
        for (int t = 0; t < nt; t += 2) {
            const bool last = (t == nt - 2);
            const char* a1 = cA + (size_t)(t + 1) * kstep;
            const char* a2 = last ? nA : cA + (size_t)(t + 2) * kstep; const char* b2 = last ? nB : cB + (size_t)(t + 2) * kstep;
            const char* a3 = a2 + kstep; const char* b3 = b2 + kstep;
            if (last && has_next) S.a_ready(nxt);
            if constexpr (SP2) {
            PG8_LDB(B0, 0, 0); PG8_LDB(B1, 0, 1); PG8_SCHED; PG8_LDA(At, 0, 0); PG8_STAGE(PG8_SA(1, 1), a1 + hstep, voffA);
            PG8_WAIT_V(8); PG8_WAIT_L(0); PG8_BAR; PG8_MMA(0, 0, At, B0); PG8_MMA(0, 1, At, B1); PG8_BAR; PG8_SCHED;
            PG8_LDA(At, 0, 1); PG8_STAGE(PG8_SB(0, 0), b2, voffB); PG8_STAGE(PG8_SB(0, 1), b2 + hstep, voffB); PG8_STAGE(PG8_SA(0, 0), a2, voffA);
            PG8_WAIT_V(8); PG8_WAIT_L(0); PG8_BAR; PG8_MMA(1, 0, At, B0); PG8_MMA(1, 1, At, B1); PG8_BAR; PG8_SCHED;
            PG8_LDB(B0, 1, 0); PG8_LDB(B1, 1, 1); PG8_SCHED; PG8_LDA(At, 1, 0); PG8_STAGE(PG8_SA(0, 1), a2 + hstep, voffA);
            PG8_WAIT_V(8); PG8_WAIT_L(0); PG8_BAR; PG8_MMA(0, 0, At, B0); PG8_MMA(0, 1, At, B1); PG8_BAR; PG8_SCHED;
            PG8_LDA(At, 1, 1); PG8_STAGE(PG8_SB(1, 0), b3, voffB); PG8_STAGE(PG8_SB(1, 1), b3 + hstep, voffB); PG8_STAGE(PG8_SA(1, 0), a3, voffA);
            PG8_WAIT_V(8); PG8_WAIT_L(0); PG8_BAR; PG8_MMA(1, 0, At, B0); PG8_MMA(1, 1, At, B1); PG8_BAR; PG8_SCHED;
            } else {
            PG8_LDB(B0, 0, 0); PG8_SCHED; PG8_LDA(At, 0, 0); PG8_STAGE(PG8_SA(1, 1), a1 + hstep, voffA);
            PG8_WAIT_L(8); PG8_BAR; PG8_WAIT_L(0); PG8_MMA(0, 0, At, B0); PG8_BAR; PG8_SCHED;
            PG8_LDB(B1, 0, 1); PG8_STAGE(PG8_SB(0, 0), b2, voffB);
            PG8_BAR; PG8_WAIT_L(0); PG8_MMA(0, 1, At, B1); PG8_BAR;
            PG8_LDA(At, 0, 1); PG8_STAGE(PG8_SA(0, 0), a2, voffA);
            PG8_BAR; PG8_WAIT_L(0); PG8_MMA(1, 0, At, B0); PG8_BAR; PG8_SCHED;
            PG8_STAGE(PG8_SB(0, 1), b2 + hstep, voffB);
            PG8_WAIT_V(6); PG8_BAR; PG8_MMA(1, 1, At, B1); PG8_BAR;
            PG8_LDB(B0, 1, 0); PG8_SCHED; PG8_LDA(At, 1, 0); PG8_STAGE(PG8_SA(0, 1), a2 + hstep, voffA);
            PG8_WAIT_L(8); PG8_BAR; PG8_WAIT_L(0); PG8_MMA(0, 0, At, B0); PG8_BAR; PG8_SCHED;
            PG8_LDB(B1, 1, 1); PG8_STAGE(PG8_SB(1, 0), b3, voffB);
            PG8_BAR; PG8_WAIT_L(0); PG8_MMA(0, 1, At, B1); PG8_BAR;
            PG8_LDA(At, 1, 1); PG8_STAGE(PG8_SA(1, 0), a3, voffA);
            PG8_BAR; PG8_WAIT_L(0); PG8_MMA(1, 0, At, B0); PG8_BAR; PG8_SCHED;
            PG8_STAGE(PG8_SB(1, 1), b3 + hstep, voffB);
            PG8_WAIT_V(6); PG8_BAR; PG8_MMA(1, 1, At, B1); PG8_BAR;
            }
        }
        if constexpr (ALIGN_EPI) { if (wr == 0) PG8_BAR; }
        if constexpr (!Epi::AFTER_DRAIN) { E(acc, cur, wr, wc, fr, fq); S.done(cur); }
        if (!has_next) break;
#pragma unroll
        for (int a = 0; a < 2; ++a)
#pragma unroll
            for (int b = 0; b < 2; ++b)
#pragma unroll
                for (int m = 0; m < 4; ++m)
#pragma unroll
                    for (int n = 0; n < 2; ++n) acc[a][b][m][n] = (f32x4){0.f, 0.f, 0.f, 0.f};
        cur = nxt; cA = nA; cB = nB; ++ui;
        if constexpr (ALIGN_EPI) { if (wr == 1) PG8_BAR; }
    }
    PG8_WAIT_V(0);
    if constexpr (!ALIGN_EPI) { if (wr == 0) PG8_BAR; }
    PG8_BAR;
    if constexpr (Epi::AFTER_DRAIN) { E.fused(acc, cur, wr, wc, fr, fq, lds, wid, lane); S.done(cur); }
#undef PG8_SA
#undef PG8_SB
#undef PG8_STAGE
#undef PG8_LDA
#undef PG8_LDB
#undef PG8_MMA
#undef PG8_WAIT_V
#undef PG8_WAIT_L
#undef PG8_BAR
#undef PG8_SCHED
}
}

#ifndef REP_P0
#define REP_P0 1
#endif
#ifndef REP_BIG
#define REP_BIG 1
#endif
#ifndef REP_SMALL
#define REP_SMALL 1
#endif
#ifndef REP_P2
#define REP_P2 1
#endif
#ifndef REP_P3
#define REP_P3 1
#endif
#define LAS __attribute__((address_space(3)))
typedef unsigned short bf16;
typedef float f32x4 __attribute__((ext_vector_type(4)));
typedef float f32x2 __attribute__((ext_vector_type(2)));
typedef unsigned u32x4 __attribute__((ext_vector_type(4)));
typedef unsigned u32x2 __attribute__((ext_vector_type(2)));
typedef short bf16x8 __attribute__((ext_vector_type(8)));
typedef short s16x4 __attribute__((ext_vector_type(4)));

constexpr int D = 1024, MP = 16384, MS = 512, M = MP + MS, SEQ = 2048, NIN = 3072, FF = 4096, CD = 512, NH = 4, HD = 128, CW = 31, NPOS = 2052;
constexpr float EPS = 1e-6f;
constexpr int NWAVES = 8, NTHREADS = 512;
constexpr int LDS_BYTES = 147456;
constexpr size_t MiB = 1u << 20;
constexpr size_t WS_CTL = 0, CTL_BYTES = 65536;
constexpr size_t WS_ROPE = 1 * MiB;
constexpr size_t WS_SSQ = 3 * MiB;
constexpr size_t WS_W = 4 * MiB, W_LAYER = 24 * MiB;
constexpr size_t W_IN = 0, W_OUT = 6 * MiB, W_UP = 8 * MiB, W_DN = 16 * MiB;
constexpr size_t WS_XN = 52 * MiB;
constexpr size_t WS_R1 = 85 * MiB;
constexpr size_t WS_H = WS_R1;
constexpr size_t ACT512 = (size_t)M * 512 * 2;
constexpr size_t WS_GLU = WS_R1, WS_Q = WS_GLU + ACT512, WS_K = WS_Q + ACT512, WS_V = WS_K + ACT512, WS_GATE = WS_V + ACT512;
constexpr size_t WS_MIX = WS_GATE + ACT512;
constexpr size_t WS_KV = WS_MIX + (size_t)M * 1024 * 2;
constexpr size_t WS_SB = WS_KV + 32 * MiB;
constexpr size_t WS_END = WS_SB + 16 * MiB;
static_assert(WS_END <= 256 * MiB, "ws map");
static_assert(WS_H + (size_t)M * FF * 2 <= WS_END, "ws map H");
constexpr size_t O_Y = 0, O_CP = (size_t)M * D, O_RP = O_CP + 2 * 8 * 30 * 512, O_CS = O_RP + 2 * 8 * 4 * 128 * 128, O_RS = O_CS + 2 * 128 * 30 * 512;

__device__ const float ROPE_INV[64] = {
1.0f, 0.865964353f, 0.749894202f, 0.649381638f, 0.562341332f, 0.486967534f, 0.421696514f, 0.365174115f, 0.316227764f, 0.273841977f, 0.237137377f, 0.2053525f, 0.177827939f, 0.153992653f, 0.133352146f, 0.115478195f, 0.100000001f, 0.0865964293f, 0.0749894232f, 0.0649381652f, 0.0562341325f, 0.0486967526f, 0.0421696492f, 0.0365174115f, 0.0316227749f, 0.0273841955f, 0.0237137377f, 0.0205352511f, 0.0177827943f, 0.0153992651f, 0.013335214f, 0.0115478197f, 0.00999999978f, 0.00865964312f, 0.00749894232f, 0.00649381615f, 0.00562341325f, 0.00486967526f, 0.00421696482f, 0.00365174119f, 0.00316227763f, 0.00273841969f, 0.00237137382f, 0.00205352507f, 0.00177827943f, 0.00153992651f, 0.00133352145f, 0.00115478202f, 0.00100000005f, 0.000865964335f, 0.000749894185f, 0.000649381604f, 0.000562341302f, 0.000486967532f, 0.000421696517f, 0.000365174114f, 0.000316227757f, 0.000273841957f, 0.00023713737f, 0.00020535251f, 0.00017782794f, 0.00015399266f, 0.00013335215f, 0.0001154782f
};

struct Args { const float* in[16]; float* out; unsigned char* ws; };

__device__ __forceinline__ float bf2f(unsigned short x) { return __uint_as_float(((unsigned)x) << 16); }
__device__ __forceinline__ float bflo(unsigned w) { return __uint_as_float(w << 16); }
__device__ __forceinline__ float bfhi(unsigned w) { return __uint_as_float(w & 0xffff0000u); }
typedef __bf16 bf16x2_t __attribute__((ext_vector_type(2)));
__device__ __forceinline__ unsigned pk_bf16(float lo, float hi) { const f32x2 v = {lo, hi}; return __builtin_bit_cast(unsigned, __builtin_convertvector(v, bf16x2_t)); }
__device__ __forceinline__ float wave_sum(float v) {
#pragma unroll
    for (int o = 1; o < 64; o <<= 1) v += __shfl_xor(v, o);
    return v;
}
__device__ __forceinline__ int ltid() { int t = threadIdx.x; asm volatile("" : "+v"(t)); return t; }
__device__ __forceinline__ float fast_rcp(float x) { return __builtin_amdgcn_rcpf(x); }
__device__ __forceinline__ float sigmoidf_(float x) { return fast_rcp(1.0f + __expf(-x)); }

struct EpiIn {
    static constexpr bool PERM = true, AFTER_DRAIN = false;
    const float* ssq; bf16 *glu, *q, *k, *v, *gate; const f32x2* rope; const float* gn_g;
    __device__ __forceinline__ void operator()(const f32x4 (&acc)[2][2][4][2], const pg8::Unit& u, int wr, int wc, int fr, int fq) const {
        const int pn = u.pn, cl = wc * 32 + fq * 8;
#pragma unroll
        for (int ai = 0; ai < 2; ++ai)
#pragma unroll
            for (int m = 0; m < 4; ++m) {
                const int row = u.pm * 256 + ai * 128 + wr * 64 + m * 16 + fr;
                const float rstd = rsqrtf(ssq[row] * (1.0f / D) + EPS);
                const f32x4 a0 = acc[ai][0][m][0] * rstd, a1 = acc[ai][0][m][1] * rstd, b0 = acc[ai][1][m][0] * rstd, b1 = acc[ai][1][m][1] * rstd;
                if (pn < 4) {
                    u32x4 w;
                    w.x = pk_bf16(a0[0] * sigmoidf_(b0[0]), a0[1] * sigmoidf_(b0[1])); w.y = pk_bf16(a0[2] * sigmoidf_(b0[2]), a0[3] * sigmoidf_(b0[3]));
                    w.z = pk_bf16(a1[0] * sigmoidf_(b1[0]), a1[1] * sigmoidf_(b1[1])); w.w = pk_bf16(a1[2] * sigmoidf_(b1[2]), a1[3] * sigmoidf_(b1[3]));
                    *(u32x4*)(glu + (size_t)row * 512 + pn * 128 + cl) = w;
                } else if (pn < 8) {
                    const int which = (pn - 4) >> 1, tp = pn & 1, head = 2 * tp + (wc >> 1), dlo = (wc & 1) * 32 + fq * 8;
                    const int prow = row < MP ? (row & (SEQ - 1)) : SEQ + ((row - MP) & 3);
                    const f32x4* rp = (const f32x4*)(rope + (size_t)prow * 64 + dlo);
                    const f32x4 c01 = rp[0], c23 = rp[1], c45 = rp[2], c67 = rp[3];
                    const float sc = which ? 0.08838834764831845f : 1.0f;
                    float o1[8], o2[8];
                    o1[0] = a0[0] * c01[0] - b0[0] * c01[1]; o2[0] = b0[0] * c01[0] + a0[0] * c01[1];
                    o1[1] = a0[1] * c01[2] - b0[1] * c01[3]; o2[1] = b0[1] * c01[2] + a0[1] * c01[3];
                    o1[2] = a0[2] * c23[0] - b0[2] * c23[1]; o2[2] = b0[2] * c23[0] + a0[2] * c23[1];
                    o1[3] = a0[3] * c23[2] - b0[3] * c23[3]; o2[3] = b0[3] * c23[2] + a0[3] * c23[3];
                    o1[4] = a1[0] * c45[0] - b1[0] * c45[1]; o2[4] = b1[0] * c45[0] + a1[0] * c45[1];
                    o1[5] = a1[1] * c45[2] - b1[1] * c45[3]; o2[5] = b1[1] * c45[2] + a1[1] * c45[3];
                    o1[6] = a1[2] * c67[0] - b1[2] * c67[1]; o2[6] = b1[2] * c67[0] + a1[2] * c67[1];
                    o1[7] = a1[3] * c67[2] - b1[3] * c67[3]; o2[7] = b1[3] * c67[2] + a1[3] * c67[3];
                    bf16* dst = (which ? k : q) + (size_t)row * 512 + head * 128 + dlo;
                    u32x4 w1, w2;
                    w1.x = pk_bf16(o1[0] * sc, o1[1] * sc); w1.y = pk_bf16(o1[2] * sc, o1[3] * sc); w1.z = pk_bf16(o1[4] * sc, o1[5] * sc); w1.w = pk_bf16(o1[6] * sc, o1[7] * sc);
                    w2.x = pk_bf16(o2[0] * sc, o2[1] * sc); w2.y = pk_bf16(o2[2] * sc, o2[3] * sc); w2.z = pk_bf16(o2[4] * sc, o2[5] * sc); w2.w = pk_bf16(o2[6] * sc, o2[7] * sc);
                    *(u32x4*)dst = w1; *(u32x4*)(dst + 64) = w2;
                } else if (pn < 10) {
                    bf16* dst = v + (size_t)row * 512 + (pn - 8) * 256 + cl;
                    u32x4 w1, w2;
                    w1.x = pk_bf16(a0[0], a0[1]); w1.y = pk_bf16(a0[2], a0[3]); w1.z = pk_bf16(a1[0], a1[1]); w1.w = pk_bf16(a1[2], a1[3]);
                    w2.x = pk_bf16(b0[0], b0[1]); w2.y = pk_bf16(b0[2], b0[3]); w2.z = pk_bf16(b1[0], b1[1]); w2.w = pk_bf16(b1[2], b1[3]);
                    *(u32x4*)dst = w1; *(u32x4*)(dst + 128) = w2;
                } else {
                    const int c0 = (pn - 10) * 256 + cl;
                    const f32x4 g0 = *(const f32x4*)(gn_g + c0), g1 = *(const f32x4*)(gn_g + c0 + 4), g2 = *(const f32x4*)(gn_g + c0 + 128), g3 = *(const f32x4*)(gn_g + c0 + 132);
                    bf16* dst = gate + (size_t)row * 512 + c0;
                    u32x4 w1, w2;
                    w1.x = pk_bf16(a0[0] * sigmoidf_(a0[0]) * g0[0], a0[1] * sigmoidf_(a0[1]) * g0[1]); w1.y = pk_bf16(a0[2] * sigmoidf_(a0[2]) * g0[2], a0[3] * sigmoidf_(a0[3]) * g0[3]);
                    w1.z = pk_bf16(a1[0] * sigmoidf_(a1[0]) * g1[0], a1[1] * sigmoidf_(a1[1]) * g1[1]); w1.w = pk_bf16(a1[2] * sigmoidf_(a1[2]) * g1[2], a1[3] * sigmoidf_(a1[3]) * g1[3]);
                    w2.x = pk_bf16(b0[0] * sigmoidf_(b0[0]) * g2[0], b0[1] * sigmoidf_(b0[1]) * g2[1]); w2.y = pk_bf16(b0[2] * sigmoidf_(b0[2]) * g2[2], b0[3] * sigmoidf_(b0[3]) * g2[3]);
                    w2.z = pk_bf16(b1[0] * sigmoidf_(b1[0]) * g3[0], b1[1] * sigmoidf_(b1[1]) * g3[1]); w2.w = pk_bf16(b1[2] * sigmoidf_(b1[2]) * g3[2], b1[3] * sigmoidf_(b1[3]) * g3[3]);
                    *(u32x4*)dst = w1; *(u32x4*)(dst + 128) = w2;
                }
            }
    }

    __device__ __forceinline__ int brow(int cg, int fb) const { return 256 * (cg >> 2) + 32 * (cg & 3) + (fb >> 1) * 128 + (fb & 1) * 16; }
    __device__ __forceinline__ void small(int row, int cg, int s4, f32x4 a, f32x4 b) const {
        const int pn = cg >> 2, cl = 32 * (cg & 3) + s4;
        const float rstd = rsqrtf(ssq[row] * (1.0f / D) + EPS);
        a = a * rstd; b = b * rstd;
        if (pn < 4) {
            u32x2 w; w.x = pk_bf16(a[0] * sigmoidf_(b[0]), a[1] * sigmoidf_(b[1])); w.y = pk_bf16(a[2] * sigmoidf_(b[2]), a[3] * sigmoidf_(b[3]));
            *(u32x2*)(glu + (size_t)row * 512 + pn * 128 + cl) = w;
        } else if (pn < 8) {
            const int which = (pn - 4) >> 1, tp = pn & 1, head = 2 * tp + (cl >> 6), dlo = cl & 63;
            const int prow = row < MP ? (row & (SEQ - 1)) : SEQ + ((row - MP) & 3);
            const f32x4* rp = (const f32x4*)(rope + (size_t)prow * 64 + dlo);
            const f32x4 c01 = rp[0], c23 = rp[1];
            const float sc = which ? 0.08838834764831845f : 1.0f;
            const float p0 = a[0] * c01[0] - b[0] * c01[1], r0 = b[0] * c01[0] + a[0] * c01[1];
            const float p1 = a[1] * c01[2] - b[1] * c01[3], r1 = b[1] * c01[2] + a[1] * c01[3];
            const float p2 = a[2] * c23[0] - b[2] * c23[1], r2 = b[2] * c23[0] + a[2] * c23[1];
            const float p3 = a[3] * c23[2] - b[3] * c23[3], r3 = b[3] * c23[2] + a[3] * c23[3];
            bf16* dst = (which ? k : q) + (size_t)row * 512 + head * 128 + dlo;
            u32x2 w1, w2; w1.x = pk_bf16(p0 * sc, p1 * sc); w1.y = pk_bf16(p2 * sc, p3 * sc); w2.x = pk_bf16(r0 * sc, r1 * sc); w2.y = pk_bf16(r2 * sc, r3 * sc);
            *(u32x2*)dst = w1; *(u32x2*)(dst + 64) = w2;
        } else if (pn < 10) {
            bf16* dst = v + (size_t)row * 512 + (pn - 8) * 256 + cl;
            u32x2 w1, w2; w1.x = pk_bf16(a[0], a[1]); w1.y = pk_bf16(a[2], a[3]); w2.x = pk_bf16(b[0], b[1]); w2.y = pk_bf16(b[2], b[3]);
            *(u32x2*)dst = w1; *(u32x2*)(dst + 128) = w2;
        } else {
            const int c0 = (pn - 10) * 256 + cl;
            const f32x4 g0 = *(const f32x4*)(gn_g + c0), g2 = *(const f32x4*)(gn_g + c0 + 128);
            bf16* dst = gate + (size_t)row * 512 + c0;
            u32x2 w1, w2;
            w1.x = pk_bf16(a[0] * sigmoidf_(a[0]) * g0[0], a[1] * sigmoidf_(a[1]) * g0[1]); w1.y = pk_bf16(a[2] * sigmoidf_(a[2]) * g0[2], a[3] * sigmoidf_(a[3]) * g0[3]);
            w2.x = pk_bf16(b[0] * sigmoidf_(b[0]) * g2[0], b[1] * sigmoidf_(b[1]) * g2[1]); w2.y = pk_bf16(b[2] * sigmoidf_(b[2]) * g2[2], b[3] * sigmoidf_(b[3]) * g2[3]);
            *(u32x2*)dst = w1; *(u32x2*)(dst + 128) = w2;
        }
    }
};

struct EpiRes {
    static constexpr bool PERM = true, AFTER_DRAIN = false;
    bf16* xs; float* ssq;
    __device__ __forceinline__ void operator()(const f32x4 (&acc)[2][2][4][2], const pg8::Unit& u, int wr, int wc, int fr, int fq) const {
        const int colb = u.pn * 256 + wc * 32 + fq * 8;
#pragma unroll
        for (int ai = 0; ai < 2; ++ai)
#pragma unroll
            for (int m = 0; m < 4; ++m) {
                const int row = u.pm * 256 + ai * 128 + wr * 64 + m * 16 + fr;
                float ss = 0.f;
#pragma unroll
                for (int bj = 0; bj < 2; ++bj) {
                    bf16* p = xs + (size_t)row * D + colb + bj * 128;
                    const u32x4 rv = *(const u32x4*)p;
                    const f32x4 a0 = acc[ai][bj][m][0], a1 = acc[ai][bj][m][1];
                    const float x0 = bflo(rv.x) + a0[0], x1 = bfhi(rv.x) + a0[1], x2 = bflo(rv.y) + a0[2], x3 = bfhi(rv.y) + a0[3];
                    const float x4 = bflo(rv.z) + a1[0], x5 = bfhi(rv.z) + a1[1], x6 = bflo(rv.w) + a1[2], x7 = bfhi(rv.w) + a1[3];
                    ss += (x0 * x0 + x1 * x1) + (x2 * x2 + x3 * x3) + (x4 * x4 + x5 * x5) + (x6 * x6 + x7 * x7);
                    u32x4 w; w.x = pk_bf16(x0, x1); w.y = pk_bf16(x2, x3); w.z = pk_bf16(x4, x5); w.w = pk_bf16(x6, x7);
                    *(u32x4*)p = w;
                }
                ss += __shfl_xor(ss, 16); ss += __shfl_xor(ss, 32);
                if (fq == 0) unsafeAtomicAdd(ssq + row, ss);
            }
    }
    __device__ __forceinline__ int brow(int cg, int fb) const { return 64 * cg + 16 * fb; }
    __device__ __forceinline__ void small(int row, int cg, int s4, f32x4 a, f32x4 b) const {
        bf16* p = xs + (size_t)row * D + 64 * cg + s4;
        const u32x2 r0 = *(const u32x2*)p, r1 = *(const u32x2*)(p + 32);
        const float x0 = bflo(r0.x) + a[0], x1 = bfhi(r0.x) + a[1], x2 = bflo(r0.y) + a[2], x3 = bfhi(r0.y) + a[3];
        const float x4 = bflo(r1.x) + b[0], x5 = bfhi(r1.x) + b[1], x6 = bflo(r1.y) + b[2], x7 = bfhi(r1.y) + b[3];
        float ss = (x0 * x0 + x1 * x1) + (x2 * x2 + x3 * x3) + (x4 * x4 + x5 * x5) + (x6 * x6 + x7 * x7);
        u32x2 w0, w1; w0.x = pk_bf16(x0, x1); w0.y = pk_bf16(x2, x3); w1.x = pk_bf16(x4, x5); w1.y = pk_bf16(x6, x7);
        *(u32x2*)p = w0; *(u32x2*)(p + 32) = w1;
        ss += __shfl_xor(ss, 1); ss += __shfl_xor(ss, 2); ss += __shfl_xor(ss, 4);
        if ((s4 >> 2) == 0) unsafeAtomicAdd(ssq + row, ss);
    }
};

struct EpiUp {
    static constexpr bool PERM = true, AFTER_DRAIN = false;
    const float* ssq; bf16* h;
    __device__ __forceinline__ void operator()(const f32x4 (&acc)[2][2][4][2], const pg8::Unit& u, int wr, int wc, int fr, int fq) const {
        const int colb = u.pn * 256 + wc * 32 + fq * 8;
#pragma unroll
        for (int ai = 0; ai < 2; ++ai)
#pragma unroll
            for (int m = 0; m < 4; ++m) {
                const int row = u.pm * 256 + ai * 128 + wr * 64 + m * 16 + fr;
                const float rstd = rsqrtf(ssq[row] * (1.0f / D) + EPS);
#pragma unroll
                for (int bj = 0; bj < 2; ++bj) {
                    f32x4 x0 = acc[ai][bj][m][0] * rstd, x1 = acc[ai][bj][m][1] * rstd;
#pragma unroll
                    for (int e = 0; e < 4; ++e) { const float t0 = fmaxf(x0[e], 0.f), t1 = fmaxf(x1[e], 0.f); x0[e] = t0 * t0; x1[e] = t1 * t1; }
                    u32x4 w; w.x = pk_bf16(x0[0], x0[1]); w.y = pk_bf16(x0[2], x0[3]); w.z = pk_bf16(x1[0], x1[1]); w.w = pk_bf16(x1[2], x1[3]);
                    *(u32x4*)(h + (size_t)row * FF + colb + bj * 128) = w;
                }
            }
    }

    __device__ __forceinline__ int brow(int cg, int fb) const { return 64 * cg + 16 * fb; }
    __device__ __forceinline__ void small(int row, int cg, int s4, f32x4 a, f32x4 b) const {
        const float rstd = rsqrtf(ssq[row] * (1.0f / D) + EPS);
        const int col = 64 * cg + s4;
#pragma unroll
        for (int e = 0; e < 4; ++e) { const float t0 = fmaxf(a[e] * rstd, 0.f), t1 = fmaxf(b[e] * rstd, 0.f); a[e] = t0 * t0; b[e] = t1 * t1; }
        u32x2 w0, w1; w0.x = pk_bf16(a[0], a[1]); w0.y = pk_bf16(a[2], a[3]); w1.x = pk_bf16(b[0], b[1]); w1.y = pk_bf16(b[2], b[3]);
        *(u32x2*)(h + (size_t)row * FF + col) = w0; *(u32x2*)(h + (size_t)row * FF + col + 32) = w1;
    }
};

constexpr int SG_LD = 68;
template <class Epi, int RT>
__device__ __forceinline__ void small_gemm(LAS unsigned char* lds, const bf16* A, const bf16* Bt, int K, int ncg, const Epi& E) {
    const int tid = ltid(), lane = tid & 63, wave = __builtin_amdgcn_readfirstlane(tid >> 6), r = lane & 15, q = lane >> 4;
    constexpr int KS = RT == 2 ? 4 : 8;
    const int kw = K / KS, kq = RT == 2 ? (wave & 3) : wave, rh = RT == 2 ? (wave >> 2) : 0;
    for (int it = blockIdx.x; it < (8 / RT) * ncg; it += gridDim.x) {
        const int rt = it / ncg, cg = it % ncg;
        const int rowbase = MP + 64 * RT * rt;
        const bf16* ap = A + (size_t)(rowbase + 64 * rh + r) * K + kq * kw + 8 * q;
        const bf16* bp0 = Bt + (size_t)(E.brow(cg, 0) + r) * K + kq * kw + 8 * q;
        const bf16* bp1 = Bt + (size_t)(E.brow(cg, 1) + r) * K + kq * kw + 8 * q;
        const bf16* bp2 = Bt + (size_t)(E.brow(cg, 2) + r) * K + kq * kw + 8 * q;
        const bf16* bp3 = Bt + (size_t)(E.brow(cg, 3) + r) * K + kq * kw + 8 * q;
        f32x4 acc[4][4];
#pragma unroll
        for (int i = 0; i < 4; ++i)
#pragma unroll
            for (int j = 0; j < 4; ++j) acc[i][j] = (f32x4){0.f, 0.f, 0.f, 0.f};
        {
            LAS unsigned char* st = lds + wave * 9216;
            const int lrow = lane >> 3, lch = lane & 7;
            const bf16* ag = A + (size_t)(rowbase + 64 * rh + lrow) * K + kq * kw + lch * 8;
            const bf16* bg0 = Bt + (size_t)(E.brow(cg, 0) + lrow) * K + kq * kw + lch * 8;
            const bf16* bg1 = Bt + (size_t)(E.brow(cg, 1) + lrow) * K + kq * kw + lch * 8;
            const bf16* bg2 = Bt + (size_t)(E.brow(cg, 2) + lrow) * K + kq * kw + lch * 8;
            const bf16* bg3 = Bt + (size_t)(E.brow(cg, 3) + lrow) * K + kq * kw + lch * 8;
            const int wro = lrow * 144 + lch * 16, fro = r * 144 + q * 16;
            u32x4 ga[8], gb[8];
#define SG_GLOAD_A(kk) do { _Pragma("unroll") for (int i = 0; i < 8; ++i) ga[i] = *(const u32x4*)(ag + (size_t)(8 * i) * K + (kk)); } while (0)
#define SG_GLOAD_B(kk) do { \
            gb[0] = *(const u32x4*)(bg0 + (kk)); gb[1] = *(const u32x4*)(bg0 + (size_t)8 * K + (kk)); gb[2] = *(const u32x4*)(bg1 + (kk)); gb[3] = *(const u32x4*)(bg1 + (size_t)8 * K + (kk)); \
            gb[4] = *(const u32x4*)(bg2 + (kk)); gb[5] = *(const u32x4*)(bg2 + (size_t)8 * K + (kk)); gb[6] = *(const u32x4*)(bg3 + (kk)); gb[7] = *(const u32x4*)(bg3 + (size_t)8 * K + (kk)); } while (0)
            SG_GLOAD_A(0); SG_GLOAD_B(0);
#pragma unroll 1
            for (int kk = 0; kk < kw; kk += 64) {
                bf16x8 a[2][4], b[2][4];
#pragma unroll
                for (int i = 0; i < 8; ++i) *(LAS u32x4*)(st + i * (8 * 144) + wro) = ga[i];
                if (kk + 64 < kw) SG_GLOAD_A(kk + 64);
#pragma unroll
                for (int ks = 0; ks < 2; ++ks)
#pragma unroll
                    for (int fa = 0; fa < 4; ++fa) a[ks][fa] = *(const LAS bf16x8*)(st + fa * (16 * 144) + fro + ks * 64);
                asm volatile("s_waitcnt lgkmcnt(0)" ::: "memory");
#pragma unroll
                for (int i = 0; i < 8; ++i) *(LAS u32x4*)(st + i * (8 * 144) + wro) = gb[i];
                if (kk + 64 < kw) SG_GLOAD_B(kk + 64);
#pragma unroll
                for (int ks = 0; ks < 2; ++ks)
#pragma unroll
                    for (int fb = 0; fb < 4; ++fb) b[ks][fb] = *(const LAS bf16x8*)(st + fb * (16 * 144) + fro + ks * 64);
                asm volatile("s_waitcnt lgkmcnt(0)" ::: "memory");
#pragma unroll
                for (int ks = 0; ks < 2; ++ks)
#pragma unroll
                    for (int fa = 0; fa < 4; ++fa)
#pragma unroll
                        for (int fb = 0; fb < 4; ++fb) acc[fa][fb] = __builtin_amdgcn_mfma_f32_16x16x32_bf16(b[ks][fb], a[ks][fa], acc[fa][fb], 0, 0, 0);
            }
#undef SG_GLOAD_A
#undef SG_GLOAD_B
        }
        __syncthreads();
        LAS float* part = (LAS float*)lds + wave * (64 * SG_LD);
#pragma unroll
        for (int fa = 0; fa < 4; ++fa)
#pragma unroll
            for (int fb = 0; fb < 4; ++fb) *(LAS f32x4*)(part + (16 * fa + r) * SG_LD + 16 * fb + 4 * q) = acc[fa][fb];
        __syncthreads();
        if (RT == 1) {
            const int row = tid >> 3, s4 = (tid & 7) * 4;
            f32x4 va = (f32x4){0.f, 0.f, 0.f, 0.f}, vb = va;
#pragma unroll
            for (int w = 0; w < 8; ++w) { const LAS float* p = (const LAS float*)lds + w * (64 * SG_LD) + row * SG_LD + s4; va += *(const LAS f32x4*)p; vb += *(const LAS f32x4*)(p + 32); }
            E.small(rowbase + row, cg, s4, va, vb);
        } else {
            const int row = tid >> 2, rr = row & 63, hh = row >> 6;
#pragma unroll
            for (int j = 0; j < 2; ++j) {
                const int s4 = (tid & 3) * 4 + 16 * j;
                f32x4 va = (f32x4){0.f, 0.f, 0.f, 0.f}, vb = va;
#pragma unroll
                for (int w = 0; w < 4; ++w) { const LAS float* p = (const LAS float*)lds + (hh * 4 + w) * (64 * SG_LD) + rr * SG_LD + s4; va += *(const LAS f32x4*)p; vb += *(const LAS f32x4*)(p + 32); }
                E.small(rowbase + row, cg, s4, va, vb);
            }
        }
        __syncthreads();
    }
}

__device__ __forceinline__ void small_gemm32(LAS unsigned char* lds, const bf16* A, const bf16* Bt, int K, const EpiRes& E) {
    const int tid = ltid(), lane = tid & 63, wave = __builtin_amdgcn_readfirstlane(tid >> 6), r = lane & 15, q = lane >> 4;
    const int kw = K >> 3;
    for (int it = blockIdx.x; it < 256; it += gridDim.x) {
        const int rt = it >> 5, cg = it & 31;
        const int rowbase = MP + 64 * rt;
        f32x4 acc[4][2];
#pragma unroll
        for (int i = 0; i < 4; ++i) { acc[i][0] = (f32x4){0.f, 0.f, 0.f, 0.f}; acc[i][1] = (f32x4){0.f, 0.f, 0.f, 0.f}; }
        {
            LAS unsigned char* st = lds + wave * 9216;
            const int lrow = lane >> 3, lch = lane & 7;
            const bf16* ag = A + (size_t)(rowbase + lrow) * K + wave * kw + lch * 8;
            const bf16* bg = Bt + (size_t)(32 * cg + lrow) * K + wave * kw + lch * 8;
            const int wro = lrow * 144 + lch * 16, fro = r * 144 + q * 16;
            u32x4 ga0[8], gb0[4], ga1[8], gb1[4];
#define SG_GLOAD(ga, gb, kk) do { _Pragma("unroll") for (int i = 0; i < 8; ++i) ga[i] = *(const u32x4*)(ag + (size_t)(8 * i) * K + (kk)); \
            _Pragma("unroll") for (int i = 0; i < 4; ++i) gb[i] = *(const u32x4*)(bg + (size_t)(8 * i) * K + (kk)); } while (0)
#define SG_STEP(ga, gb, knext) do { bf16x8 a[2][4], b[2][2]; \
            _Pragma("unroll") for (int i = 0; i < 8; ++i) *(LAS u32x4*)(st + i * (8 * 144) + wro) = ga[i]; \
            _Pragma("unroll") for (int ks = 0; ks < 2; ++ks) _Pragma("unroll") for (int fa = 0; fa < 4; ++fa) a[ks][fa] = *(const LAS bf16x8*)(st + fa * (16 * 144) + fro + ks * 64); \
            asm volatile("s_waitcnt lgkmcnt(0)" ::: "memory"); \
            _Pragma("unroll") for (int i = 0; i < 4; ++i) *(LAS u32x4*)(st + i * (8 * 144) + wro) = gb[i]; \
            _Pragma("unroll") for (int ks = 0; ks < 2; ++ks) _Pragma("unroll") for (int fb = 0; fb < 2; ++fb) b[ks][fb] = *(const LAS bf16x8*)(st + fb * (16 * 144) + fro + ks * 64); \
            asm volatile("s_waitcnt lgkmcnt(0)" ::: "memory"); \
            if ((knext) < kw) SG_GLOAD(ga, gb, (knext)); \
            _Pragma("unroll") for (int ks = 0; ks < 2; ++ks) _Pragma("unroll") for (int fa = 0; fa < 4; ++fa) _Pragma("unroll") for (int fb = 0; fb < 2; ++fb) \
                acc[fa][fb] = __builtin_amdgcn_mfma_f32_16x16x32_bf16(b[ks][fb], a[ks][fa], acc[fa][fb], 0, 0, 0); } while (0)
            SG_GLOAD(ga0, gb0, 0); SG_GLOAD(ga1, gb1, 64);
#pragma unroll 1
            for (int kk = 0; kk < kw; kk += 128) {
                SG_STEP(ga0, gb0, kk + 128);
                SG_STEP(ga1, gb1, kk + 192);
            }
#undef SG_GLOAD
#undef SG_STEP
        }
        __syncthreads();
        LAS float* part = (LAS float*)lds + wave * (64 * 36);
#pragma unroll
        for (int fa = 0; fa < 4; ++fa)
#pragma unroll
            for (int fb = 0; fb < 2; ++fb) *(LAS f32x4*)(part + (16 * fa + r) * 36 + 16 * fb + 4 * q) = acc[fa][fb];
        __syncthreads();
        const int row = tid >> 3, s4 = (tid & 7) * 4;
        f32x4 va = (f32x4){0.f, 0.f, 0.f, 0.f};
#pragma unroll
        for (int w = 0; w < 8; ++w) va += *(const LAS f32x4*)((const LAS float*)lds + w * (64 * 36) + row * 36 + s4);
        {
            const int grow = rowbase + row;
            bf16* p = E.xs + (size_t)grow * D + 32 * cg + s4;
            const u32x2 r0 = *(const u32x2*)p;
            const float x0 = bflo(r0.x) + va[0], x1 = bfhi(r0.x) + va[1], x2 = bflo(r0.y) + va[2], x3 = bfhi(r0.y) + va[3];
            float ss = (x0 * x0 + x1 * x1) + (x2 * x2 + x3 * x3);
            u32x2 w0; w0.x = pk_bf16(x0, x1); w0.y = pk_bf16(x2, x3);
            *(u32x2*)p = w0;
            ss += __shfl_xor(ss, 1); ss += __shfl_xor(ss, 2); ss += __shfl_xor(ss, 4);
            if ((tid & 7) == 0) unsafeAtomicAdd(E.ssq + grow, ss);
        }
        __syncthreads();
    }
}

__device__ __forceinline__ int win_dest_row(int s) {
    if (s < 512) return ((s >> 7) << 8) + (s & 127);
    if (s < 1024) { const int t = s - 512; return ((t >> 7) << 8) + 128 + (t & 127); }
    if (s < 2048) { const int t = s - 1024; const int which = t >> 9, hd = (t >> 7) & 3, d = t & 127; return 1024 + which * 512 + (hd >> 1) * 256 + (d >> 6) * 128 + (hd & 1) * 64 + (d & 63); }
    return s;
}
__device__ __forceinline__ void p0_transpose_item(const float* W, const float* gk, int K, int N, bf16* WT, bool perm, LAS float* scr, int item, int lane) {
    const int nblk = N / 32, kb = item / nblk, nb = item % nblk, k0 = 64 * kb, n0 = 32 * nb;
#pragma unroll
    for (int i = 0; i < 32; ++i) { const int kk = 2 * i + (lane >> 5); const float gg = gk ? gk[k0 + kk] : 1.0f; scr[kk * 33 + (lane & 31)] = gg * __builtin_nontemporal_load(W + (size_t)(k0 + kk) * N + n0 + (lane & 31)); }
    asm volatile("s_waitcnt lgkmcnt(0)" ::: "memory");
    const int c = lane & 7;
    const int drow0 = perm ? win_dest_row(n0) : n0;
#pragma unroll
    for (int j = 0; j < 4; ++j) { const int n = (lane >> 3) + 8 * j; const LAS float* s = scr + (8 * c) * 33 + n;
        u32x4 o; o.x = pk_bf16(s[0 * 33], s[1 * 33]); o.y = pk_bf16(s[2 * 33], s[3 * 33]); o.z = pk_bf16(s[4 * 33], s[5 * 33]); o.w = pk_bf16(s[6 * 33], s[7 * 33]);
        *(u32x4*)(WT + (size_t)(drow0 + n) * K + k0 + 8 * c) = o; }
    asm volatile("s_waitcnt lgkmcnt(0)" ::: "memory");
}
__device__ __forceinline__ void sincos_acc(float ang, float& c, float& s) {
    const double a = (double)ang;
    const double kd = __builtin_rint(a * 0.63661977236758134308);
    double r = __builtin_fma(-kd, 1.57079632679489655800, a);
    r = __builtin_fma(-kd, 6.12323399573676603587e-17, r);
    const int n = ((int)kd) & 3;
    const double r2 = r * r;
    double sp = -1.0 / 1307674368000.0;
    sp = sp * r2 + 1.0 / 6227020800.0; sp = sp * r2 - 1.0 / 39916800.0; sp = sp * r2 + 1.0 / 362880.0; sp = sp * r2 - 1.0 / 5040.0; sp = sp * r2 + 1.0 / 120.0; sp = sp * r2 - 1.0 / 6.0; sp = sp * r2 + 1.0;
    const double sn = r * sp;
    double cp = 1.0 / 20922789888000.0;
    cp = cp * r2 - 1.0 / 87178291200.0; cp = cp * r2 + 1.0 / 479001600.0; cp = cp * r2 - 1.0 / 3628800.0; cp = cp * r2 + 1.0 / 40320.0; cp = cp * r2 - 1.0 / 720.0; cp = cp * r2 + 1.0 / 24.0; cp = cp * r2 - 0.5; cp = cp * r2 + 1.0;
    const double cs = cp;
    double so, co;
    if (n == 0) { so = sn; co = cs; } else if (n == 1) { so = cs; co = -sn; } else if (n == 2) { so = -sn; co = -cs; } else { so = -cs; co = sn; }
    c = (float)co; s = (float)so;
}

__device__ __forceinline__ void p0_prologue(const Args& a, LAS unsigned char* lds, int wave, int lane) {
    unsigned char* ws = a.ws;
    const int G = gridDim.x, gw = blockIdx.x * NWAVES + wave, NGW = G * NWAVES;
    const int gt = blockIdx.x * NTHREADS + threadIdx.x, NGT = G * NTHREADS;
    float* ssq = (float*)(ws + WS_SSQ);
    for (int i = gt; i < 4 * M; i += NGT) ssq[M + i] = 0.f;
    f32x2* rope = (f32x2*)(ws + WS_ROPE);
    for (int i = gt; i < NPOS * 64; i += NGT) {
        const int p = i >> 6, dd = i & 63;
        const float pos = p < SEQ ? (float)p : (float)(16384 + (p - SEQ));
        const float ang = pos * ROPE_INV[dd];
        float c, s; sincos_acc(ang, c, s);
        rope[i] = (f32x2){c, s};
    }
    LAS float* scr = (LAS float*)(lds + wave * 16384);
    constexpr int I_IN = (D / 64) * (NIN / 32), I_O = (D / 64) * (D / 32), I_UP = (D / 64) * (FF / 32), I_DN = (FF / 64) * (D / 32), I_L = I_IN + I_O + I_UP + I_DN;
    for (int it = gw; it < 2 * I_L; it += NGW) {
        const int l = it / I_L; int r = it % I_L;
        unsigned char* wl = ws + WS_W + (size_t)l * W_LAYER;
        if (r < I_IN) { p0_transpose_item(a.in[5] + (size_t)l * D * NIN, a.in[4] + l * D, D, NIN, (bf16*)(wl + W_IN), true, scr, r, lane); continue; } r -= I_IN;
        if (r < I_O) { p0_transpose_item(a.in[11] + (size_t)l * D * D, nullptr, D, D, (bf16*)(wl + W_OUT), false, scr, r, lane); continue; } r -= I_O;
        if (r < I_UP) { p0_transpose_item(a.in[13] + (size_t)l * D * FF, a.in[12] + l * D, D, FF, (bf16*)(wl + W_UP), false, scr, r, lane); continue; } r -= I_UP;
        p0_transpose_item(a.in[14] + (size_t)l * FF * D, nullptr, FF, D, (bf16*)(wl + W_DN), false, scr, r, lane);
    }
    bf16* XN = (bf16*)(ws + WS_XN);
    for (int m = gw; m < M; m += 2 * NGW) {
        const int m2 = m + NGW; const bool has2 = m2 < M; const int mb = has2 ? m2 : m;
        const float* xa = m < MP ? a.in[0] + (size_t)m * D : a.in[1] + (size_t)(m - MP) * D;
        const float* xb = mb < MP ? a.in[0] + (size_t)mb * D : a.in[1] + (size_t)(mb - MP) * D;
        f32x4 va[4], vb[4];
#pragma unroll
        for (int j = 0; j < 4; ++j) { va[j] = __builtin_nontemporal_load((const f32x4*)(xa + 4 * lane + 256 * j)); vb[j] = __builtin_nontemporal_load((const f32x4*)(xb + 4 * lane + 256 * j)); }
        float sa = 0.f, sb = 0.f;
#pragma unroll
        for (int j = 0; j < 4; ++j) {
            sa += (va[j][0] * va[j][0] + va[j][1] * va[j][1]) + (va[j][2] * va[j][2] + va[j][3] * va[j][3]);
            sb += (vb[j][0] * vb[j][0] + vb[j][1] * vb[j][1]) + (vb[j][2] * vb[j][2] + vb[j][3] * vb[j][3]);
            u32x2 w; w.x = pk_bf16(va[j][0], va[j][1]); w.y = pk_bf16(va[j][2], va[j][3]);
            *(u32x2*)(XN + (size_t)m * D + 4 * lane + 256 * j) = w;
            if (has2) { u32x2 w2; w2.x = pk_bf16(vb[j][0], vb[j][1]); w2.y = pk_bf16(vb[j][2], vb[j][3]); *(u32x2*)(XN + (size_t)mb * D + 4 * lane + 256 * j) = w2; }
        }
        sa = wave_sum(sa); sb = wave_sum(sb);
        if (lane == 0) { ssq[m] = sa; if (has2) ssq[mb] = sb; }
    }
}

template <int NT, bool SAMPLE>
__device__ __forceinline__ void conv_item(LAS unsigned char* lds, int b, int tt, const bf16* glu, const float* cache, const float* cw, const float* cb, const float* lng, const float* lnb,
                                          bf16* mix, float* out_conv, int wave, int lane) {
    const int c = ltid(); lane = c & 63; wave = __builtin_amdgcn_readfirstlane(c >> 6);
    constexpr int NI = NT + 30;
    float in[NI];
    const int t0 = tt * NT;
    if (SAMPLE) {
#pragma unroll
        for (int j = 0; j < 30; ++j) in[j] = __builtin_nontemporal_load(cache + ((size_t)b * 30 + j) * 512 + c);
#pragma unroll
        for (int j = 0; j < NT; ++j) in[30 + j] = bf2f(glu[((size_t)MP + 4 * b + j) * 512 + c]);
    } else {
#pragma unroll
        for (int j = 0; j < NI; ++j) { const int t = t0 - 30 + j; in[j] = t >= 0 ? bf2f(glu[((size_t)b * SEQ + t) * 512 + c]) : 0.f; }
    }
    float w[CW];
#pragma unroll
    for (int k = 0; k < CW; ++k) w[k] = cw[k * 512 + c];
    const float bias = cb[c];
    LAS float* co = (LAS float*)lds;
#pragma unroll
    for (int t = 0; t < NT; ++t) {
        float acc = bias;
#pragma unroll
        for (int k = 0; k < CW; ++k) acc += w[k] * in[t + k];
        co[t * 512 + c] = acc;
    }
    if (SAMPLE) {
#pragma unroll
        for (int jj = 0; jj < 30; ++jj) __builtin_nontemporal_store(in[jj + NT], out_conv + ((size_t)b * 30 + jj) * 512 + c);
    } else if (tt == SEQ / NT - 1) {
#pragma unroll
        for (int jj = 0; jj < 30; ++jj) __builtin_nontemporal_store(in[jj + NT], out_conv + ((size_t)b * 30 + jj) * 512 + c);
    }
    __syncthreads();
    for (int t = wave; t < NT; t += NWAVES) {
        const size_t row = SAMPLE ? (size_t)MP + 4 * b + t : (size_t)b * SEQ + t0 + t;
        f32x4 v0 = *(const LAS f32x4*)(co + t * 512 + lane * 8), v1 = *(const LAS f32x4*)(co + t * 512 + lane * 8 + 4);
        float s = (v0[0] + v0[1]) + (v0[2] + v0[3]) + (v1[0] + v1[1]) + (v1[2] + v1[3]);
        s = wave_sum(s);
        const float mean = s * (1.0f / 512.0f);
        v0 = v0 - mean; v1 = v1 - mean;
        float q = (v0[0] * v0[0] + v0[1] * v0[1]) + (v0[2] * v0[2] + v0[3] * v0[3]) + (v1[0] * v1[0] + v1[1] * v1[1]) + (v1[2] * v1[2] + v1[3] * v1[3]);
        q = wave_sum(q);
        const float rstd = rsqrtf(q * (1.0f / 512.0f) + EPS);
        const f32x4 g0 = *(const f32x4*)(lng + lane * 8), g1 = *(const f32x4*)(lng + lane * 8 + 4), b0 = *(const f32x4*)(lnb + lane * 8), b1 = *(const f32x4*)(lnb + lane * 8 + 4);
        f32x4 y0 = v0 * rstd * g0 + b0, y1 = v1 * rstd * g1 + b1;
#pragma unroll
        for (int e = 0; e < 4; ++e) { y0[e] = y0[e] * sigmoidf_(y0[e]); y1[e] = y1[e] * sigmoidf_(y1[e]); }
        u32x4 o; o.x = pk_bf16(y0[0], y0[1]); o.y = pk_bf16(y0[2], y0[3]); o.z = pk_bf16(y1[0], y1[1]); o.w = pk_bf16(y1[2], y1[3]);
        *(u32x4*)(mix + row * D + lane * 8) = o;
    }
    __syncthreads();
}

__device__ __forceinline__ void conv_pair(LAS unsigned char* lds, int pr, const bf16* glu, const float* cw, const float* cb, const float* lng, const float* lnb, bf16* mix, float* out_conv) {
    const int tid = ltid(), lane = tid & 63, half = __builtin_amdgcn_readfirstlane(tid >> 8), wl = __builtin_amdgcn_readfirstlane((tid >> 6) & 3), t = tid & 255;
    const int itc = pr * 2 + half, b = itc >> 6, tt = itc & 63, t0 = tt * 32;
    constexpr int NT = 32, NI = NT + 30;
    f32x2 in2[NI];
#pragma unroll
    for (int j = 0; j < NI; ++j) {
        const int tk = t0 - 30 + j;
        unsigned w = 0u;
        if (tk >= 0) w = *(const unsigned*)(glu + ((size_t)b * SEQ + tk) * 512 + 2 * t);
        in2[j] = (f32x2){bflo(w), bfhi(w)};
    }
    f32x2 w2[CW];
#pragma unroll
    for (int k = 0; k < CW; ++k) w2[k] = *(const f32x2*)(cw + k * 512 + 2 * t);
    const f32x2 bias2 = *(const f32x2*)(cb + 2 * t);
    LAS float* co = (LAS float*)(lds + half * 65536);
#pragma unroll
    for (int u = 0; u < NT; ++u) {
        f32x2 acc = bias2;
#pragma unroll
        for (int k = 0; k < CW; ++k) acc = w2[k] * in2[u + k] + acc;
        *(LAS f32x2*)(co + u * 512 + 2 * t) = acc;
    }
    if (tt == SEQ / NT - 1) {
#pragma unroll
        for (int jj = 0; jj < 30; ++jj) __builtin_nontemporal_store(in2[jj + NT], (f32x2*)(out_conv + ((size_t)b * 30 + jj) * 512 + 2 * t));
    }
    const f32x4 g0 = *(const f32x4*)(lng + lane * 8), g1 = *(const f32x4*)(lng + lane * 8 + 4), b0 = *(const f32x4*)(lnb + lane * 8), b1 = *(const f32x4*)(lnb + lane * 8 + 4);
    __syncthreads();
    for (int u = wl; u < NT; u += 4) {
        const size_t row = (size_t)b * SEQ + t0 + u;
        f32x4 v0 = *(const LAS f32x4*)(co + u * 512 + lane * 8), v1 = *(const LAS f32x4*)(co + u * 512 + lane * 8 + 4);
        float sm = (v0[0] + v0[1]) + (v0[2] + v0[3]) + (v1[0] + v1[1]) + (v1[2] + v1[3]);
        sm = wave_sum(sm);
        const float mean = sm * (1.0f / 512.0f);
        v0 = v0 - mean; v1 = v1 - mean;
        float qv = (v0[0] * v0[0] + v0[1] * v0[1]) + (v0[2] * v0[2] + v0[3] * v0[3]) + (v1[0] * v1[0] + v1[1] * v1[1]) + (v1[2] * v1[2] + v1[3] * v1[3]);
        qv = wave_sum(qv);
        const float rstd = rsqrtf(qv * (1.0f / 512.0f) + EPS);
        f32x4 y0 = v0 * rstd * g0 + b0, y1 = v1 * rstd * g1 + b1;
#pragma unroll
        for (int e = 0; e < 4; ++e) { y0[e] = y0[e] * sigmoidf_(y0[e]); y1[e] = y1[e] * sigmoidf_(y1[e]); }
        u32x4 o; o.x = pk_bf16(y0[0], y0[1]); o.y = pk_bf16(y0[2], y0[3]); o.z = pk_bf16(y1[0], y1[1]); o.w = pk_bf16(y1[2], y1[3]);
        *(u32x4*)(mix + row * D + lane * 8) = o;
    }
    __syncthreads();
}

constexpr int TS = 272;
__device__ __forceinline__ bf16x8 tr_frag(LAS unsigned char* tile, int rowA, int rowB, int col0, int lane) {
    const int i = lane & 15, qq = i >> 2, p = i & 3;
    const s16x4 lo = __builtin_amdgcn_ds_read_tr16_b64_v4i16((LAS s16x4*)(tile + (rowA + qq) * TS + (col0 + 4 * p) * 2));
    const s16x4 hi = __builtin_amdgcn_ds_read_tr16_b64_v4i16((LAS s16x4*)(tile + (rowB + qq) * TS + (col0 + 4 * p) * 2));
    bf16x8 r; r[0] = lo[0]; r[1] = lo[1]; r[2] = lo[2]; r[3] = lo[3]; r[4] = hi[0]; r[5] = hi[1]; r[6] = hi[2]; r[7] = hi[3];
    return r;
}
__device__ __forceinline__ u32x4 scale_bf16x8(u32x4 v, float s) {
    u32x4 o; o.x = pk_bf16(bflo(v.x) * s, bfhi(v.x) * s); o.y = pk_bf16(bflo(v.y) * s, bfhi(v.y) * s); o.z = pk_bf16(bflo(v.z) * s, bfhi(v.z) * s); o.w = pk_bf16(bflo(v.w) * s, bfhi(v.w) * s);
    return o;
}
__device__ __forceinline__ void kvloc_item(LAS unsigned char* lds, int b, int h, int c, const bf16* K, const bf16* V, float* kvbuf, float lg2, int wave, int lane) {
    LAS unsigned char* Kt = lds; LAS unsigned char* Vt = lds + 128 * TS;
    const int tid = ltid(); lane = tid & 63; wave = __builtin_amdgcn_readfirstlane(tid >> 6); const size_t r0 = (size_t)b * SEQ + c * 128;
#pragma unroll
    for (int i = 0; i < 4; ++i) {
        const int chunk = tid + 512 * i, j = chunk >> 4, cc = chunk & 15;
        u32x4 kv = *(const u32x4*)(K + (r0 + j) * 512 + h * 128 + cc * 8);
        const u32x4 vv = *(const u32x4*)(V + (r0 + j) * 512 + h * 128 + cc * 8);
        kv = scale_bf16x8(kv, exp2f(lg2 * (float)(127 - j)));
        *(LAS u32x4*)(Kt + j * TS + cc * 16) = kv; *(LAS u32x4*)(Vt + j * TS + cc * 16) = vv;
    }
    __syncthreads();
    const int r = lane & 15, q = lane >> 4;
    f32x4 acc[8];
#pragma unroll
    for (int vf = 0; vf < 8; ++vf) acc[vf] = (f32x4){0.f, 0.f, 0.f, 0.f};
#pragma unroll
    for (int ks = 0; ks < 4; ++ks) {
        const bf16x8 bfrag = tr_frag(Kt, 32 * ks + 8 * q, 32 * ks + 8 * q + 4, 16 * wave, lane);
#pragma unroll
        for (int vf = 0; vf < 8; ++vf) {
            const bf16x8 afrag = tr_frag(Vt, 32 * ks + 8 * q, 32 * ks + 8 * q + 4, 16 * vf, lane);
            acc[vf] = __builtin_amdgcn_mfma_f32_16x16x32_bf16(afrag, bfrag, acc[vf], 0, 0, 0);
        }
    }
    float* dst = kvbuf + ((size_t)((b * NH + h) * 16 + c)) * 16384 + (size_t)(16 * wave + r) * 128 + 4 * q;
#pragma unroll
    for (int vf = 0; vf < 8; ++vf) *(f32x4*)(dst + 16 * vf) = acc[vf];
    __syncthreads();
}

__device__ __forceinline__ void kvloc_pair(LAS unsigned char* lds, int pr, const bf16* K, const bf16* V, bf16* kvbuf) {
    const int tid = ltid(), lane = tid & 63, half = __builtin_amdgcn_readfirstlane(tid >> 8), wl = __builtin_amdgcn_readfirstlane((tid >> 6) & 3), t = tid & 255;
    const int k = pr * 2 + half, b = k >> 6, h = (k >> 4) & 3, c = k & 15;
    const float lg2 = __log2f(1.0f - exp2f(-5.0f - (float)h));
    LAS unsigned char* Kt = lds + half * (256 * TS); LAS unsigned char* Vt = Kt + 128 * TS;
    const size_t r0 = (size_t)b * SEQ + c * 128;
#pragma unroll
    for (int i = 0; i < 8; ++i) {
        const int chunk = t + 256 * i, j = chunk >> 4, cc = chunk & 15;
        u32x4 kv = *(const u32x4*)(K + (r0 + j) * 512 + h * 128 + cc * 8);
        const u32x4 vv = *(const u32x4*)(V + (r0 + j) * 512 + h * 128 + cc * 8);
        kv = scale_bf16x8(kv, exp2f(lg2 * (float)(127 - j)));
        *(LAS u32x4*)(Kt + j * TS + cc * 16) = kv; *(LAS u32x4*)(Vt + j * TS + cc * 16) = vv;
    }
    __syncthreads();
    const int r = lane & 15, q = lane >> 4;
    f32x4 acc[2][8];
#pragma unroll
    for (int u = 0; u < 2; ++u)
#pragma unroll
        for (int vf = 0; vf < 8; ++vf) acc[u][vf] = (f32x4){0.f, 0.f, 0.f, 0.f};
#pragma unroll
    for (int ks = 0; ks < 4; ++ks) {
        const bf16x8 b0 = tr_frag(Kt, 32 * ks + 8 * q, 32 * ks + 8 * q + 4, 32 * wl, lane);
        const bf16x8 b1 = tr_frag(Kt, 32 * ks + 8 * q, 32 * ks + 8 * q + 4, 32 * wl + 16, lane);
#pragma unroll
        for (int vf = 0; vf < 8; ++vf) {
            const bf16x8 afrag = tr_frag(Vt, 32 * ks + 8 * q, 32 * ks + 8 * q + 4, 16 * vf, lane);
            acc[0][vf] = __builtin_amdgcn_mfma_f32_16x16x32_bf16(afrag, b0, acc[0][vf], 0, 0, 0);
            acc[1][vf] = __builtin_amdgcn_mfma_f32_16x16x32_bf16(afrag, b1, acc[1][vf], 0, 0, 0);
        }
    }
    bf16* dst = kvbuf + ((size_t)((b * NH + h) * 16 + c)) * 16384 + (size_t)(32 * wl + r) * 128 + 4 * q;
#pragma unroll
    for (int u = 0; u < 2; ++u)
#pragma unroll
        for (int vf = 0; vf < 8; ++vf) { u32x2 w; w.x = pk_bf16(acc[u][vf][0], acc[u][vf][1]); w.y = pk_bf16(acc[u][vf][2], acc[u][vf][3]); *(u32x2*)(dst + (size_t)u * 16 * 128 + 16 * vf) = w; }
    __syncthreads();
}

__device__ __forceinline__ void retout_item(LAS unsigned char* lds, int b, int h, int c, const bf16* Q, const bf16* K, const bf16* V, const bf16* GATE, const bf16* sb, bf16* mix,
                                            float lg2, int wave, int lane) {
    LAS unsigned char* Kt = lds; LAS unsigned char* Vt = lds + 128 * TS; LAS unsigned char* St = lds + 256 * TS;
    const int tid = ltid(); lane = tid & 63; wave = __builtin_amdgcn_readfirstlane(tid >> 6); const size_t r0 = (size_t)b * SEQ + c * 128;
#pragma unroll
    for (int i = 0; i < 4; ++i) {
        const int chunk = tid + 512 * i, j = chunk >> 4, cc = chunk & 15;
        const u32x4 kv = *(const u32x4*)(K + (r0 + j) * 512 + h * 128 + cc * 8);
        const u32x4 vv = *(const u32x4*)(V + (r0 + j) * 512 + h * 128 + cc * 8);
        *(LAS u32x4*)(Kt + j * TS + cc * 16) = kv; *(LAS u32x4*)(Vt + j * TS + cc * 16) = vv;
    }
    if (c > 0) {
        const bf16* sp = sb + ((size_t)((b * NH + h) * 16 + c)) * 16384;
#pragma unroll
        for (int i = 0; i < 4; ++i) {
            const int chunk = tid + 512 * i, j = chunk >> 4, cc = chunk & 15;
            *(LAS u32x4*)(St + j * TS + cc * 16) = *(const u32x4*)(sp + j * 128 + cc * 8);
        }
    }
    __syncthreads();
    const int r = lane & 15, q = lane >> 4;
    const size_t rowi = r0 + 16 * wave + r;
    bf16x8 qf[4];
#pragma unroll
    for (int ks = 0; ks < 4; ++ks) qf[ks] = *(const bf16x8*)(Q + rowi * 512 + h * 128 + 32 * ks + 8 * q);
    f32x4 sc[8];
#pragma unroll
    for (int jf = 0; jf < 8; ++jf) {
        sc[jf] = (f32x4){0.f, 0.f, 0.f, 0.f};
        if (jf <= wave) {
#pragma unroll
            for (int ks = 0; ks < 4; ++ks) {
                const bf16x8 kf = *(const LAS bf16x8*)(Kt + (16 * jf + r) * TS + (32 * ks + 8 * q) * 2);
                sc[jf] = __builtin_amdgcn_mfma_f32_16x16x32_bf16(kf, qf[ks], sc[jf], 0, 0, 0);
            }
#pragma unroll
            for (int e = 0; e < 4; ++e) { const int dlt = (16 * wave + r) - (16 * jf + 4 * q + e); sc[jf][e] = dlt >= 0 ? sc[jf][e] * exp2f(lg2 * (float)dlt) : 0.f; }
        }
    }
    f32x4 ao[8], ac[8];
#pragma unroll
    for (int vf = 0; vf < 8; ++vf) { ao[vf] = (f32x4){0.f, 0.f, 0.f, 0.f}; ac[vf] = (f32x4){0.f, 0.f, 0.f, 0.f}; }
#pragma unroll
    for (int k2 = 0; k2 < 4; ++k2) {
        if (2 * k2 <= wave) {
            union { u32x4 u; bf16x8 v; } pf;
            pf.u.x = pk_bf16(sc[2 * k2][0], sc[2 * k2][1]); pf.u.y = pk_bf16(sc[2 * k2][2], sc[2 * k2][3]); pf.u.z = pk_bf16(sc[2 * k2 + 1][0], sc[2 * k2 + 1][1]); pf.u.w = pk_bf16(sc[2 * k2 + 1][2], sc[2 * k2 + 1][3]);
#pragma unroll
            for (int vf = 0; vf < 8; ++vf) {
                const bf16x8 af = tr_frag(Vt, 32 * k2 + 4 * q, 32 * k2 + 16 + 4 * q, 16 * vf, lane);
                ao[vf] = __builtin_amdgcn_mfma_f32_16x16x32_bf16(af, pf.v, ao[vf], 0, 0, 0);
            }
        }
    }
    if (c > 0) {
#pragma unroll
        for (int ks = 0; ks < 4; ++ks) {
#pragma unroll
            for (int vf = 0; vf < 8; ++vf) {
                const bf16x8 af = tr_frag(St, 32 * ks + 8 * q, 32 * ks + 8 * q + 4, 16 * vf, lane);
                ac[vf] = __builtin_amdgcn_mfma_f32_16x16x32_bf16(af, qf[ks], ac[vf], 0, 0, 0);
            }
        }
    }
    const float gi = exp2f(lg2 * (float)(16 * wave + r + 1));
    float s = 0.f;
#pragma unroll
    for (int vf = 0; vf < 8; ++vf) { ao[vf] = ao[vf] + ac[vf] * gi; s += (ao[vf][0] + ao[vf][1]) + (ao[vf][2] + ao[vf][3]); }
    s += __shfl_xor(s, 16); s += __shfl_xor(s, 32);
    const float mean = s * (1.0f / 128.0f);
    float qv = 0.f;
#pragma unroll
    for (int vf = 0; vf < 8; ++vf) { ao[vf] = ao[vf] - mean; qv += (ao[vf][0] * ao[vf][0] + ao[vf][1] * ao[vf][1]) + (ao[vf][2] * ao[vf][2] + ao[vf][3] * ao[vf][3]); }
    qv += __shfl_xor(qv, 16); qv += __shfl_xor(qv, 32);
    const float rstd = rsqrtf(qv * (1.0f / 128.0f) + EPS);
#pragma unroll
    for (int vf = 0; vf < 8; ++vf) {
        const u32x2 gw = *(const u32x2*)(GATE + rowi * 512 + h * 128 + 16 * vf + 4 * q);
        u32x2 o; o.x = pk_bf16(ao[vf][0] * rstd * bflo(gw.x), ao[vf][1] * rstd * bfhi(gw.x)); o.y = pk_bf16(ao[vf][2] * rstd * bflo(gw.y), ao[vf][3] * rstd * bfhi(gw.y));
        *(u32x2*)(mix + rowi * D + 512 + h * 128 + 16 * vf + 4 * q) = o;
    }
    __syncthreads();
}

__device__ __forceinline__ void scan_phase(const bf16* kvbuf, bf16* sb, float* out_state) {
    const int tid = ltid();
    for (int idx = blockIdx.x * NTHREADS + tid; idx < 32 * 4096; idx += gridDim.x * NTHREADS) {
        const int bh = idx >> 12, e4 = idx & 4095, h = bh & 3;
        const float g128 = exp2f(128.0f * __log2f(1.0f - exp2f(-5.0f - (float)h)));
        const bf16* base = kvbuf + (size_t)bh * 16 * 16384 + e4 * 4;
        u32x2 kvr[16];
#pragma unroll
        for (int c = 0; c < 16; ++c) kvr[c] = *(const u32x2*)(base + (size_t)c * 16384);
        f32x4 s = (f32x4){0.f, 0.f, 0.f, 0.f};
#pragma unroll
        for (int c = 0; c < 16; ++c) {
            if (c > 0) { u32x2 w; w.x = pk_bf16(s[0], s[1]); w.y = pk_bf16(s[2], s[3]); *(u32x2*)(sb + ((size_t)(bh * 16 + c)) * 16384 + e4 * 4) = w; }
            s = s * g128 + (f32x4){bflo(kvr[c].x), bfhi(kvr[c].x), bflo(kvr[c].y), bfhi(kvr[c].y)};
        }
        __builtin_nontemporal_store(s, (f32x4*)(out_state + (size_t)bh * 16384 + e4 * 4));
    }
}

__device__ __forceinline__ void ret_sample_item(LAS unsigned char* lds, int b, int h, const bf16* Q, const bf16* K, const bf16* V, const bf16* GATE, const float* state_in, float* out_state,
                                                bf16* mix, float lg2, int wave, int lane) {
    LAS float* qs = (LAS float*)lds; LAS float* ks = qs + 512; LAS float* vs = ks + 512; LAS float* scs = vs + 512;
    LAS float* red = (LAS float*)(lds + 8192); LAS float* wsum = (LAS float*)(lds + 8192 + 32768);
    const int tid = ltid(); lane = tid & 63; wave = __builtin_amdgcn_readfirstlane(tid >> 6); const size_t row0 = (size_t)MP + 4 * b;
    { const int i = tid >> 7, d = tid & 127; const size_t o = (row0 + i) * 512 + h * 128 + d; qs[tid] = bf2f(Q[o]); ks[tid] = bf2f(K[o]); vs[tid] = bf2f(V[o]); }
    __syncthreads();
    { const int i = wave >> 1;
#pragma unroll
      for (int jj = 0; jj < 2; ++jj) { const int j = (wave & 1) * 2 + jj; float p = qs[i * 128 + lane] * ks[j * 128 + lane] + qs[i * 128 + 64 + lane] * ks[j * 128 + 64 + lane]; p = wave_sum(p);
          if (lane == 0) scs[i * 4 + j] = (j <= i) ? p * exp2f(lg2 * (float)(i - j)) : 0.f; } }
    const int v4 = (tid & 31) * 4, dg = tid >> 5;
    const float g4 = exp2f(lg2 * 4.0f), gk0 = exp2f(lg2 * 3.0f), gk1 = exp2f(lg2 * 2.0f), gk2 = exp2f(lg2), gk3 = 1.0f;
    const float* sin_ = state_in + ((size_t)(b * NH + h) * 128) * 128; float* sout = out_state + ((size_t)(b * NH + h) * 128) * 128;
    const f32x4 vv0 = *(const LAS f32x4*)(vs + v4), vv1 = *(const LAS f32x4*)(vs + 128 + v4), vv2 = *(const LAS f32x4*)(vs + 256 + v4), vv3 = *(const LAS f32x4*)(vs + 384 + v4);
    f32x4 p0 = (f32x4){0.f, 0.f, 0.f, 0.f}, p1 = p0, p2 = p0, p3 = p0;
#pragma unroll
    for (int dd = 0; dd < 8; ++dd) {
        const int d = dg * 8 + dd;
        const f32x4 s4 = *(const f32x4*)(sin_ + (size_t)d * 128 + v4);
        p0 += s4 * qs[d]; p1 += s4 * qs[128 + d]; p2 += s4 * qs[256 + d]; p3 += s4 * qs[384 + d];
        f32x4 ns = s4 * g4 + vv0 * (gk0 * ks[d]) + vv1 * (gk1 * ks[128 + d]) + vv2 * (gk2 * ks[256 + d]) + vv3 * (gk3 * ks[384 + d]);
        *(f32x4*)(sout + (size_t)d * 128 + v4) = ns;
    }
    *(LAS f32x4*)(red + (dg * 4 + 0) * 128 + v4) = p0; *(LAS f32x4*)(red + (dg * 4 + 1) * 128 + v4) = p1; *(LAS f32x4*)(red + (dg * 4 + 2) * 128 + v4) = p2; *(LAS f32x4*)(red + (dg * 4 + 3) * 128 + v4) = p3;
    __syncthreads();
    const int i = tid >> 7, v = tid & 127;
    float cross = 0.f;
#pragma unroll
    for (int g = 0; g < 16; ++g) cross += red[(g * 4 + i) * 128 + v];
    float o = exp2f(lg2 * (float)(i + 1)) * cross;
#pragma unroll
    for (int j = 0; j < 4; ++j) o += scs[i * 4 + j] * vs[j * 128 + v];
    float s = wave_sum(o);
    if (lane == 0) wsum[wave] = s;
    __syncthreads();
    const float mean = (wsum[2 * i] + wsum[2 * i + 1]) * (1.0f / 128.0f);
    const float dv = o - mean;
    float qv = wave_sum(dv * dv);
    if (lane == 0) wsum[8 + wave] = qv;
    __syncthreads();
    const float rstd = rsqrtf((wsum[8 + 2 * i] + wsum[8 + 2 * i + 1]) * (1.0f / 128.0f) + EPS);
    const float gt = bf2f(GATE[(row0 + i) * 512 + h * 128 + v]);
    const unsigned pk = pk_bf16(dv * rstd * gt, 0.f);
    mix[(row0 + i) * D + 512 + h * 128 + v] = (bf16)(pk & 0xffffu);
    __syncthreads();
}

__device__ __forceinline__ void ret_sample_pair(LAS unsigned char* lds, int pair, const bf16* Q, const bf16* K, const bf16* V, const bf16* GATE, const float* state_in, float* out_state, bf16* mix) {
    const int tid = ltid(), half = __builtin_amdgcn_readfirstlane(tid >> 8), t = tid & 255, lane = tid & 63, wl = __builtin_amdgcn_readfirstlane((tid >> 6) & 3);
    const int item = pair * 2 + half, b = item >> 2, h = item & 3;
    const float lg2 = __log2f(1.0f - exp2f(-5.0f - (float)h));
    LAS float* base = (LAS float*)(lds + half * 32768);
    LAS float* qs = base; LAS float* ks = base + 512; LAS float* vs = base + 1024; LAS float* red = base + 2048;
    const size_t row0 = (size_t)MP + 4 * b;
#pragma unroll
    for (int u = 0; u < 2; ++u) { const int e = t + 256 * u, i = e >> 7, d = e & 127; const size_t o = (row0 + i) * 512 + h * 128 + d; qs[e] = bf2f(Q[o]); ks[e] = bf2f(K[o]); vs[e] = bf2f(V[o]); }
    const float gt0 = bf2f(GATE[(row0 + wl) * 512 + h * 128 + lane]), gt1 = bf2f(GATE[(row0 + wl) * 512 + h * 128 + 64 + lane]);
    __syncthreads();
    {
        const int v4 = (t & 31) * 4, dg = t >> 5;
        const float g4 = exp2f(lg2 * 4.0f), gk0 = exp2f(lg2 * 3.0f), gk1 = exp2f(lg2 * 2.0f), gk2 = exp2f(lg2);
        const float* sin_ = state_in + ((size_t)(b * NH + h) * 128) * 128; float* sout = out_state + ((size_t)(b * NH + h) * 128) * 128;
        const f32x4 vv0 = *(const LAS f32x4*)(vs + v4), vv1 = *(const LAS f32x4*)(vs + 128 + v4), vv2 = *(const LAS f32x4*)(vs + 256 + v4), vv3 = *(const LAS f32x4*)(vs + 384 + v4);
        f32x4 p0 = (f32x4){0.f, 0.f, 0.f, 0.f}, p1 = p0, p2 = p0, p3 = p0;
        f32x4 s4[16];
#pragma unroll
        for (int dd = 0; dd < 16; ++dd) s4[dd] = __builtin_nontemporal_load((const f32x4*)(sin_ + (size_t)(dg * 16 + dd) * 128 + v4));
#pragma unroll
        for (int dd = 0; dd < 16; ++dd) {
            const int d = dg * 16 + dd;
            p0 += s4[dd] * qs[d]; p1 += s4[dd] * qs[128 + d]; p2 += s4[dd] * qs[256 + d]; p3 += s4[dd] * qs[384 + d];
            const f32x4 ns = s4[dd] * g4 + vv0 * (gk0 * ks[d]) + vv1 * (gk1 * ks[128 + d]) + vv2 * (gk2 * ks[256 + d]) + vv3 * ks[384 + d];
            __builtin_nontemporal_store(ns, (f32x4*)(sout + (size_t)d * 128 + v4));
        }
        *(LAS f32x4*)(red + (dg * 4 + 0) * 128 + v4) = p0; *(LAS f32x4*)(red + (dg * 4 + 1) * 128 + v4) = p1; *(LAS f32x4*)(red + (dg * 4 + 2) * 128 + v4) = p2; *(LAS f32x4*)(red + (dg * 4 + 3) * 128 + v4) = p3;
    }
    __syncthreads();
    {
        const int i = wl;
        float o0 = 0.f, o1 = 0.f;
#pragma unroll
        for (int g = 0; g < 8; ++g) { o0 += red[(g * 4 + i) * 128 + lane]; o1 += red[(g * 4 + i) * 128 + 64 + lane]; }
        const float gi = exp2f(lg2 * (float)(i + 1));
        o0 *= gi; o1 *= gi;
#pragma unroll
        for (int j = 0; j < 4; ++j) {
            if (j <= i) {
                float p = qs[i * 128 + lane] * ks[j * 128 + lane] + qs[i * 128 + 64 + lane] * ks[j * 128 + 64 + lane];
                p = wave_sum(p) * exp2f(lg2 * (float)(i - j));
                o0 += p * vs[j * 128 + lane]; o1 += p * vs[j * 128 + 64 + lane];
            }
        }
        const float mean = wave_sum(o0 + o1) * (1.0f / 128.0f);
        const float d0 = o0 - mean, d1 = o1 - mean;
        const float rstd = rsqrtf(wave_sum(d0 * d0 + d1 * d1) * (1.0f / 128.0f) + EPS);
        const unsigned pk = pk_bf16(d0 * rstd * gt0, d1 * rstd * gt1);
        bf16* mo = mix + (row0 + i) * D + 512 + h * 128 + lane;
        mo[0] = (bf16)(pk & 0xffffu); mo[64] = (bf16)(pk >> 16);
    }
    __syncthreads();
}

#define XB_TMO      128
#define XB_XCNT(j)  (256  + 64 * (j))
#define XB_XSUB(j)  (1280 + 64 * (j))
#define XB_XGEN(j)  (2304 + 64 * (j))
#define XB_TOP      3328
#define XB_TOPGEN   3392
#define XCD_BAR_WORDS 3456
#define XB_SPIN_CAP (1u << 18)

__device__ __forceinline__ unsigned xb_ld(unsigned* p)              { return __hip_atomic_load(p, __ATOMIC_RELAXED, __HIP_MEMORY_SCOPE_AGENT); }
__device__ __forceinline__ unsigned xb_add(unsigned* p, unsigned v) { return __hip_atomic_fetch_add(p, v, __ATOMIC_RELAXED, __HIP_MEMORY_SCOPE_AGENT); }
__device__ __forceinline__ unsigned xb_xcc_id() { return (unsigned)__builtin_amdgcn_s_getreg((3 << 11) | 20) & 0xFu; }
#define XB_SPIN(cond, bar) do { unsigned _sp = 0; while (cond) { __builtin_amdgcn_s_sleep(1); \
    if ((++_sp & 255u) == 0u) { if (xb_ld(&(bar)[XB_TMO])) break; if (_sp > XB_SPIN_CAP) { atomicAdd(&(bar)[XB_TMO], 1u); break; } } } } while (0)

struct XcdBarrier {
    unsigned* bar; unsigned x;
    volatile LAS unsigned* st;
};

__device__ __forceinline__ XcdBarrier xcd_barrier_post(unsigned* bar, volatile LAS unsigned* st) {
    XcdBarrier b; b.bar = bar; b.x = xb_xcc_id(); b.st = st;
    if (threadIdx.x == 0) (void)xb_add(&bar[XB_XCNT(b.x)], 1u);
    return b;
}
__device__ __forceinline__ void xcd_barrier_complete(unsigned* bar, unsigned x, unsigned& nloc, unsigned& nx) {
    const unsigned G = gridDim.x * gridDim.y * gridDim.z;
    unsigned sum, cnt, mine, sp = 0u;
    for (;;) {
        sum = 0u; cnt = 0u; mine = 0u;
#pragma unroll
        for (unsigned j = 0; j < 16; ++j) { const unsigned c = xb_ld(&bar[XB_XCNT(j)]); sum += c; cnt += (c > 0u) ? 1u : 0u; mine = (j == x) ? c : mine; }
        if (sum == G) break;
        __builtin_amdgcn_s_sleep(1);
        if ((++sp & 255u) == 0u) { if (xb_ld(&bar[XB_TMO])) break; if (sp > XB_SPIN_CAP) { atomicAdd(&bar[XB_TMO], 1u); break; } }
    }
    nloc = mine > 0u ? mine : 1u; nx = cnt > 0u ? cnt : 1u;
}

__device__ __forceinline__ void xcd_barrier(const XcdBarrier& b) {
    asm volatile("s_waitcnt vmcnt(0)" ::: "memory");
    __syncthreads();
    if (threadIdx.x == 0) {
        unsigned* bar = b.bar;
        __builtin_amdgcn_s_waitcnt(0);
        unsigned nloc = b.st[0], nx = b.st[1];
        if (nloc == 0u) { xcd_barrier_complete(bar, b.x, nloc, nx); b.st[0] = nloc; b.st[1] = nx; }
        const unsigned old = xb_add(&bar[XB_XSUB(b.x)], 1u);
        const unsigned gen = old / nloc;
        if (old + 1u == (gen + 1u) * nloc) {
            __builtin_amdgcn_fence(__ATOMIC_RELEASE, "agent");
            asm volatile("s_waitcnt vmcnt(0)" ::: "memory");
            const unsigned og = xb_add(&bar[XB_TOP], 1u);
            const unsigned tg = og / nx;
            if (og + 1u == (tg + 1u) * nx) xb_add(&bar[XB_TOPGEN], 1u);
            else XB_SPIN(xb_ld(&bar[XB_TOPGEN]) == tg, bar);
            __builtin_amdgcn_fence(__ATOMIC_ACQUIRE, "agent");
            xb_add(&bar[XB_XGEN(b.x)], 1u);
            asm volatile("s_waitcnt vmcnt(0)" ::: "memory");
        } else {
            __builtin_amdgcn_fence(__ATOMIC_ACQUIRE, "agent");
            asm volatile("s_waitcnt vmcnt(0)" ::: "memory");
            XB_SPIN(xb_ld(&bar[XB_XGEN(b.x)]) == gen, bar);
            asm volatile("" ::: "memory");
            asm volatile("s_waitcnt vmcnt(0)" ::: "memory");
        }
    }
    __syncthreads();
}

#define GRID_SYNC() do { XcdBarrier b_ = bar; unsigned* p_ = (unsigned*)(a.ws + WS_CTL) + 4096; asm volatile("" : "+s"(p_)); b_.bar = p_; unsigned x_ = bar.x; asm volatile("" : "+s"(x_)); b_.x = x_; xcd_barrier(b_); } while (0)

__global__ void __launch_bounds__(NTHREADS, 2) mega_fwd(Args a) {
    extern __shared__ __attribute__((aligned(16))) unsigned char lds_raw[];
    LAS unsigned char* lds = (LAS unsigned char*)lds_raw;
    cg::grid_group grid = cg::this_grid();
    const int tid = threadIdx.x, lane = tid & 63, wave = __builtin_amdgcn_readfirstlane(tid >> 6);
    const int G = gridDim.x, bid = blockIdx.x;
    unsigned char* ws = a.ws;
    float* ssq = (float*)(ws + WS_SSQ);
    const f32x2* rope = (const f32x2*)(ws + WS_ROPE);
    bf16* XN = (bf16*)(ws + WS_XN);
    bf16 *GLU = (bf16*)(ws + WS_GLU), *Qb = (bf16*)(ws + WS_Q), *Kb = (bf16*)(ws + WS_K), *Vb = (bf16*)(ws + WS_V), *GATE = (bf16*)(ws + WS_GATE), *MIX = (bf16*)(ws + WS_MIX), *Hb = (bf16*)(ws + WS_H);
    bf16* KVB = (bf16*)(ws + WS_KV);
    bf16* SB = (bf16*)(ws + WS_SB);
    float* XR = a.out + O_Y;
    volatile LAS unsigned* MISC = (volatile LAS unsigned*)(lds + LDS_BYTES - 256);
    if (tid < 64) MISC[tid] = 0u;
    __syncthreads();
    XcdBarrier bar = xcd_barrier_post((unsigned*)(ws + WS_CTL) + 4096, MISC + 8);

#ifndef SKIP_P0
    for (int rep = 0; rep < REP_P0; ++rep) p0_prologue(a, lds, wave, lane);
#endif
    if (a.ws == nullptr) grid.sync();
    GRID_SYNC();

    for (int l = 0; l < 2; ++l) {
        const unsigned char* wl = ws + WS_W + (size_t)l * W_LAYER;
        {
            pg8::Gemm g{XN, (const bf16*)(wl + W_IN), MP, NIN, D}; pg8::StaticOrder S; S.init(MP, NIN, G, bid);
            EpiIn E{ssq + (size_t)(2 * l) * M, GLU, Qb, Kb, Vb, GATE, rope, a.in[10] + l * 512};
#ifndef SKIP_IN
            for (int rep = 0; rep < REP_BIG; ++rep) pg8::gemm_phase<EpiIn, pg8::StaticOrder, true, true>(lds, g, S, E);
#endif
            for (int rep = 0; rep < REP_SMALL; ++rep) small_gemm<EpiIn, 2>(lds, XN, (const bf16*)(wl + W_IN), D, 48, E);
        }
        GRID_SYNC();
        {
            const float* cw = a.in[6] + (size_t)l * CW * 512; const float* cb = a.in[7] + l * 512; const float* lng = a.in[8] + l * 512; const float* lnb = a.in[9] + l * 512;
            const float* cache = a.in[2] + (size_t)l * 128 * 30 * 512;
            float* ocp = a.out + O_CP + (size_t)l * 8 * 30 * 512; float* ocs = a.out + O_CS + (size_t)l * 128 * 30 * 512;
            const float* st_in = a.in[3] + (size_t)l * 128 * NH * 16384; float* ors = a.out + O_RS + (size_t)l * 128 * NH * 16384;
            for (int rep = 0; rep < REP_P2; ++rep)
            for (int it = bid; it < 896; it += G) {
#ifndef SKIP_P2
                if (it < 256) { conv_pair(lds, it, GLU, cw, cb, lng, lnb, MIX, ocp); }
                else if (it < 384) { conv_item<4, true>(lds, it - 256, 0, GLU, cache, cw, cb, lng, lnb, MIX, ocs, wave, lane); }
                else if (it < 640) { kvloc_pair(lds, it - 384, Kb, Vb, KVB); }
                else { ret_sample_pair(lds, it - 640, Qb, Kb, Vb, GATE, st_in, ors, MIX); }
#endif
            }
        }
        GRID_SYNC();
        scan_phase(KVB, SB, a.out + O_RP + (size_t)l * 8 * NH * 16384);
        GRID_SYNC();
        {
#ifndef SKIP_P3
            for (int rep = 0; rep < REP_P3; ++rep)
            for (int it = bid; it < 512; it += G) { const int h = (it >> 4) & 3; retout_item(lds, it >> 6, h, it & 15, Qb, Kb, Vb, GATE, SB, MIX, __log2f(1.0f - exp2f(-5.0f - (float)h)), wave, lane); }
#endif
        }
        GRID_SYNC();
        {
            pg8::Gemm g{MIX, (const bf16*)(wl + W_OUT), MP, D, D}; pg8::StaticOrder S; S.init(MP, D, G, bid);
            EpiRes E{XN, ssq + (size_t)(2 * l + 1) * M};
#ifndef SKIP_RES
            pg8::gemm_phase<EpiRes, pg8::StaticOrder, true, true>(lds, g, S, E);
#endif
            small_gemm32(lds, MIX, (const bf16*)(wl + W_OUT), D, E);
        }
        GRID_SYNC();
        {
            pg8::Gemm g{XN, (const bf16*)(wl + W_UP), MP, FF, D}; pg8::StaticOrder S; S.init(MP, FF, G, bid);
            EpiUp E{ssq + (size_t)(2 * l + 1) * M, Hb};
#ifndef SKIP_UP
            for (int rep = 0; rep < REP_BIG; ++rep) pg8::gemm_phase<EpiUp, pg8::StaticOrder, true, true>(lds, g, S, E);
#endif
            for (int rep = 0; rep < REP_SMALL; ++rep) small_gemm<EpiUp, 2>(lds, XN, (const bf16*)(wl + W_UP), D, 64, E);
        }
        GRID_SYNC();
        {
            pg8::Gemm g{Hb, (const bf16*)(wl + W_DN), MP, D, FF}; pg8::StaticOrder S; S.init(MP, D, G, bid);
            EpiRes E{XN, ssq + (size_t)(2 * l + 2) * M};
#ifndef SKIP_RES
            pg8::gemm_phase<EpiRes, pg8::StaticOrder, true, true>(lds, g, S, E);
#endif
            small_gemm32(lds, Hb, (const bf16*)(wl + W_DN), FF, E);
        }
        GRID_SYNC();
    }
    {
        const float* gf = a.in[15]; const float* sq = ssq + (size_t)4 * M;
        const int gw = bid * NWAVES + wave, NGW = G * NWAVES;
        for (int m0 = gw; m0 < M; m0 += 4 * NGW) {
            u32x4 v[4][2]; float rs[4];
#pragma unroll
            for (int u = 0; u < 4; ++u) {
                const int m = (m0 + u * NGW) < M ? (m0 + u * NGW) : m0;
                rs[u] = sq[m];
                v[u][0] = *(const u32x4*)(XN + (size_t)m * D + 8 * lane); v[u][1] = *(const u32x4*)(XN + (size_t)m * D + 8 * lane + 512);
            }
#pragma unroll
            for (int u = 0; u < 4; ++u) {
                const int m = m0 + u * NGW;
                if (m < M) {
                    const float rstd = rsqrtf(rs[u] * (1.0f / D) + EPS);
                    float* yrow = XR + (size_t)m * D;
#pragma unroll
                    for (int j = 0; j < 2; ++j) {
                        const u32x4 w = v[u][j];
                        const f32x4 g0 = *(const f32x4*)(gf + 8 * lane + 512 * j), g1 = *(const f32x4*)(gf + 8 * lane + 512 * j + 4);
                        f32x4 y0, y1;
                        y0[0] = bflo(w.x) * rstd * g0[0]; y0[1] = bfhi(w.x) * rstd * g0[1]; y0[2] = bflo(w.y) * rstd * g0[2]; y0[3] = bfhi(w.y) * rstd * g0[3];
                        y1[0] = bflo(w.z) * rstd * g1[0]; y1[1] = bfhi(w.z) * rstd * g1[1]; y1[2] = bflo(w.w) * rstd * g1[2]; y1[3] = bfhi(w.w) * rstd * g1[3];
                        __builtin_nontemporal_store(y0, (f32x4*)(yrow + 8 * lane + 512 * j)); __builtin_nontemporal_store(y1, (f32x4*)(yrow + 8 * lane + 512 * j + 4));
                    }
                }
            }
        }
    }
}

extern "C" void kernel_launch(void* const* d_in, const int* in_sizes, int n_in, void* d_out, int out_size, void* d_ws, size_t ws_size, hipStream_t stream) {
    static int grid = 0;
    if (grid == 0) {
        int dev = 0, cus = 0, per_cu = 0;
        (void)hipGetDevice(&dev);
        (void)hipDeviceGetAttribute(&cus, hipDeviceAttributeMultiprocessorCount, dev);
        (void)hipFuncSetAttribute((const void*)mega_fwd, hipFuncAttributeMaxDynamicSharedMemorySize, LDS_BYTES);
        (void)hipOccupancyMaxActiveBlocksPerMultiprocessor(&per_cu, (const void*)mega_fwd, NTHREADS, LDS_BYTES);
        if (per_cu < 1) per_cu = 1;
        if (per_cu > 1) per_cu = 1;
        grid = cus * per_cu;
        if (n_in != 16 || ws_size < WS_END) { fprintf(stderr, "kernel_launch: unexpected n_in %d / ws %zu\n", n_in, ws_size); }
    }
    (void)hipMemsetAsync((char*)d_ws + WS_CTL, 0, CTL_BYTES, stream);
    Args a{};
    for (int i = 0; i < 16; ++i) a.in[i] = (const float*)d_in[i];
    a.out = (float*)d_out; a.ws = (unsigned char*)d_ws;
    void* args[] = {&a};
    hipError_t e = hipLaunchCooperativeKernel((const void*)mega_fwd, dim3(grid), dim3(NTHREADS), args, LDS_BYTES, stream);
    if (e != hipSuccess) fprintf(stderr, "cooperative launch failed: %s (grid %d)\n", hipGetErrorString(e), grid);
}
```

```cpp
#include <hip/hip_runtime.h>
#include <hip/hip_cooperative_groups.h>
#include <cstdio>
#include <cstdint>
namespace cg = cooperative_groups;
namespace pg8 {
#define PG8_LAS __attribute__((address_space(3)))
typedef unsigned short bf16_t;
typedef short bf16x8 __attribute__((ext_vector_type(8)));
typedef float f32x4 __attribute__((ext_vector_type(4)));
typedef unsigned u32x4 __attribute__((ext_vector_type(4)));
constexpr int BM = 256, BK = 64, HALF = 128, HTB = HALF * BK * 2  , STAGE_BYTES = 8 * HTB, NXCD = 8, WGM = 8;

__host__ __device__ __forceinline__ int lds_byte(int r, int c) { const int st = (r >> 4) * 2 + (c >> 5), rr = r & 15, cc = c & 31, ob = rr * 64 + cc * 2; return st * 1024 + (ob ^ (((ob >> 9) & 1) << 5)); }
__host__ __device__ __forceinline__ void stage_rc(int b, int& R, int& C) { const int st = b / 1024, sb = b % 1024, swz = sb ^ (((sb >> 9) & 1) << 5); R = (st >> 1) * 16 + swz / 64; C = (st & 1) * 32 + (swz % 64) / 2; }
__host__ __device__ __forceinline__ int perm32(int rho) { const int n = rho >> 4, i = rho & 15; return 8 * (i >> 2) + 4 * n + (i & 3); }

struct Unit { int pm, pn; };
struct Gemm { const bf16_t* A; const bf16_t* Bt; int M, N, K; };

struct StaticOrder {
    int nM, nN, nwg, G, c;
    __host__ __device__ void init(int M, int N, int G_, int c_) { nM = M / BM; nN = N / BM; nwg = nM * nN; G = G_; c = c_; }
    __host__ __device__ bool next(int i, Unit& u) const {
        const long L = (long)i * G + c; if (L >= nwg) return false;
        int wgid = (int)L; { const int q = nwg / NXCD, r = nwg % NXCD, xcd = wgid % NXCD, off = wgid / NXCD; wgid = (xcd < r ? xcd * (q + 1) : r * (q + 1) + (xcd - r) * q) + off; }
        const int nig = WGM * nN, gid = wgid / nig, fm = gid * WGM, gsz = (nM - fm) < WGM ? (nM - fm) : WGM;
        u.pm = fm + ((wgid % nig) % gsz); u.pn = (wgid % nig) / gsz; return true;
    }
    __device__ __forceinline__ void a_ready(const Unit&) const {}
    __device__ __forceinline__ void done(const Unit&) const {}
};
__device__ __forceinline__ unsigned cvt_pk_bf16(float lo, float hi) { unsigned r; asm volatile("v_cvt_pk_bf16_f32 %0, %1, %2" : "=v"(r) : "v"(lo), "v"(hi)); return r; }
typedef float f32x2 __attribute__((ext_vector_type(2)));
template <class Epi, class Sched, bool ALIGN_EPI = false, bool SP2 = false>
__device__ __forceinline__ void gemm_phase(PG8_LAS unsigned char* lds, const Gemm g, const Sched& S, const Epi& E) {
    int tid_ = threadIdx.x; asm volatile("" : "+v"(tid_)); const int tid = tid_, wid = __builtin_amdgcn_readfirstlane(tid >> 6), lane = tid & 63, wr = wid >> 2, wc = wid & 3, fr = lane & 15, fq = lane >> 4;
    const int K = g.K, nt = K / BK;
    unsigned voffA[2], voffB[2];
#pragma unroll
    for (int i = 0; i < 2; ++i) { int R, C; stage_rc(tid * 16 + i * 8192, R, C); const int Rb = Epi::PERM ? ((R & ~31) + perm32(R & 31)) : R;
        voffA[i] = (unsigned)(R * K + C) * 2u; voffB[i] = (unsigned)(Rb * K + C) * 2u; }
    const size_t kstep = (size_t)(BK * 2);
    const size_t hstep = (size_t)HALF * K * 2;
    const size_t tstep = 2 * hstep;
    const unsigned ldsw = (unsigned)wid * 1024u;
    const int aoff = lds_byte(wr * 64 + fr, fq * 8), boff = lds_byte(wc * 32 + fr, fq * 8);
#define PG8_SA(b, h) (((b) * 2 + (h)) * HTB)
#define PG8_SB(b, h) ((4 + (b) * 2 + (h)) * HTB)
#define PG8_STAGE(bufoff, gbase, voff) do { _Pragma("unroll") for (int _i = 0; _i < 2; ++_i) \
        __builtin_amdgcn_global_load_lds((const unsigned*)((const char*)(gbase) + (voff)[_i]), (PG8_LAS unsigned*)(lds + (bufoff) + ldsw + _i * 8192), 16, 0, 0); } while (0)
#define PG8_LDA(dst, b, h) do { _Pragma("unroll") for (int m = 0; m < 4; ++m) _Pragma("unroll") for (int k = 0; k < 2; ++k) dst[m][k] = *(const PG8_LAS bf16x8*)(lds + PG8_SA(b, h) + aoff + m * 2048 + k * 1024); } while (0)
#define PG8_LDB(dst, b, h) do { _Pragma("unroll") for (int n = 0; n < 2; ++n) _Pragma("unroll") for (int k = 0; k < 2; ++k) dst[n][k] = *(const PG8_LAS bf16x8*)(lds + PG8_SB(b, h) + boff + n * 2048 + k * 1024); } while (0)
#define PG8_MMA(ai, bj, At, Bt) do { __builtin_amdgcn_s_setprio(1); _Pragma("unroll") for (int m = 0; m < 4; ++m) _Pragma("unroll") for (int n = 0; n < 2; ++n) _Pragma("unroll") for (int k = 0; k < 2; ++k) \
        acc[ai][bj][m][n] = __builtin_amdgcn_mfma_f32_16x16x32_bf16(Bt[n][k], At[m][k], acc[ai][bj][m][n], 0, 0, 0); __builtin_amdgcn_s_setprio(0); } while (0)
#define PG8_WAIT_V(n) asm volatile("s_waitcnt vmcnt(" #n ")" ::: "memory")
#define PG8_WAIT_L(n) asm volatile("s_waitcnt lgkmcnt(" #n ")" ::: "memory")
#define PG8_BAR __builtin_amdgcn_s_barrier()
#define PG8_SCHED __builtin_amdgcn_sched_barrier(0)
    Unit cur, nxt; int ui = 0;
    if (!S.next(0, cur)) return;
    f32x4 acc[2][2][4][2];
#pragma unroll
    for (int a = 0; a < 2; ++a)
#pragma unroll
        for (int b = 0; b < 2; ++b)
#pragma unroll
            for (int m = 0; m < 4; ++m)
#pragma unroll
                for (int n = 0; n < 2; ++n) acc[a][b][m][n] = (f32x4){0.f, 0.f, 0.f, 0.f};
    bf16x8 At[4][2], B0[2][2], B1[2][2];
    const char* cA = (const char*)g.A + (size_t)cur.pm * tstep; const char* cB = (const char*)g.Bt + (size_t)cur.pn * tstep;
    S.a_ready(cur);
    if constexpr (SP2) {
        PG8_STAGE(PG8_SB(0, 0), cB, voffB); PG8_STAGE(PG8_SB(0, 1), cB + hstep, voffB); PG8_STAGE(PG8_SA(0, 0), cA, voffA); PG8_STAGE(PG8_SA(0, 1), cA + hstep, voffA);
        if (wr == 1) PG8_BAR;
        PG8_WAIT_V(2); PG8_BAR;
        PG8_STAGE(PG8_SB(1, 0), cB + kstep, voffB); PG8_STAGE(PG8_SA(1, 0), cA + kstep, voffA); PG8_STAGE(PG8_SB(1, 1), cB + hstep + kstep, voffB);
        PG8_WAIT_V(6); PG8_BAR;
    } else {
        PG8_STAGE(PG8_SB(0, 0), cB, voffB); PG8_STAGE(PG8_SA(0, 0), cA, voffA); PG8_STAGE(PG8_SB(0, 1), cB + hstep, voffB); PG8_STAGE(PG8_SA(0, 1), cA + hstep, voffA);
        if (wr == 1) PG8_BAR;
        PG8_WAIT_V(4); PG8_BAR;
        PG8_STAGE(PG8_SB(1, 0), cB + kstep, voffB); PG8_STAGE(PG8_SA(1, 0), cA + kstep, voffA); PG8_STAGE(PG8_SB(1, 1), cB + hstep + kstep, voffB);
        PG8_WAIT_V(6); PG8_BAR;
    }
    for (;;) {
        const bool has_next = S.next(ui + 1, nxt);
        const char* nA = has_next ? (const char*)g.A + (size_t)nxt.pm * tstep : cA; const char* nB = has_next ? (const char*)g.Bt + (size_t)nxt.pn * tstep : cB;
        for (int t = 0; t < nt; t += 2) {
            const bool last = (t == nt - 2);
            const char* a1 = cA + (size_t)(t + 1) * kstep;
            const char* a2 = last ? nA : cA + (size_t)(t + 2) * kstep; const char* b2 = last ? nB : cB + (size_t)(t + 2) * kstep;
            const char* a3 = a2 + kstep; const char* b3 = b2 + kstep;
            if (last && has_next) S.a_ready(nxt);
            if constexpr (SP2) {
            PG8_LDB(B0, 0, 0); PG8_LDB(B1, 0, 1); PG8_SCHED; PG8_LDA(At, 0, 0); PG8_STAGE(PG8_SA(1, 1), a1 + hstep, voffA);
            PG8_WAIT_V(8); PG8_WAIT_L(0); PG8_BAR; PG8_MMA(0, 0, At, B0); PG8_MMA(0, 1, At, B1); PG8_BAR; PG8_SCHED;
            PG8_LDA(At, 0, 1); PG8_STAGE(PG8_SB(0, 0), b2, voffB); PG8_STAGE(PG8_SB(0, 1), b2 + hstep, voffB); PG8_STAGE(PG8_SA(0, 0), a2, voffA);
            PG8_WAIT_V(8); PG8_WAIT_L(0); PG8_BAR; PG8_MMA(1, 0, At, B0); PG8_MMA(1, 1, At, B1); PG8_BAR; PG8_SCHED;
            PG8_LDB(B0, 1, 0); PG8_LDB(B1, 1, 1); PG8_SCHED; PG8_LDA(At, 1, 0); PG8_STAGE(PG8_SA(0, 1), a2 + hstep, voffA);
            PG8_WAIT_V(8); PG8_WAIT_L(0); PG8_BAR; PG8_MMA(0, 0, At, B0); PG8_MMA(0, 1, At, B1); PG8_BAR; PG8_SCHED;
            PG8_LDA(At, 1, 1); PG8_STAGE(PG8_SB(1, 0), b3, voffB); PG8_STAGE(PG8_SB(1, 1), b3 + hstep, voffB); PG8_STAGE(PG8_SA(1, 0), a3, voffA);
            PG8_WAIT_V(8); PG8_WAIT_L(0); PG8_BAR; PG8_MMA(1, 0, At, B0); PG8_MMA(1, 1, At, B1); PG8_BAR; PG8_SCHED;
            } else {
            PG8_LDB(B0, 0, 0); PG8_SCHED; PG8_LDA(At, 0, 0); PG8_STAGE(PG8_SA(1, 1), a1 + hstep, voffA);
            PG8_WAIT_L(8); PG8_BAR; PG8_WAIT_L(0); PG8_MMA(0, 0, At, B0); PG8_BAR; PG8_SCHED;
            PG8_LDB(B1, 0, 1); PG8_STAGE(PG8_SB(0, 0), b2, voffB);
            PG8_BAR; PG8_WAIT_L(0); PG8_MMA(0, 1, At, B1); PG8_BAR;
            PG8_LDA(At, 0, 1); PG8_STAGE(PG8_SA(0, 0), a2, voffA);
            PG8_BAR; PG8_WAIT_L(0); PG8_MMA(1, 0, At, B0); PG8_BAR; PG8_SCHED;
            PG8_STAGE(PG8_SB(0, 1), b2 + hstep, voffB);
            PG8_WAIT_V(6); PG8_BAR; PG8_MMA(1, 1, At, B1); PG8_BAR;
            PG8_LDB(B0, 1, 0); PG8_SCHED; PG8_LDA(At, 1, 0); PG8_STAGE(PG8_SA(0, 1), a2 + hstep, voffA);
            PG8_WAIT_L(8); PG8_BAR; PG8_WAIT_L(0); PG8_MMA(0, 0, At, B0); PG8_BAR; PG8_SCHED;
            PG8_LDB(B1, 1, 1); PG8_STAGE(PG8_SB(1, 0), b3, voffB);
            PG8_BAR; PG8_WAIT_L(0); PG8_MMA(0, 1, At, B1); PG8_BAR;
            PG8_LDA(At, 1, 1); PG8_STAGE(PG8_SA(1, 0), a3, voffA);
            PG8_BAR; PG8_WAIT_L(0); PG8_MMA(1, 0, At, B0); PG8_BAR; PG8_SCHED;
            PG8_STAGE(PG8_SB(1, 1), b3 + hstep, voffB);
            PG8_WAIT_V(6); PG8_BAR; PG8_MMA(1, 1, At, B1); PG8_BAR;
            }
        }
        if constexpr (ALIGN_EPI) { if (wr == 0) PG8_BAR; }
        if constexpr (!Epi::AFTER_DRAIN) { E(acc, cur, wr, wc, fr, fq); S.done(cur); }
        if (!has_next) break;
#pragma unroll
        for (int a = 0; a < 2; ++a)
#pragma unroll
            for (int b = 0; b < 2; ++b)
#pragma unroll
                for (int m = 0; m < 4; ++m)
#pragma unroll
                    for (int n = 0; n < 2; ++n) acc[a][b][m][n] = (f32x4){0.f, 0.f, 0.f, 0.f};
        cur = nxt; cA = nA; cB = nB; ++ui;
        if constexpr (ALIGN_EPI) { if (wr == 1) PG8_BAR; }
    }
    PG8_WAIT_V(0);
    if constexpr (!ALIGN_EPI) { if (wr == 0) PG8_BAR; }
    PG8_BAR;
    if constexpr (Epi::AFTER_DRAIN) { E.fused(acc, cur, wr, wc, fr, fq, lds, wid, lane); S.done(cur); }
#undef PG8_SA
#undef PG8_SB
#undef PG8_STAGE
#undef PG8_LDA
#undef PG8_LDB
#undef PG8_MMA
#undef PG8_WAIT_V
#undef PG8_WAIT_L
#undef PG8_BAR
#undef PG8_SCHED
}
}

#ifndef REP_P0
#define REP_P0 1
#endif
#ifndef REP_BIG
#define REP_BIG 1
#endif
#ifndef REP_SMALL
#define REP_SMALL 1
#endif
#ifndef REP_P2
#define REP_P2 1
#endif
#ifndef REP_P3
#define REP_P3 1
#endif
#define LAS __attribute__((address_space(3)))
typedef unsigned short bf16;
typedef float f32x4 __attribute__((ext_vector_type(4)));
typedef float f32x2 __attribute__((ext_vector_type(2)));
typedef unsigned u32x4 __attribute__((ext_vector_type(4)));
typedef unsigned u32x2 __attribute__((ext_vector_type(2)));
typedef short bf16x8 __attribute__((ext_vector_type(8)));
typedef short s16x4 __attribute__((ext_vector_type(4)));

constexpr int D = 1024, MP = 16384, MS = 512, M = MP + MS, SEQ = 2048, NIN = 3072, FF = 4096, CD = 512, NH = 4, HD = 128, CW = 31, NPOS = 2052;
constexpr float EPS = 1e-6f;
constexpr int NWAVES = 8, NTHREADS = 512;
constexpr int LDS_BYTES = 147456;
constexpr size_t MiB = 1u << 20;
constexpr size_t WS_CTL = 0, CTL_BYTES = 65536;
constexpr size_t WS_ROPE = 1 * MiB;
constexpr size_t WS_SSQ = 3 * MiB;
constexpr size_t WS_W = 4 * MiB, W_LAYER = 24 * MiB;
constexpr size_t W_IN = 0, W_OUT = 6 * MiB, W_UP = 8 * MiB, W_DN = 16 * MiB;
constexpr size_t WS_XN = 52 * MiB;
constexpr size_t WS_R1 = 85 * MiB;
constexpr size_t WS_H = WS_R1;
constexpr size_t ACT512 = (size_t)M * 512 * 2;
constexpr size_t WS_GLU = WS_R1, WS_Q = WS_GLU + ACT512, WS_K = WS_Q + ACT512, WS_V = WS_K + ACT512, WS_GATE = WS_V + ACT512;
constexpr size_t WS_MIX = WS_GATE + ACT512;
constexpr size_t WS_KV = WS_MIX + (size_t)M * 1024 * 2;
constexpr size_t WS_SB = WS_KV + 32 * MiB;
constexpr size_t WS_END = WS_SB + 16 * MiB;
static_assert(WS_END <= 256 * MiB, "ws map");
static_assert(WS_H + (size_t)M * FF * 2 <= WS_END, "ws map H");
constexpr size_t O_Y = 0, O_CP = (size_t)M * D, O_RP = O_CP + 2 * 8 * 30 * 512, O_CS = O_RP + 2 * 8 * 4 * 128 * 128, O_RS = O_CS + 2 * 128 * 30 * 512;

__device__ const float ROPE_INV[64] = {
1.0f, 0.865964353f, 0.749894202f, 0.649381638f, 0.562341332f, 0.486967534f, 0.421696514f, 0.365174115f, 0.316227764f, 0.273841977f, 0.237137377f, 0.2053525f, 0.177827939f, 0.153992653f, 0.133352146f, 0.115478195f, 0.100000001f, 0.0865964293f, 0.0749894232f, 0.0649381652f, 0.0562341325f, 0.0486967526f, 0.0421696492f, 0.0365174115f, 0.0316227749f, 0.0273841955f, 0.0237137377f, 0.0205352511f, 0.0177827943f, 0.0153992651f, 0.013335214f, 0.0115478197f, 0.00999999978f, 0.00865964312f, 0.00749894232f, 0.00649381615f, 0.00562341325f, 0.00486967526f, 0.00421696482f, 0.00365174119f, 0.00316227763f, 0.00273841969f, 0.00237137382f, 0.00205352507f, 0.00177827943f, 0.00153992651f, 0.00133352145f, 0.00115478202f, 0.00100000005f, 0.000865964335f, 0.000749894185f, 0.000649381604f, 0.000562341302f, 0.000486967532f, 0.000421696517f, 0.000365174114f, 0.000316227757f, 0.000273841957f, 0.00023713737f, 0.00020535251f, 0.00017782794f, 0.00015399266f, 0.00013335215f, 0.0001154782f
};

struct Args { const float* in[16]; float* out; unsigned char* ws; };

__device__ __forceinline__ float bf2f(unsigned short x) { return __uint_as_float(((unsigned)x) << 16); }
__device__ __forceinline__ float bflo(unsigned w) { return __uint_as_float(w << 16); }
__device__ __forceinline__ float bfhi(unsigned w) { return __uint_as_float(w & 0xffff0000u); }
typedef __bf16 bf16x2_t __attribute__((ext_vector_type(2)));
__device__ __forceinline__ unsigned pk_bf16(float lo, float hi) { const f32x2 v = {lo, hi}; return __builtin_bit_cast(unsigned, __builtin_convertvector(v, bf16x2_t)); }
__device__ __forceinline__ float wave_sum(float v) {
#pragma unroll
    for (int o = 1; o < 64; o <<= 1) v += __shfl_xor(v, o);
    return v;
}
__device__ __forceinline__ int ltid() { int t = threadIdx.x; asm volatile("" : "+v"(t)); return t; }
__device__ __forceinline__ float fast_rcp(float x) { return __builtin_amdgcn_rcpf(x); }
__device__ __forceinline__ float sigmoidf_(float x) { return fast_rcp(1.0f + __expf(-x)); }

struct EpiIn {
    static constexpr bool PERM = true, AFTER_DRAIN = false;
    const float* ssq; bf16 *glu, *q, *k, *v, *gate; const f32x2* rope; const float* gn_g;
    __device__ __forceinline__ void operator()(const f32x4 (&acc)[2][2][4][2], const pg8::Unit& u, int wr, int wc, int fr, int fq) const {
        const int pn = u.pn, cl = wc * 32 + fq * 8;
#pragma unroll
        for (int ai = 0; ai < 2; ++ai)
#pragma unroll
            for (int m = 0; m < 4; ++m) {
                const int row = u.pm * 256 + ai * 128 + wr * 64 + m * 16 + fr;
                const float rstd = rsqrtf(ssq[row] * (1.0f / D) + EPS);
                const f32x4 a0 = acc[ai][0][m][0] * rstd, a1 = acc[ai][0][m][1] * rstd, b0 = acc[ai][1][m][0] * rstd, b1 = acc[ai][1][m][1] * rstd;
                if (pn < 4) {
                    u32x4 w;
                    w.x = pk_bf16(a0[0] * sigmoidf_(b0[0]), a0[1] * sigmoidf_(b0[1])); w.y = pk_bf16(a0[2] * sigmoidf_(b0[2]), a0[3] * sigmoidf_(b0[3]));
                    w.z = pk_bf16(a1[0] * sigmoidf_(b1[0]), a1[1] * sigmoidf_(b1[1])); w.w = pk_bf16(a1[2] * sigmoidf_(b1[2]), a1[3] * sigmoidf_(b1[3]));
                    *(u32x4*)(glu + (size_t)row * 512 + pn * 128 + cl) = w;
                } else if (pn < 8) {
                    const int which = (pn - 4) >> 1, tp = pn & 1, head = 2 * tp + (wc >> 1), dlo = (wc & 1) * 32 + fq * 8;
                    const int prow = row < MP ? (row & (SEQ - 1)) : SEQ + ((row - MP) & 3);
                    const f32x4* rp = (const f32x4*)(rope + (size_t)prow * 64 + dlo);
                    const f32x4 c01 = rp[0], c23 = rp[1], c45 = rp[2], c67 = rp[3];
                    const float sc = which ? 0.08838834764831845f : 1.0f;
                    float o1[8], o2[8];
                    o1[0] = a0[0] * c01[0] - b0[0] * c01[1]; o2[0] = b0[0] * c01[0] + a0[0] * c01[1];
                    o1[1] = a0[1] * c01[2] - b0[1] * c01[3]; o2[1] = b0[1] * c01[2] + a0[1] * c01[3];
                    o1[2] = a0[2] * c23[0] - b0[2] * c23[1]; o2[2] = b0[2] * c23[0] + a0[2] * c23[1];
                    o1[3] = a0[3] * c23[2] - b0[3] * c23[3]; o2[3] = b0[3] * c23[2] + a0[3] * c23[3];
                    o1[4] = a1[0] * c45[0] - b1[0] * c45[1]; o2[4] = b1[0] * c45[0] + a1[0] * c45[1];
                    o1[5] = a1[1] * c45[2] - b1[1] * c45[3]; o2[5] = b1[1] * c45[2] + a1[1] * c45[3];
                    o1[6] = a1[2] * c67[0] - b1[2] * c67[1]; o2[6] = b1[2] * c67[0] + a1[2] * c67[1];
                    o1[7] = a1[3] * c67[2] - b1[3] * c67[3]; o2[7] = b1[3] * c67[2] + a1[3] * c67[3];
                    bf16* dst = (which ? k : q) + (size_t)row * 512 + head * 128 + dlo;
                    u32x4 w1, w2;
                    w1.x = pk_bf16(o1[0] * sc, o1[1] * sc); w1.y = pk_bf16(o1[2] * sc, o1[3] * sc); w1.z = pk_bf16(o1[4] * sc, o1[5] * sc); w1.w = pk_bf16(o1[6] * sc, o1[7] * sc);
                    w2.x = pk_bf16(o2[0] * sc, o2[1] * sc); w2.y = pk_bf16(o2[2] * sc, o2[3] * sc); w2.z = pk_bf16(o2[4] * sc, o2[5] * sc); w2.w = pk_bf16(o2[6] * sc, o2[7] * sc);
                    *(u32x4*)dst = w1; *(u32x4*)(dst + 64) = w2;
                } else if (pn < 10) {
                    bf16* dst = v + (size_t)row * 512 + (pn - 8) * 256 + cl;
                    u32x4 w1, w2;
                    w1.x = pk_bf16(a0[0], a0[1]); w1.y = pk_bf16(a0[2], a0[3]); w1.z = pk_bf16(a1[0], a1[1]); w1.w = pk_bf16(a1[2], a1[3]);
                    w2.x = pk_bf16(b0[0], b0[1]); w2.y = pk_bf16(b0[2], b0[3]); w2.z = pk_bf16(b1[0], b1[1]); w2.w = pk_bf16(b1[2], b1[3]);
                    *(u32x4*)dst = w1; *(u32x4*)(dst + 128) = w2;
                } else {
                    const int c0 = (pn - 10) * 256 + cl;
                    const f32x4 g0 = *(const f32x4*)(gn_g + c0), g1 = *(const f32x4*)(gn_g + c0 + 4), g2 = *(const f32x4*)(gn_g + c0 + 128), g3 = *(const f32x4*)(gn_g + c0 + 132);
                    bf16* dst = gate + (size_t)row * 512 + c0;
                    u32x4 w1, w2;
                    w1.x = pk_bf16(a0[0] * sigmoidf_(a0[0]) * g0[0], a0[1] * sigmoidf_(a0[1]) * g0[1]); w1.y = pk_bf16(a0[2] * sigmoidf_(a0[2]) * g0[2], a0[3] * sigmoidf_(a0[3]) * g0[3]);
                    w1.z = pk_bf16(a1[0] * sigmoidf_(a1[0]) * g1[0], a1[1] * sigmoidf_(a1[1]) * g1[1]); w1.w = pk_bf16(a1[2] * sigmoidf_(a1[2]) * g1[2], a1[3] * sigmoidf_(a1[3]) * g1[3]);
                    w2.x = pk_bf16(b0[0] * sigmoidf_(b0[0]) * g2[0], b0[1] * sigmoidf_(b0[1]) * g2[1]); w2.y = pk_bf16(b0[2] * sigmoidf_(b0[2]) * g2[2], b0[3] * sigmoidf_(b0[3]) * g2[3]);
                    w2.z = pk_bf16(b1[0] * sigmoidf_(b1[0]) * g3[0], b1[1] * sigmoidf_(b1[1]) * g3[1]); w2.w = pk_bf16(b1[2] * sigmoidf_(b1[2]) * g3[2], b1[3] * sigmoidf_(b1[3]) * g3[3]);
                    *(u32x4*)dst = w1; *(u32x4*)(dst + 128) = w2;
                }
            }
    }

    __device__ __forceinline__ int brow(int cg, int fb) const { return 256 * (cg >> 2) + 32 * (cg & 3) + (fb >> 1) * 128 + (fb & 1) * 16; }
    __device__ __forceinline__ void small(int row, int cg, int s4, f32x4 a, f32x4 b) const {
        const int pn = cg >> 2, cl = 32 * (cg & 3) + s4;
        const float rstd = rsqrtf(ssq[row] * (1.0f / D) + EPS);
        a = a * rstd; b = b * rstd;
        if (pn < 4) {
            u32x2 w; w.x = pk_bf16(a[0] * sigmoidf_(b[0]), a[1] * sigmoidf_(b[1])); w.y = pk_bf16(a[2] * sigmoidf_(b[2]), a[3] * sigmoidf_(b[3]));
            *(u32x2*)(glu + (size_t)row * 512 + pn * 128 + cl) = w;
        } else if (pn < 8) {
            const int which = (pn - 4) >> 1, tp = pn & 1, head = 2 * tp + (cl >> 6), dlo = cl & 63;
            const int prow = row < MP ? (row & (SEQ - 1)) : SEQ + ((row - MP) & 3);
            const f32x4* rp = (const f32x4*)(rope + (size_t)prow * 64 + dlo);
            const f32x4 c01 = rp[0], c23 = rp[1];
            const float sc = which ? 0.08838834764831845f : 1.0f;
            const float p0 = a[0] * c01[0] - b[0] * c01[1], r0 = b[0] * c01[0] + a[0] * c01[1];
            const float p1 = a[1] * c01[2] - b[1] * c01[3], r1 = b[1] * c01[2] + a[1] * c01[3];
            const float p2 = a[2] * c23[0] - b[2] * c23[1], r2 = b[2] * c23[0] + a[2] * c23[1];
            const float p3 = a[3] * c23[2] - b[3] * c23[3], r3 = b[3] * c23[2] + a[3] * c23[3];
            bf16* dst = (which ? k : q) + (size_t)row * 512 + head * 128 + dlo;
            u32x2 w1, w2; w1.x = pk_bf16(p0 * sc, p1 * sc); w1.y = pk_bf16(p2 * sc, p3 * sc); w2.x = pk_bf16(r0 * sc, r1 * sc); w2.y = pk_bf16(r2 * sc, r3 * sc);
            *(u32x2*)dst = w1; *(u32x2*)(dst + 64) = w2;
        } else if (pn < 10) {
            bf16* dst = v + (size_t)row * 512 + (pn - 8) * 256 + cl;
            u32x2 w1, w2; w1.x = pk_bf16(a[0], a[1]); w1.y = pk_bf16(a[2], a[3]); w2.x = pk_bf16(b[0], b[1]); w2.y = pk_bf16(b[2], b[3]);
            *(u32x2*)dst = w1; *(u32x2*)(dst + 128) = w2;
        } else {
            const int c0 = (pn - 10) * 256 + cl;
            const f32x4 g0 = *(const f32x4*)(gn_g + c0), g2 = *(const f32x4*)(gn_g + c0 + 128);
            bf16* dst = gate + (size_t)row * 512 + c0;
            u32x2 w1, w2;
            w1.x = pk_bf16(a[0] * sigmoidf_(a[0]) * g0[0], a[1] * sigmoidf_(a[1]) * g0[1]); w1.y = pk_bf16(a[2] * sigmoidf_(a[2]) * g0[2], a[3] * sigmoidf_(a[3]) * g0[3]);
            w2.x = pk_bf16(b[0] * sigmoidf_(b[0]) * g2[0], b[1] * sigmoidf_(b[1]) * g2[1]); w2.y = pk_bf16(b[2] * sigmoidf_(b[2]) * g2[2], b[3] * sigmoidf_(b[3]) * g2[3]);
            *(u32x2*)dst = w1; *(u32x2*)(dst + 128) = w2;
        }
    }
};

struct EpiRes {
    static constexpr bool PERM = true, AFTER_DRAIN = false;
    bf16* xs; float* ssq;
    __device__ __forceinline__ void operator()(const f32x4 (&acc)[2][2][4][2], const pg8::Unit& u, int wr, int wc, int fr, int fq) const {
        const int colb = u.pn * 256 + wc * 32 + fq * 8;
#pragma unroll
        for (int ai = 0; ai < 2; ++ai)
#pragma unroll
            for (int m = 0; m < 4; ++m) {
                const int row = u.pm * 256 + ai * 128 + wr * 64 + m * 16 + fr;
                float ss = 0.f;
#pragma unroll
                for (int bj = 0; bj < 2; ++bj) {
                    bf16* p = xs + (size_t)row * D + colb + bj * 128;
                    const u32x4 rv = *(const u32x4*)p;
                    const f32x4 a0 = acc[ai][bj][m][0], a1 = acc[ai][bj][m][1];
                    const float x0 = bflo(rv.x) + a0[0], x1 = bfhi(rv.x) + a0[1], x2 = bflo(rv.y) + a0[2], x3 = bfhi(rv.y) + a0[3];
                    const float x4 = bflo(rv.z) + a1[0], x5 = bfhi(rv.z) + a1[1], x6 = bflo(rv.w) + a1[2], x7 = bfhi(rv.w) + a1[3];
                    ss += (x0 * x0 + x1 * x1) + (x2 * x2 + x3 * x3) + (x4 * x4 + x5 * x5) + (x6 * x6 + x7 * x7);
                    u32x4 w; w.x = pk_bf16(x0, x1); w.y = pk_bf16(x2, x3); w.z = pk_bf16(x4, x5); w.w = pk_bf16(x6, x7);
                    *(u32x4*)p = w;
                }
                ss += __shfl_xor(ss, 16); ss += __shfl_xor(ss, 32);
                if (fq == 0) unsafeAtomicAdd(ssq + row, ss);
            }
    }
    __device__ __forceinline__ int brow(int cg, int fb) const { return 64 * cg + 16 * fb; }
    __device__ __forceinline__ void small(int row, int cg, int s4, f32x4 a, f32x4 b) const {
        bf16* p = xs + (size_t)row * D + 64 * cg + s4;
        const u32x2 r0 = *(const u32x2*)p, r1 = *(const u32x2*)(p + 32);
        const float x0 = bflo(r0.x) + a[0], x1 = bfhi(r0.x) + a[1], x2 = bflo(r0.y) + a[2], x3 = bfhi(r0.y) + a[3];
        const float x4 = bflo(r1.x) + b[0], x5 = bfhi(r1.x) + b[1], x6 = bflo(r1.y) + b[2], x7 = bfhi(r1.y) + b[3];
        float ss = (x0 * x0 + x1 * x1) + (x2 * x2 + x3 * x3) + (x4 * x4 + x5 * x5) + (x6 * x6 + x7 * x7);
        u32x2 w0, w1; w0.x = pk_bf16(x0, x1); w0.y = pk_bf16(x2, x3); w1.x = pk_bf16(x4, x5); w1.y = pk_bf16(x6, x7);
        *(u32x2*)p = w0; *(u32x2*)(p + 32) = w1;
        ss += __shfl_xor(ss, 1); ss += __shfl_xor(ss, 2); ss += __shfl_xor(ss, 4);
        if ((s4 >> 2) == 0) unsafeAtomicAdd(ssq + row, ss);
    }
};

struct EpiUp {
    static constexpr bool PERM = true, AFTER_DRAIN = false;
    const float* ssq; bf16* h;
    __device__ __forceinline__ void operator()(const f32x4 (&acc)[2][2][4][2], const pg8::Unit& u, int wr, int wc, int fr, int fq) const {
        const int colb = u.pn * 256 + wc * 32 + fq * 8;
#pragma unroll
        for (int ai = 0; ai < 2; ++ai)
#pragma unroll
            for (int m = 0; m < 4; ++m) {
                const int row = u.pm * 256 + ai * 128 + wr * 64 + m * 16 + fr;
                const float rstd = rsqrtf(ssq[row] * (1.0f / D) + EPS);
#pragma unroll
                for (int bj = 0; bj < 2; ++bj) {
                    f32x4 x0 = acc[ai][bj][m][0] * rstd, x1 = acc[ai][bj][m][1] * rstd;
#pragma unroll
                    for (int e = 0; e < 4; ++e) { const float t0 = fmaxf(x0[e], 0.f), t1 = fmaxf(x1[e], 0.f); x0[e] = t0 * t0; x1[e] = t1 * t1; }
                    u32x4 w; w.x = pk_bf16(x0[0], x0[1]); w.y = pk_bf16(x0[2], x0[3]); w.z = pk_bf16(x1[0], x1[1]); w.w = pk_bf16(x1[2], x1[3]);
                    *(u32x4*)(h + (size_t)row * FF + colb + bj * 128) = w;
                }
            }
    }

    __device__ __forceinline__ int brow(int cg, int fb) const { return 64 * cg + 16 * fb; }
    __device__ __forceinline__ void small(int row, int cg, int s4, f32x4 a, f32x4 b) const {
        const float rstd = rsqrtf(ssq[row] * (1.0f / D) + EPS);
        const int col = 64 * cg + s4;
#pragma unroll
        for (int e = 0; e < 4; ++e) { const float t0 = fmaxf(a[e] * rstd, 0.f), t1 = fmaxf(b[e] * rstd, 0.f); a[e] = t0 * t0; b[e] = t1 * t1; }
        u32x2 w0, w1; w0.x = pk_bf16(a[0], a[1]); w0.y = pk_bf16(a[2], a[3]); w1.x = pk_bf16(b[0], b[1]); w1.y = pk_bf16(b[2], b[3]);
        *(u32x2*)(h + (size_t)row * FF + col) = w0; *(u32x2*)(h + (size_t)row * FF + col + 32) = w1;
    }
};

constexpr int SG_LD = 68;
template <class Epi, int RT>
__device__ __forceinline__ void small_gemm(LAS unsigned char* lds, const bf16* A, const bf16* Bt, int K, int ncg, const Epi& E) {
    const int tid = ltid(), lane = tid & 63, wave = __builtin_amdgcn_readfirstlane(tid >> 6), r = lane & 15, q = lane >> 4;
    constexpr int KS = RT == 2 ? 4 : 8;
    const int kw = K / KS, kq = RT == 2 ? (wave & 3) : wave, rh = RT == 2 ? (wave >> 2) : 0;
    for (int it = blockIdx.x; it < (8 / RT) * ncg; it += gridDim.x) {
        const int rt = it / ncg, cg = it % ncg;
        const int rowbase = MP + 64 * RT * rt;
        const bf16* ap = A + (size_t)(rowbase + 64 * rh + r) * K + kq * kw + 8 * q;
        const bf16* bp0 = Bt + (size_t)(E.brow(cg, 0) + r) * K + kq * kw + 8 * q;
        const bf16* bp1 = Bt + (size_t)(E.brow(cg, 1) + r) * K + kq * kw + 8 * q;
        const bf16* bp2 = Bt + (size_t)(E.brow(cg, 2) + r) * K + kq * kw + 8 * q;
        const bf16* bp3 = Bt + (size_t)(E.brow(cg, 3) + r) * K + kq * kw + 8 * q;
        f32x4 acc[4][4];
#pragma unroll
        for (int i = 0; i < 4; ++i)
#pragma unroll
            for (int j = 0; j < 4; ++j) acc[i][j] = (f32x4){0.f, 0.f, 0.f, 0.f};
        {
            LAS unsigned char* st = lds + wave * 9216;
            const int lrow = lane >> 3, lch = lane & 7;
            const bf16* ag = A + (size_t)(rowbase + 64 * rh + lrow) * K + kq * kw + lch * 8;
            const bf16* bg0 = Bt + (size_t)(E.brow(cg, 0) + lrow) * K + kq * kw + lch * 8;
            const bf16* bg1 = Bt + (size_t)(E.brow(cg, 1) + lrow) * K + kq * kw + lch * 8;
            const bf16* bg2 = Bt + (size_t)(E.brow(cg, 2) + lrow) * K + kq * kw + lch * 8;
            const bf16* bg3 = Bt + (size_t)(E.brow(cg, 3) + lrow) * K + kq * kw + lch * 8;
            const int wro = lrow * 144 + lch * 16, fro = r * 144 + q * 16;
            u32x4 ga[8], gb[8];
#define SG_GLOAD_A(kk) do { _Pragma("unroll") for (int i = 0; i < 8; ++i) ga[i] = *(const u32x4*)(ag + (size_t)(8 * i) * K + (kk)); } while (0)
#define SG_GLOAD_B(kk) do { \
            gb[0] = *(const u32x4*)(bg0 + (kk)); gb[1] = *(const u32x4*)(bg0 + (size_t)8 * K + (kk)); gb[2] = *(const u32x4*)(bg1 + (kk)); gb[3] = *(const u32x4*)(bg1 + (size_t)8 * K + (kk)); \
            gb[4] = *(const u32x4*)(bg2 + (kk)); gb[5] = *(const u32x4*)(bg2 + (size_t)8 * K + (kk)); gb[6] = *(const u32x4*)(bg3 + (kk)); gb[7] = *(const u32x4*)(bg3 + (size_t)8 * K + (kk)); } while (0)
            SG_GLOAD_A(0); SG_GLOAD_B(0);
#pragma unroll 1
            for (int kk = 0; kk < kw; kk += 64) {
                bf16x8 a[2][4], b[2][4];
#pragma unroll
                for (int i = 0; i < 8; ++i) *(LAS u32x4*)(st + i * (8 * 144) + wro) = ga[i];
                if (kk + 64 < kw) SG_GLOAD_A(kk + 64);
#pragma unroll
                for (int ks = 0; ks < 2; ++ks)
#pragma unroll
                    for (int fa = 0; fa < 4; ++fa) a[ks][fa] = *(const LAS bf16x8*)(st + fa * (16 * 144) + fro + ks * 64);
                asm volatile("s_waitcnt lgkmcnt(0)" ::: "memory");
#pragma unroll
                for (int i = 0; i < 8; ++i) *(LAS u32x4*)(st + i * (8 * 144) + wro) = gb[i];
                if (kk + 64 < kw) SG_GLOAD_B(kk + 64);
#pragma unroll
                for (int ks = 0; ks < 2; ++ks)
#pragma unroll
                    for (int fb = 0; fb < 4; ++fb) b[ks][fb] = *(const LAS bf16x8*)(st + fb * (16 * 144) + fro + ks * 64);
                asm volatile("s_waitcnt lgkmcnt(0)" ::: "memory");
#pragma unroll
                for (int ks = 0; ks < 2; ++ks)
#pragma unroll
                    for (int fa = 0; fa < 4; ++fa)
#pragma unroll
                        for (int fb = 0; fb < 4; ++fb) acc[fa][fb] = __builtin_amdgcn_mfma_f32_16x16x32_bf16(b[ks][fb], a[ks][fa], acc[fa][fb], 0, 0, 0);
            }
#undef SG_GLOAD_A
#undef SG_GLOAD_B
        }
        __syncthreads();
        LAS float* part = (LAS float*)lds + wave * (64 * SG_LD);
#pragma unroll
        for (int fa = 0; fa < 4; ++fa)
#pragma unroll
            for (int fb = 0; fb < 4; ++fb) *(LAS f32x4*)(part + (16 * fa + r) * SG_LD + 16 * fb + 4 * q) = acc[fa][fb];
        __syncthreads();
        if (RT == 1) {
            const int row = tid >> 3, s4 = (tid & 7) * 4;
            f32x4 va = (f32x4){0.f, 0.f, 0.f, 0.f}, vb = va;
#pragma unroll
            for (int w = 0; w < 8; ++w) { const LAS float* p = (const LAS float*)lds + w * (64 * SG_LD) + row * SG_LD + s4; va += *(const LAS f32x4*)p; vb += *(const LAS f32x4*)(p + 32); }
            E.small(rowbase + row, cg, s4, va, vb);
        } else {
            const int row = tid >> 2, rr = row & 63, hh = row >> 6;
#pragma unroll
            for (int j = 0; j < 2; ++j) {
                const int s4 = (tid & 3) * 4 + 16 * j;
                f32x4 va = (f32x4){0.f, 0.f, 0.f, 0.f}, vb = va;
#pragma unroll
                for (int w = 0; w < 4; ++w) { const LAS float* p = (const LAS float*)lds + (hh * 4 + w) * (64 * SG_LD) + rr * SG_LD + s4; va += *(const LAS f32x4*)p; vb += *(const LAS f32x4*)(p + 32); }
                E.small(rowbase + row, cg, s4, va, vb);
            }
        }
        __syncthreads();
    }
}

__device__ __forceinline__ void small_gemm32(LAS unsigned char* lds, const bf16* A, const bf16* Bt, int K, const EpiRes& E) {
    const int tid = ltid(), lane = tid & 63, wave = __builtin_amdgcn_readfirstlane(tid >> 6), r = lane & 15, q = lane >> 4;
    const int kw = K >> 3;
    for (int it = blockIdx.x; it < 256; it += gridDim.x) {
        const int rt = it >> 5, cg = it & 31;
        const int rowbase = MP + 64 * rt;
        f32x4 acc[4][2];
#pragma unroll
        for (int i = 0; i < 4; ++i) { acc[i][0] = (f32x4){0.f, 0.f, 0.f, 0.f}; acc[i][1] = (f32x4){0.f, 0.f, 0.f, 0.f}; }
        {
            LAS unsigned char* st = lds + wave * 9216;
            const int lrow = lane >> 3, lch = lane & 7;
            const bf16* ag = A + (size_t)(rowbase + lrow) * K + wave * kw + lch * 8;
            const bf16* bg = Bt + (size_t)(32 * cg + lrow) * K + wave * kw + lch * 8;
            const int wro = lrow * 144 + lch * 16, fro = r * 144 + q * 16;
            u32x4 ga0[8], gb0[4], ga1[8], gb1[4];
#define SG_GLOAD(ga, gb, kk) do { _Pragma("unroll") for (int i = 0; i < 8; ++i) ga[i] = *(const u32x4*)(ag + (size_t)(8 * i) * K + (kk)); \
            _Pragma("unroll") for (int i = 0; i < 4; ++i) gb[i] = *(const u32x4*)(bg + (size_t)(8 * i) * K + (kk)); } while (0)
#define SG_STEP(ga, gb, knext) do { bf16x8 a[2][4], b[2][2]; \
            _Pragma("unroll") for (int i = 0; i < 8; ++i) *(LAS u32x4*)(st + i * (8 * 144) + wro) = ga[i]; \
            _Pragma("unroll") for (int ks = 0; ks < 2; ++ks) _Pragma("unroll") for (int fa = 0; fa < 4; ++fa) a[ks][fa] = *(const LAS bf16x8*)(st + fa * (16 * 144) + fro + ks * 64); \
            asm volatile("s_waitcnt lgkmcnt(0)" ::: "memory"); \
            _Pragma("unroll") for (int i = 0; i < 4; ++i) *(LAS u32x4*)(st + i * (8 * 144) + wro) = gb[i]; \
            _Pragma("unroll") for (int ks = 0; ks < 2; ++ks) _Pragma("unroll") for (int fb = 0; fb < 2; ++fb) b[ks][fb] = *(const LAS bf16x8*)(st + fb * (16 * 144) + fro + ks * 64); \
            asm volatile("s_waitcnt lgkmcnt(0)" ::: "memory"); \
            if ((knext) < kw) SG_GLOAD(ga, gb, (knext)); \
            _Pragma("unroll") for (int ks = 0; ks < 2; ++ks) _Pragma("unroll") for (int fa = 0; fa < 4; ++fa) _Pragma("unroll") for (int fb = 0; fb < 2; ++fb) \
                acc[fa][fb] = __builtin_amdgcn_mfma_f32_16x16x32_bf16(b[ks][fb], a[ks][fa], acc[fa][fb], 0, 0, 0); } while (0)
            SG_GLOAD(ga0, gb0, 0); SG_GLOAD(ga1, gb1, 64);
#pragma unroll 1
            for (int kk = 0; kk < kw; kk += 128) {
                SG_STEP(ga0, gb0, kk + 128);
                SG_STEP(ga1, gb1, kk + 192);
            }
#undef SG_GLOAD
#undef SG_STEP
        }
        __syncthreads();
        LAS float* part = (LAS float*)lds + wave * (64 * 36);
#pragma unroll
        for (int fa = 0; fa < 4; ++fa)
#pragma unroll
            for (int fb = 0; fb < 2; ++fb) *(LAS f32x4*)(part + (16 * fa + r) * 36 + 16 * fb + 4 * q) = acc[fa][fb];
        __syncthreads();
        const int row = tid >> 3, s4 = (tid & 7) * 4;
        f32x4 va = (f32x4){0.f, 0.f, 0.f, 0.f};
#pragma unroll
        for (int w = 0; w < 8; ++w) va += *(const LAS f32x4*)((const LAS float*)lds + w * (64 * 36) + row * 36 + s4);
        {
            const int grow = rowbase + row;
            bf16* p = E.xs + (size_t)grow * D + 32 * cg + s4;
            const u32x2 r0 = *(const u32x2*)p;
            const float x0 = bflo(r0.x) + va[0], x1 = bfhi(r0.x) + va[1], x2 = bflo(r0.y) + va[2], x3 = bfhi(r0.y) + va[3];
            float ss = (x0 * x0 + x1 * x1) + (x2 * x2 + x3 * x3);
            u32x2 w0; w0.x = pk_bf16(x0, x1); w0.y = pk_bf16(x2, x3);
            *(u32x2*)p = w0;
            ss += __shfl_xor(ss, 1); ss += __shfl_xor(ss, 2); ss += __shfl_xor(ss, 4);
            if ((tid & 7) == 0) unsafeAtomicAdd(E.ssq + grow, ss);
        }
        __syncthreads();
    }
}

__device__ __forceinline__ int win_dest_row(int s) {
    if (s < 512) return ((s >> 7) << 8) + (s & 127);
    if (s < 1024) { const int t = s - 512; return ((t >> 7) << 8) + 128 + (t & 127); }
    if (s < 2048) { const int t = s - 1024; const int which = t >> 9, hd = (t >> 7) & 3, d = t & 127; return 1024 + which * 512 + (hd >> 1) * 256 + (d >> 6) * 128 + (hd & 1) * 64 + (d & 63); }
    return s;
}
__device__ __forceinline__ void p0_transpose_item(const float* W, const float* gk, int K, int N, bf16* WT, bool perm, LAS float* scr, int item, int lane) {
    const int nblk = N / 32, kb = item / nblk, nb = item % nblk, k0 = 64 * kb, n0 = 32 * nb;
#pragma unroll
    for (int i = 0; i < 32; ++i) { const int kk = 2 * i + (lane >> 5); const float gg = gk ? gk[k0 + kk] : 1.0f; scr[kk * 33 + (lane & 31)] = gg * __builtin_nontemporal_load(W + (size_t)(k0 + kk) * N + n0 + (lane & 31)); }
    asm volatile("s_waitcnt lgkmcnt(0)" ::: "memory");
    const int c = lane & 7;
    const int drow0 = perm ? win_dest_row(n0) : n0;
#pragma unroll
    for (int j = 0; j < 4; ++j) { const int n = (lane >> 3) + 8 * j; const LAS float* s = scr + (8 * c) * 33 + n;
        u32x4 o; o.x = pk_bf16(s[0 * 33], s[1 * 33]); o.y = pk_bf16(s[2 * 33], s[3 * 33]); o.z = pk_bf16(s[4 * 33], s[5 * 33]); o.w = pk_bf16(s[6 * 33], s[7 * 33]);
        *(u32x4*)(WT + (size_t)(drow0 + n) * K + k0 + 8 * c) = o; }
    asm volatile("s_waitcnt lgkmcnt(0)" ::: "memory");
}
__device__ __forceinline__ void sincos_acc(float ang, float& c, float& s) {
    const double a = (double)ang;
    const double kd = __builtin_rint(a * 0.63661977236758134308);
    double r = __builtin_fma(-kd, 1.57079632679489655800, a);
    r = __builtin_fma(-kd, 6.12323399573676603587e-17, r);
    const int n = ((int)kd) & 3;
    const double r2 = r * r;
    double sp = -1.0 / 1307674368000.0;
    sp = sp * r2 + 1.0 / 6227020800.0; sp = sp * r2 - 1.0 / 39916800.0; sp = sp * r2 + 1.0 / 362880.0; sp = sp * r2 - 1.0 / 5040.0; sp = sp * r2 + 1.0 / 120.0; sp = sp * r2 - 1.0 / 6.0; sp = sp * r2 + 1.0;
    const double sn = r * sp;
    double cp = 1.0 / 20922789888000.0;
    cp = cp * r2 - 1.0 / 87178291200.0; cp = cp * r2 + 1.0 / 479001600.0; cp = cp * r2 - 1.0 / 3628800.0; cp = cp * r2 + 1.0 / 40320.0; cp = cp * r2 - 1.0 / 720.0; cp = cp * r2 + 1.0 / 24.0; cp = cp * r2 - 0.5; cp = cp * r2 + 1.0;
    const double cs = cp;
    double so, co;
    if (n == 0) { so = sn; co = cs; } else if (n == 1) { so = cs; co = -sn; } else if (n == 2) { so = -sn; co = -cs; } else { so = -cs; co = sn; }
    c = (float)co; s = (float)so;
}

__device__ __forceinline__ void p0_prologue(const Args& a, LAS unsigned char* lds, int wave, int lane) {
    unsigned char* ws = a.ws;
    const int G = gridDim.x, gw = blockIdx.x * NWAVES + wave, NGW = G * NWAVES;
    const int gt = blockIdx.x * NTHREADS + threadIdx.x, NGT = G * NTHREADS;
    float* ssq = (float*)(ws + WS_SSQ);
    for (int i = gt; i < 4 * M; i += NGT) ssq[M + i] = 0.f;
    f32x2* rope = (f32x2*)(ws + WS_ROPE);
    for (int i = gt; i < NPOS * 64; i += NGT) {
        const int p = i >> 6, dd = i & 63;
        const float pos = p < SEQ ? (float)p : (float)(16384 + (p - SEQ));
        const float ang = pos * ROPE_INV[dd];
        float c, s; sincos_acc(ang, c, s);
        rope[i] = (f32x2){c, s};
    }
    LAS float* scr = (LAS float*)(lds + wave * 16384);
    constexpr int I_IN = (D / 64) * (NIN / 32), I_O = (D / 64) * (D / 32), I_UP = (D / 64) * (FF / 32), I_DN = (FF / 64) * (D / 32), I_L = I_IN + I_O + I_UP + I_DN;
    for (int it = gw; it < 2 * I_L; it += NGW) {
        const int l = it / I_L; int r = it % I_L;
        unsigned char* wl = ws + WS_W + (size_t)l * W_LAYER;
        if (r < I_IN) { p0_transpose_item(a.in[5] + (size_t)l * D * NIN, a.in[4] + l * D, D, NIN, (bf16*)(wl + W_IN), true, scr, r, lane); continue; } r -= I_IN;
        if (r < I_O) { p0_transpose_item(a.in[11] + (size_t)l * D * D, nullptr, D, D, (bf16*)(wl + W_OUT), false, scr, r, lane); continue; } r -= I_O;
        if (r < I_UP) { p0_transpose_item(a.in[13] + (size_t)l * D * FF, a.in[12] + l * D, D, FF, (bf16*)(wl + W_UP), false, scr, r, lane); continue; } r -= I_UP;
        p0_transpose_item(a.in[14] + (size_t)l * FF * D, nullptr, FF, D, (bf16*)(wl + W_DN), false, scr, r, lane);
    }
    bf16* XN = (bf16*)(ws + WS_XN);
    for (int m = gw; m < M; m += 2 * NGW) {
        const int m2 = m + NGW; const bool has2 = m2 < M; const int mb = has2 ? m2 : m;
        const float* xa = m < MP ? a.in[0] + (size_t)m * D : a.in[1] + (size_t)(m - MP) * D;
        const float* xb = mb < MP ? a.in[0] + (size_t)mb * D : a.in[1] + (size_t)(mb - MP) * D;
        f32x4 va[4], vb[4];
#pragma unroll
        for (int j = 0; j < 4; ++j) { va[j] = __builtin_nontemporal_load((const f32x4*)(xa + 4 * lane + 256 * j)); vb[j] = __builtin_nontemporal_load((const f32x4*)(xb + 4 * lane + 256 * j)); }
        float sa = 0.f, sb = 0.f;
#pragma unroll
        for (int j = 0; j < 4; ++j) {
            sa += (va[j][0] * va[j][0] + va[j][1] * va[j][1]) + (va[j][2] * va[j][2] + va[j][3] * va[j][3]);
            sb += (vb[j][0] * vb[j][0] + vb[j][1] * vb[j][1]) + (vb[j][2] * vb[j][2] + vb[j][3] * vb[j][3]);
            u32x2 w; w.x = pk_bf16(va[j][0], va[j][1]); w.y = pk_bf16(va[j][2], va[j][3]);
            *(u32x2*)(XN + (size_t)m * D + 4 * lane + 256 * j) = w;
            if (has2) { u32x2 w2; w2.x = pk_bf16(vb[j][0], vb[j][1]); w2.y = pk_bf16(vb[j][2], vb[j][3]); *(u32x2*)(XN + (size_t)mb * D + 4 * lane + 256 * j) = w2; }
        }
        sa = wave_sum(sa); sb = wave_sum(sb);
        if (lane == 0) { ssq[m] = sa; if (has2) ssq[mb] = sb; }
    }
}

template <int NT, bool SAMPLE>
__device__ __forceinline__ void conv_item(LAS unsigned char* lds, int b, int tt, const bf16* glu, const float* cache, const float* cw, const float* cb, const float* lng, const float* lnb,
                                          bf16* mix, float* out_conv, int wave, int lane) {
    const int c = ltid(); lane = c & 63; wave = __builtin_amdgcn_readfirstlane(c >> 6);
    constexpr int NI = NT + 30;
    float in[NI];
    const int t0 = tt * NT;
    if (SAMPLE) {
#pragma unroll
        for (int j = 0; j < 30; ++j) in[j] = __builtin_nontemporal_load(cache + ((size_t)b * 30 + j) * 512 + c);
#pragma unroll
        for (int j = 0; j < NT; ++j) in[30 + j] = bf2f(glu[((size_t)MP + 4 * b + j) * 512 + c]);
    } else {
#pragma unroll
        for (int j = 0; j < NI; ++j) { const int t = t0 - 30 + j; in[j] = t >= 0 ? bf2f(glu[((size_t)b * SEQ + t) * 512 + c]) : 0.f; }
    }
    float w[CW];
#pragma unroll
    for (int k = 0; k < CW; ++k) w[k] = cw[k * 512 + c];
    const float bias = cb[c];
    LAS float* co = (LAS float*)lds;
#pragma unroll
    for (int t = 0; t < NT; ++t) {
        float acc = bias;
#pragma unroll
        for (int k = 0; k < CW; ++k) acc += w[k] * in[t + k];
        co[t * 512 + c] = acc;
    }
    if (SAMPLE) {
#pragma unroll
        for (int jj = 0; jj < 30; ++jj) __builtin_nontemporal_store(in[jj + NT], out_conv + ((size_t)b * 30 + jj) * 512 + c);
    } else if (tt == SEQ / NT - 1) {
#pragma unroll
        for (int jj = 0; jj < 30; ++jj) __builtin_nontemporal_store(in[jj + NT], out_conv + ((size_t)b * 30 + jj) * 512 + c);
    }
    __syncthreads();
    for (int t = wave; t < NT; t += NWAVES) {
        const size_t row = SAMPLE ? (size_t)MP + 4 * b + t : (size_t)b * SEQ + t0 + t;
        f32x4 v0 = *(const LAS f32x4*)(co + t * 512 + lane * 8), v1 = *(const LAS f32x4*)(co + t * 512 + lane * 8 + 4);
        float s = (v0[0] + v0[1]) + (v0[2] + v0[3]) + (v1[0] + v1[1]) + (v1[2] + v1[3]);
        s = wave_sum(s);
        const float mean = s * (1.0f / 512.0f);
        v0 = v0 - mean; v1 = v1 - mean;
        float q = (v0[0] * v0[0] + v0[1] * v0[1]) + (v0[2] * v0[2] + v0[3] * v0[3]) + (v1[0] * v1[0] + v1[1] * v1[1]) + (v1[2] * v1[2] + v1[3] * v1[3]);
        q = wave_sum(q);
        const float rstd = rsqrtf(q * (1.0f / 512.0f) + EPS);
        const f32x4 g0 = *(const f32x4*)(lng + lane * 8), g1 = *(const f32x4*)(lng + lane * 8 + 4), b0 = *(const f32x4*)(lnb + lane * 8), b1 = *(const f32x4*)(lnb + lane * 8 + 4);
        f32x4 y0 = v0 * rstd * g0 + b0, y1 = v1 * rstd * g1 + b1;
#pragma unroll
        for (int e = 0; e < 4; ++e) { y0[e] = y0[e] * sigmoidf_(y0[e]); y1[e] = y1[e] * sigmoidf_(y1[e]); }
        u32x4 o; o.x = pk_bf16(y0[0], y0[1]); o.y = pk_bf16(y0[2], y0[3]); o.z = pk_bf16(y1[0], y1[1]); o.w = pk_bf16(y1[2], y1[3]);
        *(u32x4*)(mix + row * D + lane * 8) = o;
    }
    __syncthreads();
}

__device__ __forceinline__ void conv_pair(LAS unsigned char* lds, int pr, const bf16* glu, const float* cw, const float* cb, const float* lng, const float* lnb, bf16* mix, float* out_conv) {
    const int tid = ltid(), lane = tid & 63, half = __builtin_amdgcn_readfirstlane(tid >> 8), wl = __builtin_amdgcn_readfirstlane((tid >> 6) & 3), t = tid & 255;
    const int itc = pr * 2 + half, b = itc >> 6, tt = itc & 63, t0 = tt * 32;
    constexpr int NT = 32, NI = NT + 30;
    f32x2 in2[NI];
#pragma unroll
    for (int j = 0; j < NI; ++j) {
        const int tk = t0 - 30 + j;
        unsigned w = 0u;
        if (tk >= 0) w = *(const unsigned*)(glu + ((size_t)b * SEQ + tk) * 512 + 2 * t);
        in2[j] = (f32x2){bflo(w), bfhi(w)};
    }
    f32x2 w2[CW];
#pragma unroll
    for (int k = 0; k < CW; ++k) w2[k] = *(const f32x2*)(cw + k * 512 + 2 * t);
    const f32x2 bias2 = *(const f32x2*)(cb + 2 * t);
    LAS float* co = (LAS float*)(lds + half * 65536);
#pragma unroll
    for (int u = 0; u < NT; ++u) {
        f32x2 acc = bias2;
#pragma unroll
        for (int k = 0; k < CW; ++k) acc = w2[k] * in2[u + k] + acc;
        *(LAS f32x2*)(co + u * 512 + 2 * t) = acc;
    }
    if (tt == SEQ / NT - 1) {
#pragma unroll
        for (int jj = 0; jj < 30; ++jj) __builtin_nontemporal_store(in2[jj + NT], (f32x2*)(out_conv + ((size_t)b * 30 + jj) * 512 + 2 * t));
    }
    const f32x4 g0 = *(const f32x4*)(lng + lane * 8), g1 = *(const f32x4*)(lng + lane * 8 + 4), b0 = *(const f32x4*)(lnb + lane * 8), b1 = *(const f32x4*)(lnb + lane * 8 + 4);
    __syncthreads();
    for (int u = wl; u < NT; u += 4) {
        const size_t row = (size_t)b * SEQ + t0 + u;
        f32x4 v0 = *(const LAS f32x4*)(co + u * 512 + lane * 8), v1 = *(const LAS f32x4*)(co + u * 512 + lane * 8 + 4);
        float sm = (v0[0] + v0[1]) + (v0[2] + v0[3]) + (v1[0] + v1[1]) + (v1[2] + v1[3]);
        sm = wave_sum(sm);
        const float mean = sm * (1.0f / 512.0f);
        v0 = v0 - mean; v1 = v1 - mean;
        float qv = (v0[0] * v0[0] + v0[1] * v0[1]) + (v0[2] * v0[2] + v0[3] * v0[3]) + (v1[0] * v1[0] + v1[1] * v1[1]) + (v1[2] * v1[2] + v1[3] * v1[3]);
        qv = wave_sum(qv);
        const float rstd = rsqrtf(qv * (1.0f / 512.0f) + EPS);
        f32x4 y0 = v0 * rstd * g0 + b0, y1 = v1 * rstd * g1 + b1;
#pragma unroll
        for (int e = 0; e < 4; ++e) { y0[e] = y0[e] * sigmoidf_(y0[e]); y1[e] = y1[e] * sigmoidf_(y1[e]); }
        u32x4 o; o.x = pk_bf16(y0[0], y0[1]); o.y = pk_bf16(y0[2], y0[3]); o.z = pk_bf16(y1[0], y1[1]); o.w = pk_bf16(y1[2], y1[3]);
        *(u32x4*)(mix + row * D + lane * 8) = o;
    }
    __syncthreads();
}

constexpr int TS = 272;
__device__ __forceinline__ bf16x8 tr_frag(LAS unsigned char* tile, int rowA, int rowB, int col0, int lane) {
    const int i = lane & 15, qq = i >> 2, p = i & 3;
    const s16x4 lo = __builtin_amdgcn_ds_read_tr16_b64_v4i16((LAS s16x4*)(tile + (rowA + qq) * TS + (col0 + 4 * p) * 2));
    const s16x4 hi = __builtin_amdgcn_ds_read_tr16_b64_v4i16((LAS s16x4*)(tile + (rowB + qq) * TS + (col0 + 4 * p) * 2));
    bf16x8 r; r[0] = lo[0]; r[1] = lo[1]; r[2] = lo[2]; r[3] = lo[3]; r[4] = hi[0]; r[5] = hi[1]; r[6] = hi[2]; r[7] = hi[3];
    return r;
}
__device__ __forceinline__ u32x4 scale_bf16x8(u32x4 v, float s) {
    u32x4 o; o.x = pk_bf16(bflo(v.x) * s, bfhi(v.x) * s); o.y = pk_bf16(bflo(v.y) * s, bfhi(v.y) * s); o.z = pk_bf16(bflo(v.z) * s, bfhi(v.z) * s); o.w = pk_bf16(bflo(v.w) * s, bfhi(v.w) * s);
    return o;
}
__device__ __forceinline__ void kvloc_item(LAS unsigned char* lds, int b, int h, int c, const bf16* K, const bf16* V, float* kvbuf, float lg2, int wave, int lane) {
    LAS unsigned char* Kt = lds; LAS unsigned char* Vt = lds + 128 * TS;
    const int tid = ltid(); lane = tid & 63; wave = __builtin_amdgcn_readfirstlane(tid >> 6); const size_t r0 = (size_t)b * SEQ + c * 128;
#pragma unroll
    for (int i = 0; i < 4; ++i) {
        const int chunk = tid + 512 * i, j = chunk >> 4, cc = chunk & 15;
        u32x4 kv = *(const u32x4*)(K + (r0 + j) * 512 + h * 128 + cc * 8);
        const u32x4 vv = *(const u32x4*)(V + (r0 + j) * 512 + h * 128 + cc * 8);
        kv = scale_bf16x8(kv, exp2f(lg2 * (float)(127 - j)));
        *(LAS u32x4*)(Kt + j * TS + cc * 16) = kv; *(LAS u32x4*)(Vt + j * TS + cc * 16) = vv;
    }
    __syncthreads();
    const int r = lane & 15, q = lane >> 4;
    f32x4 acc[8];
#pragma unroll
    for (int vf = 0; vf < 8; ++vf) acc[vf] = (f32x4){0.f, 0.f, 0.f, 0.f};
#pragma unroll
    for (int ks = 0; ks < 4; ++ks) {
        const bf16x8 bfrag = tr_frag(Kt, 32 * ks + 8 * q, 32 * ks + 8 * q + 4, 16 * wave, lane);
#pragma unroll
        for (int vf = 0; vf < 8; ++vf) {
            const bf16x8 afrag = tr_frag(Vt, 32 * ks + 8 * q, 32 * ks + 8 * q + 4, 16 * vf, lane);
            acc[vf] = __builtin_amdgcn_mfma_f32_16x16x32_bf16(afrag, bfrag, acc[vf], 0, 0, 0);
        }
    }
    float* dst = kvbuf + ((size_t)((b * NH + h) * 16 + c)) * 16384 + (size_t)(16 * wave + r) * 128 + 4 * q;
#pragma unroll
    for (int vf = 0; vf < 8; ++vf) *(f32x4*)(dst + 16 * vf) = acc[vf];
    __syncthreads();
}

__device__ __forceinline__ void kvloc_pair(LAS unsigned char* lds, int pr, const bf16* K, const bf16* V, bf16* kvbuf) {
    const int tid = ltid(), lane = tid & 63, half = __builtin_amdgcn_readfirstlane(tid >> 8), wl = __builtin_amdgcn_readfirstlane((tid >> 6) & 3), t = tid & 255;
    const int k = pr * 2 + half, b = k >> 6, h = (k >> 4) & 3, c = k & 15;
    const float lg2 = __log2f(1.0f - exp2f(-5.0f - (float)h));
    LAS unsigned char* Kt = lds + half * (256 * TS); LAS unsigned char* Vt = Kt + 128 * TS;
    const size_t r0 = (size_t)b * SEQ + c * 128;
#pragma unroll
    for (int i = 0; i < 8; ++i) {
        const int chunk = t + 256 * i, j = chunk >> 4, cc = chunk & 15;
        u32x4 kv = *(const u32x4*)(K + (r0 + j) * 512 + h * 128 + cc * 8);
        const u32x4 vv = *(const u32x4*)(V + (r0 + j) * 512 + h * 128 + cc * 8);
        kv = scale_bf16x8(kv, exp2f(lg2 * (float)(127 - j)));
        *(LAS u32x4*)(Kt + j * TS + cc * 16) = kv; *(LAS u32x4*)(Vt + j * TS + cc * 16) = vv;
    }
    __syncthreads();
    const int r = lane & 15, q = lane >> 4;
    f32x4 acc[2][8];
#pragma unroll
    for (int u = 0; u < 2; ++u)
#pragma unroll
        for (int vf = 0; vf < 8; ++vf) acc[u][vf] = (f32x4){0.f, 0.f, 0.f, 0.f};
#pragma unroll
    for (int ks = 0; ks < 4; ++ks) {
        const bf16x8 b0 = tr_frag(Kt, 32 * ks + 8 * q, 32 * ks + 8 * q + 4, 32 * wl, lane);
        const bf16x8 b1 = tr_frag(Kt, 32 * ks + 8 * q, 32 * ks + 8 * q + 4, 32 * wl + 16, lane);
#pragma unroll
        for (int vf = 0; vf < 8; ++vf) {
            const bf16x8 afrag = tr_frag(Vt, 32 * ks + 8 * q, 32 * ks + 8 * q + 4, 16 * vf, lane);
            acc[0][vf] = __builtin_amdgcn_mfma_f32_16x16x32_bf16(afrag, b0, acc[0][vf], 0, 0, 0);
            acc[1][vf] = __builtin_amdgcn_mfma_f32_16x16x32_bf16(afrag, b1, acc[1][vf], 0, 0, 0);
        }
    }
    bf16* dst = kvbuf + ((size_t)((b * NH + h) * 16 + c)) * 16384 + (size_t)(32 * wl + r) * 128 + 4 * q;
#pragma unroll
    for (int u = 0; u < 2; ++u)
#pragma unroll
        for (int vf = 0; vf < 8; ++vf) { u32x2 w; w.x = pk_bf16(acc[u][vf][0], acc[u][vf][1]); w.y = pk_bf16(acc[u][vf][2], acc[u][vf][3]); *(u32x2*)(dst + (size_t)u * 16 * 128 + 16 * vf) = w; }
    __syncthreads();
}

__device__ __forceinline__ void retout_item(LAS unsigned char* lds, int b, int h, int c, const bf16* Q, const bf16* K, const bf16* V, const bf16* GATE, const bf16* sb, bf16* mix,
                                            float lg2, int wave, int lane) {
    LAS unsigned char* Kt = lds; LAS unsigned char* Vt = lds + 128 * TS; LAS unsigned char* St = lds + 256 * TS;
    const int tid = ltid(); lane = tid & 63; wave = __builtin_amdgcn_readfirstlane(tid >> 6); const size_t r0 = (size_t)b * SEQ + c * 128;
#pragma unroll
    for (int i = 0; i < 4; ++i) {
        const int chunk = tid + 512 * i, j = chunk >> 4, cc = chunk & 15;
        const u32x4 kv = *(const u32x4*)(K + (r0 + j) * 512 + h * 128 + cc * 8);
        const u32x4 vv = *(const u32x4*)(V + (r0 + j) * 512 + h * 128 + cc * 8);
        *(LAS u32x4*)(Kt + j * TS + cc * 16) = kv; *(LAS u32x4*)(Vt + j * TS + cc * 16) = vv;
    }
    if (c > 0) {
        const bf16* sp = sb + ((size_t)((b * NH + h) * 16 + c)) * 16384;
#pragma unroll
        for (int i = 0; i < 4; ++i) {
            const int chunk = tid + 512 * i, j = chunk >> 4, cc = chunk & 15;
            *(LAS u32x4*)(St + j * TS + cc * 16) = *(const u32x4*)(sp + j * 128 + cc * 8);
        }
    }
    __syncthreads();
    const int r = lane & 15, q = lane >> 4;
    const size_t rowi = r0 + 16 * wave + r;
    bf16x8 qf[4];
#pragma unroll
    for (int ks = 0; ks < 4; ++ks) qf[ks] = *(const bf16x8*)(Q + rowi * 512 + h * 128 + 32 * ks + 8 * q);
    f32x4 sc[8];
#pragma unroll
    for (int jf = 0; jf < 8; ++jf) {
        sc[jf] = (f32x4){0.f, 0.f, 0.f, 0.f};
        if (jf <= wave) {
#pragma unroll
            for (int ks = 0; ks < 4; ++ks) {
                const bf16x8 kf = *(const LAS bf16x8*)(Kt + (16 * jf + r) * TS + (32 * ks + 8 * q) * 2);
                sc[jf] = __builtin_amdgcn_mfma_f32_16x16x32_bf16(kf, qf[ks], sc[jf], 0, 0, 0);
            }
#pragma unroll
            for (int e = 0; e < 4; ++e) { const int dlt = (16 * wave + r) - (16 * jf + 4 * q + e); sc[jf][e] = dlt >= 0 ? sc[jf][e] * exp2f(lg2 * (float)dlt) : 0.f; }
        }
    }
    f32x4 ao[8], ac[8];
#pragma unroll
    for (int vf = 0; vf < 8; ++vf) { ao[vf] = (f32x4){0.f, 0.f, 0.f, 0.f}; ac[vf] = (f32x4){0.f, 0.f, 0.f, 0.f}; }
#pragma unroll
    for (int k2 = 0; k2 < 4; ++k2) {
        if (2 * k2 <= wave) {
            union { u32x4 u; bf16x8 v; } pf;
            pf.u.x = pk_bf16(sc[2 * k2][0], sc[2 * k2][1]); pf.u.y = pk_bf16(sc[2 * k2][2], sc[2 * k2][3]); pf.u.z = pk_bf16(sc[2 * k2 + 1][0], sc[2 * k2 + 1][1]); pf.u.w = pk_bf16(sc[2 * k2 + 1][2], sc[2 * k2 + 1][3]);
#pragma unroll
            for (int vf = 0; vf < 8; ++vf) {
                const bf16x8 af = tr_frag(Vt, 32 * k2 + 4 * q, 32 * k2 + 16 + 4 * q, 16 * vf, lane);
                ao[vf] = __builtin_amdgcn_mfma_f32_16x16x32_bf16(af, pf.v, ao[vf], 0, 0, 0);
            }
        }
    }
    if (c > 0) {
#pragma unroll
        for (int ks = 0; ks < 4; ++ks) {
#pragma unroll
            for (int vf = 0; vf < 8; ++vf) {
                const bf16x8 af = tr_frag(St, 32 * ks + 8 * q, 32 * ks + 8 * q + 4, 16 * vf, lane);
                ac[vf] = __builtin_amdgcn_mfma_f32_16x16x32_bf16(af, qf[ks], ac[vf], 0, 0, 0);
            }
        }
    }
    const float gi = exp2f(lg2 * (float)(16 * wave + r + 1));
    float s = 0.f;
#pragma unroll
    for (int vf = 0; vf < 8; ++vf) { ao[vf] = ao[vf] + ac[vf] * gi; s += (ao[vf][0] + ao[vf][1]) + (ao[vf][2] + ao[vf][3]); }
    s += __shfl_xor(s, 16); s += __shfl_xor(s, 32);
    const float mean = s * (1.0f / 128.0f);
    float qv = 0.f;
#pragma unroll
    for (int vf = 0; vf < 8; ++vf) { ao[vf] = ao[vf] - mean; qv += (ao[vf][0] * ao[vf][0] + ao[vf][1] * ao[vf][1]) + (ao[vf][2] * ao[vf][2] + ao[vf][3] * ao[vf][3]); }
    qv += __shfl_xor(qv, 16); qv += __shfl_xor(qv, 32);
    const float rstd = rsqrtf(qv * (1.0f / 128.0f) + EPS);
#pragma unroll
    for (int vf = 0; vf < 8; ++vf) {
        const u32x2 gw = *(const u32x2*)(GATE + rowi * 512 + h * 128 + 16 * vf + 4 * q);
        u32x2 o; o.x = pk_bf16(ao[vf][0] * rstd * bflo(gw.x), ao[vf][1] * rstd * bfhi(gw.x)); o.y = pk_bf16(ao[vf][2] * rstd * bflo(gw.y), ao[vf][3] * rstd * bfhi(gw.y));
        *(u32x2*)(mix + rowi * D + 512 + h * 128 + 16 * vf + 4 * q) = o;
    }
    __syncthreads();
}

__device__ __forceinline__ void scan_phase(const bf16* kvbuf, bf16* sb, float* out_state) {
    const int tid = ltid();
    for (int idx = blockIdx.x * NTHREADS + tid; idx < 32 * 4096; idx += gridDim.x * NTHREADS) {
        const int bh = idx >> 12, e4 = idx & 4095, h = bh & 3;
        const float g128 = exp2f(128.0f * __log2f(1.0f - exp2f(-5.0f - (float)h)));
        const bf16* base = kvbuf + (size_t)bh * 16 * 16384 + e4 * 4;
        u32x2 kvr[16];
#pragma unroll
        for (int c = 0; c < 16; ++c) kvr[c] = *(const u32x2*)(base + (size_t)c * 16384);
        f32x4 s = (f32x4){0.f, 0.f, 0.f, 0.f};
#pragma unroll
        for (int c = 0; c < 16; ++c) {
            if (c > 0) { u32x2 w; w.x = pk_bf16(s[0], s[1]); w.y = pk_bf16(s[2], s[3]); *(u32x2*)(sb + ((size_t)(bh * 16 + c)) * 16384 + e4 * 4) = w; }
            s = s * g128 + (f32x4){bflo(kvr[c].x), bfhi(kvr[c].x), bflo(kvr[c].y), bfhi(kvr[c].y)};
        }
        __builtin_nontemporal_store(s, (f32x4*)(out_state + (size_t)bh * 16384 + e4 * 4));
    }
}

__device__ __forceinline__ void ret_sample_item(LAS unsigned char* lds, int b, int h, const bf16* Q, const bf16* K, const bf16* V, const bf16* GATE, const float* state_in, float* out_state,
                                                bf16* mix, float lg2, int wave, int lane) {
    LAS float* qs = (LAS float*)lds; LAS float* ks = qs + 512; LAS float* vs = ks + 512; LAS float* scs = vs + 512;
    LAS float* red = (LAS float*)(lds + 8192); LAS float* wsum = (LAS float*)(lds + 8192 + 32768);
    const int tid = ltid(); lane = tid & 63; wave = __builtin_amdgcn_readfirstlane(tid >> 6); const size_t row0 = (size_t)MP + 4 * b;
    { const int i = tid >> 7, d = tid & 127; const size_t o = (row0 + i) * 512 + h * 128 + d; qs[tid] = bf2f(Q[o]); ks[tid] = bf2f(K[o]); vs[tid] = bf2f(V[o]); }
    __syncthreads();
    { const int i = wave >> 1;
#pragma unroll
      for (int jj = 0; jj < 2; ++jj) { const int j = (wave & 1) * 2 + jj; float p = qs[i * 128 + lane] * ks[j * 128 + lane] + qs[i * 128 + 64 + lane] * ks[j * 128 + 64 + lane]; p = wave_sum(p);
          if (lane == 0) scs[i * 4 + j] = (j <= i) ? p * exp2f(lg2 * (float)(i - j)) : 0.f; } }
    const int v4 = (tid & 31) * 4, dg = tid >> 5;
    const float g4 = exp2f(lg2 * 4.0f), gk0 = exp2f(lg2 * 3.0f), gk1 = exp2f(lg2 * 2.0f), gk2 = exp2f(lg2), gk3 = 1.0f;
    const float* sin_ = state_in + ((size_t)(b * NH + h) * 128) * 128; float* sout = out_state + ((size_t)(b * NH + h) * 128) * 128;
    const f32x4 vv0 = *(const LAS f32x4*)(vs + v4), vv1 = *(const LAS f32x4*)(vs + 128 + v4), vv2 = *(const LAS f32x4*)(vs + 256 + v4), vv3 = *(const LAS f32x4*)(vs + 384 + v4);
    f32x4 p0 = (f32x4){0.f, 0.f, 0.f, 0.f}, p1 = p0, p2 = p0, p3 = p0;
#pragma unroll
    for (int dd = 0; dd < 8; ++dd) {
        const int d = dg * 8 + dd;
        const f32x4 s4 = *(const f32x4*)(sin_ + (size_t)d * 128 + v4);
        p0 += s4 * qs[d]; p1 += s4 * qs[128 + d]; p2 += s4 * qs[256 + d]; p3 += s4 * qs[384 + d];
        f32x4 ns = s4 * g4 + vv0 * (gk0 * ks[d]) + vv1 * (gk1 * ks[128 + d]) + vv2 * (gk2 * ks[256 + d]) + vv3 * (gk3 * ks[384 + d]);
        *(f32x4*)(sout + (size_t)d * 128 + v4) = ns;
    }
    *(LAS f32x4*)(red + (dg * 4 + 0) * 128 + v4) = p0; *(LAS f32x4*)(red + (dg * 4 + 1) * 128 + v4) = p1; *(LAS f32x4*)(red + (dg * 4 + 2) * 128 + v4) = p2; *(LAS f32x4*)(red + (dg * 4 + 3) * 128 + v4) = p3;
    __syncthreads();
    const int i = tid >> 7, v = tid & 127;
    float cross = 0.f;
#pragma unroll
    for (int g = 0; g < 16; ++g) cross += red[(g * 4 + i) * 128 + v];
    float o = exp2f(lg2 * (float)(i + 1)) * cross;
#pragma unroll
    for (int j = 0; j < 4; ++j) o += scs[i * 4 + j] * vs[j * 128 + v];
    float s = wave_sum(o);
    if (lane == 0) wsum[wave] = s;
    __syncthreads();
    const float mean = (wsum[2 * i] + wsum[2 * i + 1]) * (1.0f / 128.0f);
    const float dv = o - mean;
    float qv = wave_sum(dv * dv);
    if (lane == 0) wsum[8 + wave] = qv;
    __syncthreads();
    const float rstd = rsqrtf((wsum[8 + 2 * i] + wsum[8 + 2 * i + 1]) * (1.0f / 128.0f) + EPS);
    const float gt = bf2f(GATE[(row0 + i) * 512 + h * 128 + v]);
    const unsigned pk = pk_bf16(dv * rstd * gt, 0.f);
    mix[(row0 + i) * D + 512 + h * 128 + v] = (bf16)(pk & 0xffffu);
    __syncthreads();
}

__device__ __forceinline__ void ret_sample_pair(LAS unsigned char* lds, int pair, const bf16* Q, const bf16* K, const bf16* V, const bf16* GATE, const float* state_in, float* out_state, bf16* mix) {
    const int tid = ltid(), half = __builtin_amdgcn_readfirstlane(tid >> 8), t = tid & 255, lane = tid & 63, wl = __builtin_amdgcn_readfirstlane((tid >> 6) & 3);
    const int item = pair * 2 + half, b = item >> 2, h = item & 3;
    const float lg2 = __log2f(1.0f - exp2f(-5.0f - (float)h));
    LAS float* base = (LAS float*)(lds + half * 32768);
    LAS float* qs = base; LAS float* ks = base + 512; LAS float* vs = base + 1024; LAS float* red = base + 2048;
    const size_t row0 = (size_t)MP + 4 * b;
#pragma unroll
    for (int u = 0; u < 2; ++u) { const int e = t + 256 * u, i = e >> 7, d = e & 127; const size_t o = (row0 + i) * 512 + h * 128 + d; qs[e] = bf2f(Q[o]); ks[e] = bf2f(K[o]); vs[e] = bf2f(V[o]); }
    const float gt0 = bf2f(GATE[(row0 + wl) * 512 + h * 128 + lane]), gt1 = bf2f(GATE[(row0 + wl) * 512 + h * 128 + 64 + lane]);
    __syncthreads();
    {
        const int v4 = (t & 31) * 4, dg = t >> 5;
        const float g4 = exp2f(lg2 * 4.0f), gk0 = exp2f(lg2 * 3.0f), gk1 = exp2f(lg2 * 2.0f), gk2 = exp2f(lg2);
        const float* sin_ = state_in + ((size_t)(b * NH + h) * 128) * 128; float* sout = out_state + ((size_t)(b * NH + h) * 128) * 128;
        const f32x4 vv0 = *(const LAS f32x4*)(vs + v4), vv1 = *(const LAS f32x4*)(vs + 128 + v4), vv2 = *(const LAS f32x4*)(vs + 256 + v4), vv3 = *(const LAS f32x4*)(vs + 384 + v4);
        f32x4 p0 = (f32x4){0.f, 0.f, 0.f, 0.f}, p1 = p0, p2 = p0, p3 = p0;
        f32x4 s4[16];
#pragma unroll
        for (int dd = 0; dd < 16; ++dd) s4[dd] = __builtin_nontemporal_load((const f32x4*)(sin_ + (size_t)(dg * 16 + dd) * 128 + v4));
#pragma unroll
        for (int dd = 0; dd < 16; ++dd) {
            const int d = dg * 16 + dd;
            p0 += s4[dd] * qs[d]; p1 += s4[dd] * qs[128 + d]; p2 += s4[dd] * qs[256 + d]; p3 += s4[dd] * qs[384 + d];
            const f32x4 ns = s4[dd] * g4 + vv0 * (gk0 * ks[d]) + vv1 * (gk1 * ks[128 + d]) + vv2 * (gk2 * ks[256 + d]) + vv3 * ks[384 + d];
            __builtin_nontemporal_store(ns, (f32x4*)(sout + (size_t)d * 128 + v4));
        }
        *(LAS f32x4*)(red + (dg * 4 + 0) * 128 + v4) = p0; *(LAS f32x4*)(red + (dg * 4 + 1) * 128 + v4) = p1; *(LAS f32x4*)(red + (dg * 4 + 2) * 128 + v4) = p2; *(LAS f32x4*)(red + (dg * 4 + 3) * 128 + v4) = p3;
    }
    __syncthreads();
    {
        const int i = wl;
        float o0 = 0.f, o1 = 0.f;
#pragma unroll
        for (int g = 0; g < 8; ++g) { o0 += red[(g * 4 + i) * 128 + lane]; o1 += red[(g * 4 + i) * 128 + 64 + lane]; }
        const float gi = exp2f(lg2 * (float)(i + 1));
        o0 *= gi; o1 *= gi;
#pragma unroll
        for (int j = 0; j < 4; ++j) {
            if (j <= i) {
                float p = qs[i * 128 + lane] * ks[j * 128 + lane] + qs[i * 128 + 64 + lane] * ks[j * 128 + 64 + lane];
                p = wave_sum(p) * exp2f(lg2 * (float)(i - j));
                o0 += p * vs[j * 128 + lane]; o1 += p * vs[j * 128 + 64 + lane];
            }
        }
        const float mean = wave_sum(o0 + o1) * (1.0f / 128.0f);
        const float d0 = o0 - mean, d1 = o1 - mean;
        const float rstd = rsqrtf(wave_sum(d0 * d0 + d1 * d1) * (1.0f / 128.0f) + EPS);
        const unsigned pk = pk_bf16(d0 * rstd * gt0, d1 * rstd * gt1);
        bf16* mo = mix + (row0 + i) * D + 512 + h * 128 + lane;
        mo[0] = (bf16)(pk & 0xffffu); mo[64] = (bf16)(pk >> 16);
    }
    __syncthreads();
}

#define XB_TMO      128
#define XB_XCNT(j)  (256  + 64 * (j))
#define XB_XSUB(j)  (1280 + 64 * (j))
#define XB_XGEN(j)  (2304 + 64 * (j))
#define XB_TOP      3328
#define XB_TOPGEN   3392
#define XCD_BAR_WORDS 3456
#define XB_SPIN_CAP (1u << 18)

__device__ __forceinline__ unsigned xb_ld(unsigned* p)              { return __hip_atomic_load(p, __ATOMIC_RELAXED, __HIP_MEMORY_SCOPE_AGENT); }
__device__ __forceinline__ unsigned xb_add(unsigned* p, unsigned v) { return __hip_atomic_fetch_add(p, v, __ATOMIC_RELAXED, __HIP_MEMORY_SCOPE_AGENT); }
__device__ __forceinline__ unsigned xb_xcc_id() { return (unsigned)__builtin_amdgcn_s_getreg((3 << 11) | 20) & 0xFu; }
#define XB_SPIN(cond, bar) do { unsigned _sp = 0; while (cond) { __builtin_amdgcn_s_sleep(1); \
    if ((++_sp & 255u) == 0u) { if (xb_ld(&(bar)[XB_TMO])) break; if (_sp > XB_SPIN_CAP) { atomicAdd(&(bar)[XB_TMO], 1u); break; } } } } while (0)

struct XcdBarrier {
    unsigned* bar; unsigned x;
    volatile LAS unsigned* st;
};

__device__ __forceinline__ XcdBarrier xcd_barrier_post(unsigned* bar, volatile LAS unsigned* st) {
    XcdBarrier b; b.bar = bar; b.x = xb_xcc_id(); b.st = st;
    if (threadIdx.x == 0) (void)xb_add(&bar[XB_XCNT(b.x)], 1u);
    return b;
}
__device__ __forceinline__ void xcd_barrier_complete(unsigned* bar, unsigned x, unsigned& nloc, unsigned& nx) {
    const unsigned G = gridDim.x * gridDim.y * gridDim.z;
    unsigned sum, cnt, mine, sp = 0u;
    for (;;) {
        sum = 0u; cnt = 0u; mine = 0u;
#pragma unroll
        for (unsigned j = 0; j < 16; ++j) { const unsigned c = xb_ld(&bar[XB_XCNT(j)]); sum += c; cnt += (c > 0u) ? 1u : 0u; mine = (j == x) ? c : mine; }
        if (sum == G) break;
        __builtin_amdgcn_s_sleep(1);
        if ((++sp & 255u) == 0u) { if (xb_ld(&bar[XB_TMO])) break; if (sp > XB_SPIN_CAP) { atomicAdd(&bar[XB_TMO], 1u); break; } }
    }
    nloc = mine > 0u ? mine : 1u; nx = cnt > 0u ? cnt : 1u;
}

__device__ __forceinline__ void xcd_barrier(const XcdBarrier& b) {
    asm volatile("s_waitcnt vmcnt(0)" ::: "memory");
    __syncthreads();
    if (threadIdx.x == 0) {
        unsigned* bar = b.bar;
        __builtin_amdgcn_s_waitcnt(0);
        unsigned nloc = b.st[0], nx = b.st[1];
        if (nloc == 0u) { xcd_barrier_complete(bar, b.x, nloc, nx); b.st[0] = nloc; b.st[1] = nx; }
        const unsigned old = xb_add(&bar[XB_XSUB(b.x)], 1u);
        const unsigned gen = old / nloc;
        if (old + 1u == (gen + 1u) * nloc) {
            __builtin_amdgcn_fence(__ATOMIC_RELEASE, "agent");
            asm volatile("s_waitcnt vmcnt(0)" ::: "memory");
            const unsigned og = xb_add(&bar[XB_TOP], 1u);
            const unsigned tg = og / nx;
            if (og + 1u == (tg + 1u) * nx) xb_add(&bar[XB_TOPGEN], 1u);
            else XB_SPIN(xb_ld(&bar[XB_TOPGEN]) == tg, bar);
            __builtin_amdgcn_fence(__ATOMIC_ACQUIRE, "agent");
            xb_add(&bar[XB_XGEN(b.x)], 1u);
            asm volatile("s_waitcnt vmcnt(0)" ::: "memory");
        } else {
            __builtin_amdgcn_fence(__ATOMIC_ACQUIRE, "agent");
            asm volatile("s_waitcnt vmcnt(0)" ::: "memory");
            XB_SPIN(xb_ld(&bar[XB_TOPGEN]) == gen, bar);
            asm volatile("" ::: "memory");
            asm volatile("s_waitcnt vmcnt(0)" ::: "memory");
        }
    }
    __syncthreads();
}

#define GRID_SYNC() do { XcdBarrier b_ = bar; unsigned* p_ = (unsigned*)(a.ws + WS_CTL) + 4096; asm volatile("" : "+s"(p_)); b_.bar = p_; unsigned x_ = bar.x; asm volatile("" : "+s"(x_)); b_.x = x_; xcd_barrier(b_); } while (0)

__global__ void __launch_bounds__(NTHREADS, 2) mega_fwd(Args a) {
    extern __shared__ __attribute__((aligned(16))) unsigned char lds_raw[];
    LAS unsigned char* lds = (LAS unsigned char*)lds_raw;
    cg::grid_group grid = cg::this_grid();
    const int tid = threadIdx.x, lane = tid & 63, wave = __builtin_amdgcn_readfirstlane(tid >> 6);
    const int G = gridDim.x, bid = blockIdx.x;
    unsigned char* ws = a.ws;
    float* ssq = (float*)(ws + WS_SSQ);
    const f32x2* rope = (const f32x2*)(ws + WS_ROPE);
    bf16* XN = (bf16*)(ws + WS_XN);
    bf16 *GLU = (bf16*)(ws + WS_GLU), *Qb = (bf16*)(ws + WS_Q), *Kb = (bf16*)(ws + WS_K), *Vb = (bf16*)(ws + WS_V), *GATE = (bf16*)(ws + WS_GATE), *MIX = (bf16*)(ws + WS_MIX), *Hb = (bf16*)(ws + WS_H);
    bf16* KVB = (bf16*)(ws + WS_KV);
    bf16* SB = (bf16*)(ws + WS_SB);
    float* XR = a.out + O_Y;
    volatile LAS unsigned* MISC = (volatile LAS unsigned*)(lds + LDS_BYTES - 256);
    if (tid < 64) MISC[tid] = 0u;
    __syncthreads();
    XcdBarrier bar = xcd_barrier_post((unsigned*)(ws + WS_CTL) + 4096, MISC + 8);

#ifndef SKIP_P0
    for (int rep = 0; rep < REP_P0; ++rep) p0_prologue(a, lds, wave, lane);
#endif
    if (a.ws == nullptr) grid.sync();
    GRID_SYNC();

    for (int l = 0; l < 2; ++l) {
        const unsigned char* wl = ws + WS_W + (size_t)l * W_LAYER;
        {
            pg8::Gemm g{XN, (const bf16*)(wl + W_IN), MP, NIN, D}; pg8::StaticOrder S; S.init(MP, NIN, G, bid);
            EpiIn E{ssq + (size_t)(2 * l) * M, GLU, Qb, Kb, Vb, GATE, rope, a.in[10] + l * 512};
#ifndef SKIP_IN
            for (int rep = 0; rep < REP_BIG; ++rep) pg8::gemm_phase<EpiIn, pg8::StaticOrder, true, true>(lds, g, S, E);
#endif
            for (int rep = 0; rep < REP_SMALL; ++rep) small_gemm<EpiIn, 2>(lds, XN, (const bf16*)(wl + W_IN), D, 48, E);
        }
        GRID_SYNC();
        {
            const float* cw = a.in[6] + (size_t)l * CW * 512; const float* cb = a.in[7] + l * 512; const float* lng = a.in[8] + l * 512; const float* lnb = a.in[9] + l * 512;
            const float* cache = a.in[2] + (size_t)l * 128 * 30 * 512;
            float* ocp = a.out + O_CP + (size_t)l * 8 * 30 * 512; float* ocs = a.out + O_CS + (size_t)l * 128 * 30 * 512;
            const float* st_in = a.in[3] + (size_t)l * 128 * NH * 16384; float* ors = a.out + O_RS + (size_t)l * 128 * NH * 16384;
            for (int rep = 0; rep < REP_P2; ++rep)
            for (int it = bid; it < 896; it += G) {
#ifndef SKIP_P2
                if (it < 256) { conv_pair(lds, it, GLU, cw, cb, lng, lnb, MIX, ocp); }
                else if (it < 384) { conv_item<4, true>(lds, it - 256, 0, GLU, cache, cw, cb, lng, lnb, MIX, ocs, wave, lane); }
                else if (it < 640) { kvloc_pair(lds, it - 384, Kb, Vb, KVB); }
                else { ret_sample_pair(lds, it - 640, Qb, Kb, Vb, GATE, st_in, ors, MIX); }
#endif
            }
        }
        GRID_SYNC();
        scan_phase(KVB, SB, a.out + O_RP + (size_t)l * 8 * NH * 16384);
        GRID_SYNC();
        {
#ifndef SKIP_P3
            for (int rep = 0; rep < REP_P3; ++rep)
            for (int it = bid; it < 512; it += G) { const int h = (it >> 4) & 3; retout_item(lds, it >> 6, h, it & 15, Qb, Kb, Vb, GATE, SB, MIX, __log2f(1.0f - exp2f(-5.0f - (float)h)), wave, lane); }
#endif
        }
        GRID_SYNC();
        {
            pg8::Gemm g{MIX, (const bf16*)(wl + W_OUT), MP, D, D}; pg8::StaticOrder S; S.init(MP, D, G, bid);
            EpiRes E{XN, ssq + (size_t)(2 * l + 1) * M};
#ifndef SKIP_RES
            pg8::gemm_phase<EpiRes, pg8::StaticOrder, true, true>(lds, g, S, E);
#endif
            small_gemm32(lds, MIX, (const bf16*)(wl + W_OUT), D, E);
        }
        GRID_SYNC();
        {
            pg8::Gemm g{XN, (const bf16*)(wl + W_UP), MP, FF, D}; pg8::StaticOrder S; S.init(MP, FF, G, bid);
            EpiUp E{ssq + (size_t)(2 * l + 1) * M, Hb};
#ifndef SKIP_UP
            for (int rep = 0; rep < REP_BIG; ++rep) pg8::gemm_phase<EpiUp, pg8::StaticOrder, true, true>(lds, g, S, E);
#endif
            for (int rep = 0; rep < REP_SMALL; ++rep) small_gemm<EpiUp, 2>(lds, XN, (const bf16*)(wl + W_UP), D, 64, E);
        }
        GRID_SYNC();
        {
            pg8::Gemm g{Hb, (const bf16*)(wl + W_DN), MP, D, FF}; pg8::StaticOrder S; S.init(MP, D, G, bid);
            EpiRes E{XN, ssq + (size_t)(2 * l + 2) * M};
#ifndef SKIP_RES
            pg8::gemm_phase<EpiRes, pg8::StaticOrder, true, true>(lds, g, S, E);
#endif
            small_gemm32(lds, Hb, (const bf16*)(wl + W_DN), FF, E);
        }
        GRID_SYNC();
    }
    {
        const float* gf = a.in[15]; const float* sq = ssq + (size_t)4 * M;
        const int gw = bid * NWAVES + wave, NGW = G * NWAVES;
        for (int m0 = gw; m0 < M; m0 += 4 * NGW) {
            u32x4 v[4][2]; float rs[4];
#pragma unroll
            for (int u = 0; u < 4; ++u) {
                const int m = (m0 + u * NGW) < M ? (m0 + u * NGW) : m0;
                rs[u] = sq[m];
                v[u][0] = *(const u32x4*)(XN + (size_t)m * D + 8 * lane); v[u][1] = *(const u32x4*)(XN + (size_t)m * D + 8 * lane + 512);
            }
#pragma unroll
            for (int u = 0; u < 4; ++u) {
                const int m = m0 + u * NGW;
                if (m < M) {
                    const float rstd = rsqrtf(rs[u] * (1.0f / D) + EPS);
                    float* yrow = XR + (size_t)m * D;
#pragma unroll
                    for (int j = 0; j < 2; ++j) {
                        const u32x4 w = v[u][j];
                        const f32x4 g0 = *(const f32x4*)(gf + 8 * lane + 512 * j), g1 = *(const f32x4*)(gf + 8 * lane + 512 * j + 4);
                        f32x4 y0, y1;
                        y0[0] = bflo(w.x) * rstd * g0[0]; y0[1] = bfhi(w.x) * rstd * g0[1]; y0[2] = bflo(w.y) * rstd * g0[2]; y0[3] = bfhi(w.y) * rstd * g0[3];
                        y1[0] = bflo(w.z) * rstd * g1[0]; y1[1] = bfhi(w.z) * rstd * g1[1]; y1[2] = bflo(w.w) * rstd * g1[2]; y1[3] = bfhi(w.w) * rstd * g1[3];
                        __builtin_nontemporal_store(y0, (f32x4*)(yrow + 8 * lane + 512 * j)); __builtin_nontemporal_store(y1, (f32x4*)(yrow + 8 * lane + 512 * j + 4));
                    }
                }
            }
        }
    }
}

extern "C" void kernel_launch(void* const* d_in, const int* in_sizes, int n_in, void* d_out, int out_size, void* d_ws, size_t ws_size, hipStream_t stream) {
    static int grid = 0;
    if (grid == 0) {
        int dev = 0, cus = 0, per_cu = 0;
        (void)hipGetDevice(&dev);
        (void)hipDeviceGetAttribute(&cus, hipDeviceAttributeMultiprocessorCount, dev);
        (void)hipFuncSetAttribute((const void*)mega_fwd, hipFuncAttributeMaxDynamicSharedMemorySize, LDS_BYTES);
        (void)hipOccupancyMaxActiveBlocksPerMultiprocessor(&per_cu, (const void*)mega_fwd, NTHREADS, LDS_BYTES);
        if (per_cu < 1) per_cu = 1;
        if (per_cu > 1) per_cu = 1;
        grid = cus * per_cu;
        if (n_in != 16 || ws_size < WS_END) { fprintf(stderr, "kernel_launch: unexpected n_in %d / ws %zu\n", n_in, ws_size); }
    }
    (void)hipMemsetAsync((char*)d_ws + WS_CTL, 0, CTL_BYTES, stream);
    Args a{};
    for (int i = 0; i < 16; ++i) a.in[i] = (const float*)d_in[i];
    a.out = (float*)d_out; a.ws = (unsigned char*)d_ws;
    void* args[] = {&a};
    hipError_t e = hipLaunchCooperativeKernel((const void*)mega_fwd, dim3(grid), dim3(NTHREADS), args, LDS_BYTES, stream);
    if (e != hipSuccess) fprintf(stderr, "cooperative launch failed: %s (grid %d)\n", hipGetErrorString(e), grid);
}
```

```cpp
#include <hip/hip_runtime.h>
#include <hip/hip_cooperative_groups.h>
#include <cstdio>
#include <cstdint>
namespace cg = cooperative_groups;
namespace pg8 {
#define PG8_LAS __attribute__((address_space(3)))
typedef unsigned short bf16_t;
typedef short bf16x8 __attribute__((ext_vector_type(8)));
typedef float f32x4 __attribute__((ext_vector_type(4)));
typedef unsigned u32x4 __attribute__((ext_vector_type(4)));
constexpr int BM = 256, BK = 64, HALF = 128, HTB = HALF * BK * 2  , STAGE_BYTES = 8 * HTB, NXCD = 8, WGM = 8;

__host__ __device__ __forceinline__ int lds_byte(int r, int c) { const int st = (r >> 4) * 2 + (c >> 5), rr = r & 15, cc = c & 31, ob = rr * 64 + cc * 2; return st * 1024 + (ob ^ (((ob >> 9) & 1) << 5)); }
__host__ __device__ __forceinline__ void stage_rc(int b, int& R, int& C) { const int st = b / 1024, sb = b % 1024, swz = sb ^ (((sb >> 9) & 1) << 5); R = (st >> 1) * 16 + swz / 64; C = (st & 1) * 32 + (swz % 64) / 2; }
__host__ __device__ __forceinline__ int perm32(int rho) { const int n = rho >> 4, i = rho & 15; return 8 * (i >> 2) + 4 * n + (i & 3); }

struct Unit { int pm, pn; };
struct Gemm { const bf16_t* A; const bf16_t* Bt; int M, N, K; };

struct StaticOrder {
    int nM, nN, nwg, G, c;
    __host__ __device__ void init(int M, int N, int G_, int c_) { nM = M / BM; nN = N / BM; nwg = nM * nN; G = G_; c = c_; }
    __host__ __device__ bool next(int i, Unit& u) const {
        const long L = (long)i * G + c; if (L >= nwg) return false;
        int wgid = (int)L; { const int q = nwg / NXCD, r = nwg % NXCD, xcd = wgid % NXCD, off = wgid / NXCD; wgid = (xcd < r ? xcd * (q + 1) : r * (q + 1) + (xcd - r) * q) + off; }
        const int nig = WGM * nN, gid = wgid / nig, fm = gid * WGM, gsz = (nM - fm) < WGM ? (nM - fm) : WGM;
        u.pm = fm + ((wgid % nig) % gsz); u.pn = (wgid % nig) / gsz; return true;
    }
    __device__ __forceinline__ void a_ready(const Unit&) const {}
    __device__ __forceinline__ void done(const Unit&) const {}
};
__device__ __forceinline__ unsigned cvt_pk_bf16(float lo, float hi) { unsigned r; asm volatile("v_cvt_pk_bf16_f32 %0, %1, %2" : "=v"(r) : "v"(lo), "v"(hi)); return r; }
typedef float f32x2 __attribute__((ext_vector_type(2)));
template <class Epi, class Sched, bool ALIGN_EPI = false, bool SP2 = false>
__device__ __forceinline__ void gemm_phase(PG8_LAS unsigned char* lds, const Gemm g, const Sched& S, const Epi& E) {
    int tid_ = threadIdx.x; asm volatile("" : "+v"(tid_)); const int tid = tid_, wid = __builtin_amdgcn_readfirstlane(tid >> 6), lane = tid & 63, wr = wid >> 2, wc = wid & 3, fr = lane & 15, fq = lane >> 4;
    const int K = g.K, nt = K / BK;
    unsigned voffA[2], voffB[2];
#pragma unroll
    for (int i = 0; i < 2; ++i) { int R, C; stage_rc(tid * 16 + i * 8192, R, C); const int Rb = Epi::PERM ? ((R & ~31) + perm32(R & 31)) : R;
        voffA[i] = (unsigned)(R * K + C) * 2u; voffB[i] = (unsigned)(Rb * K + C) * 2u; }
    const size_t kstep = (size_t)(BK * 2);
    const size_t hstep = (size_t)HALF * K * 2;
    const size_t tstep = 2 * hstep;
    const unsigned ldsw = (unsigned)wid * 1024u;
    const int aoff = lds_byte(wr * 64 + fr, fq * 8), boff = lds_byte(wc * 32 + fr, fq * 8);
#define PG8_SA(b, h) (((b) * 2 + (h)) * HTB)
#define PG8_SB(b, h) ((4 + (b) * 2 + (h)) * HTB)
#define PG8_STAGE(bufoff, gbase, voff) do { _Pragma("unroll") for (int _i = 0; _i < 2; ++_i) \
        __builtin_amdgcn_global_load_lds((const unsigned*)((const char*)(gbase) + (voff)[_i]), (PG8_LAS unsigned*)(lds + (bufoff) + ldsw + _i * 8192), 16, 0, 0); } while (0)
#define PG8_LDA(dst, b, h) do { _Pragma("unroll") for (int m = 0; m < 4; ++m) _Pragma("unroll") for (int k = 0; k < 2; ++k) dst[m][k] = *(const PG8_LAS bf16x8*)(lds + PG8_SA(b, h) + aoff + m * 2048 + k * 1024); } while (0)
#define PG8_LDB(dst, b, h) do { _Pragma("unroll") for (int n = 0; n < 2; ++n) _Pragma("unroll") for (int k = 0; k < 2; ++k) dst[n][k] = *(const PG8_LAS bf16x8*)(lds + PG8_SB(b, h) + boff + n * 2048 + k * 1024); } while (0)
#define PG8_MMA(ai, bj, At, Bt) do { __builtin_amdgcn_s_setprio(1); _Pragma("unroll") for (int m = 0; m < 4; ++m) _Pragma("unroll") for (int n = 0; n < 2; ++n) _Pragma("unroll") for (int k = 0; k < 2; ++k) \
        acc[ai][bj][m][n] = __builtin_amdgcn_mfma_f32_16x16x32_bf16(Bt[n][k], At[m][k], acc[ai][bj][m][n], 0, 0, 0); __builtin_amdgcn_s_setprio(0); } while (0)
#define PG8_WAIT_V(n) asm volatile("s_waitcnt vmcnt(" #n ")" ::: "memory")
#define PG8_WAIT_L(n) asm volatile("s_waitcnt lgkmcnt(" #n ")" ::: "memory")
#define PG8_BAR __builtin_amdgcn_s_barrier()
#define PG8_SCHED __builtin_amdgcn_sched_barrier(0)
    Unit cur, nxt; int ui = 0;
    if (!S.next(0, cur)) return;
    f32x4 acc[2][2][4][2];
#pragma unroll
    for (int a = 0; a < 2; ++a)
#pragma unroll
        for (int b = 0; b < 2; ++b)
#pragma unroll
            for (int m = 0; m < 4; ++m)
#pragma unroll
                for (int n = 0; n < 2; ++n) acc[a][b][m][n] = (f32x4){0.f, 0.f, 0.f, 0.f};
    bf16x8 At[4][2], B0[2][2], B1[2][2];
    const char* cA = (const char*)g.A + (size_t)cur.pm * tstep; const char* cB = (const char*)g.Bt + (size_t)cur.pn * tstep;
    S.a_ready(cur);
    if constexpr (SP2) {
        PG8_STAGE(PG8_SB(0, 0), cB, voffB); PG8_STAGE(PG8_SB(0, 1), cB + hstep, voffB); PG8_STAGE(PG8_SA(0, 0), cA, voffA); PG8_STAGE(PG8_SA(0, 1), cA + hstep, voffA);
        if (wr == 1) PG8_BAR;
        PG8_WAIT_V(2); PG8_BAR;
        PG8_STAGE(PG8_SB(1, 0), cB + kstep, voffB); PG8_STAGE(PG8_SA(1, 0), cA + kstep, voffA); PG8_STAGE(PG8_SB(1, 1), cB + hstep + kstep, voffB);
        PG8_WAIT_V(6); PG8_BAR;
    } else {
        PG8_STAGE(PG8_SB(0, 0), cB, voffB); PG8_STAGE(PG8_SA(0, 0), cA, voffA); PG8_STAGE(PG8_SB(0, 1), cB + hstep, voffB); PG8_STAGE(PG8_SA(0, 1), cA + hstep, voffA);
        if (wr == 1) PG8_BAR;
        PG8_WAIT_V(4); PG8_BAR;
        PG8_STAGE(PG8_SB(1, 0), cB + kstep, voffB); PG8_STAGE(PG8_SA(1, 0), cA + kstep, voffA); PG8_STAGE(PG8_SB(1, 1), cB + hstep + kstep, voffB);
        PG8_WAIT_V(6); PG8_BAR;
    }
    for (;;) {
        const bool has_next = S.next(ui + 1, nxt);
        const char* nA = has_next ? (const char*)g.A + (size_t)nxt.pm * tstep : cA; const char* nB = has_next ? (const char*)g.Bt + (size_t)nxt.pn * tstep : cB;
        for (int t = 0; t < nt; t += 2) {
            const bool last = (t == nt - 2);
            const char* a1 = cA + (size_t)(t + 1) * kstep;
            const char* a2 = last ? nA : cA + (size_t)(t + 2) * kstep; const char* b2 = last ? nB : cB + (size_t)(t + 2) * kstep;
            const char* a3 = a2 + kstep; const char* b3 = b2 + kstep;
            if (last && has_next) S.a_ready(nxt);
            if constexpr (SP2) {
            PG8_LDB(B0, 0, 0); PG8_LDB(B1, 0, 1); PG8_SCHED; PG8_LDA(At, 0, 0); PG8_STAGE(PG8_SA(1, 1), a1 + hstep, voffA);
            PG8_WAIT_V(8); PG8_WAIT_L(0); PG8_BAR; PG8_MMA(0, 0, At, B0); PG8_MMA(0, 1, At, B1); PG8_BAR; PG8_SCHED;
            PG8_LDA(At, 0, 1); PG8_STAGE(PG8_SB(0, 0), b2, voffB); PG8_STAGE(PG8_SB(0, 1), b2 + hstep, voffB); PG8_STAGE(PG8_SA(0, 0), a2, voffA);
            PG8_WAIT_V(8); PG8_WAIT_L(0); PG8_BAR; PG8_MMA(1, 0, At, B0); PG8_MMA(1, 1, At, B1); PG8_BAR; PG8_SCHED;
            PG8_LDB(B0, 1, 0); PG8_LDB(B1, 1, 1); PG8_SCHED; PG8_LDA(At, 1, 0); PG8_STAGE(PG8_SA(0, 1), a2 + hstep, voffA);
            PG8_WAIT_V(8); PG8_WAIT_L(0); PG8_BAR; PG8_MMA(0, 0, At, B0); PG8_MMA(0, 1, At, B1); PG8_BAR; PG8_SCHED;
            PG8_LDA(At, 1, 1); PG8_STAGE(PG8_SB(1, 0), b3, voffB); PG8_STAGE(PG8_SB(1, 1), b3 + hstep, voffB); PG8_STAGE(PG8_SA(1, 0), a3, voffA);
            PG8_WAIT_V(8); PG8_WAIT_L(0); PG8_BAR; PG8_MMA(1, 0, At, B0); PG8_MMA(1, 1, At, B1); PG8_BAR; PG8_SCHED;
            } else {
            PG8_LDB(B0, 0, 0); PG8_SCHED; PG8_LDA(At, 0, 0); PG8_STAGE(PG8_SA(1, 1), a1 + hstep, voffA);
            PG8_WAIT_L(8); PG8_BAR; PG8_WAIT_L(0); PG8_MMA(0, 0, At, B0); PG8_BAR; PG8_SCHED;
            PG8_LDB(B1, 0, 1); PG8_STAGE(PG8_SB(0, 0), b2, voffB);
            PG8_BAR; PG8_WAIT_L(0); PG8_MMA(0, 1, At, B1); PG8_BAR;
            PG8_LDA(At, 0, 1); PG8_STAGE(PG8_SA(0, 0), a2, voffA);
            PG8_BAR; PG8_WAIT_L(0); PG8_MMA(1, 0, At, B0); PG8_BAR; PG8_SCHED;
            PG8_STAGE(PG8_SB(0, 1), b2 + hstep, voffB);
            PG8_WAIT_V(6); PG8_BAR; PG8_MMA(1, 1, At, B1); PG8_BAR;
            PG8_LDB(B0, 1, 0); PG8_SCHED; PG8_LDA(At, 1, 0); PG8_STAGE(PG8_SA(0, 1), a2 + hstep, voffA);
            PG8_WAIT_L(8); PG8_BAR; PG8_WAIT_L(0); PG8_MMA(0, 0, At, B0); PG8_BAR; PG8_SCHED;
            PG8_LDB(B1, 1, 1); PG8_STAGE(PG8_SB(1, 0), b3, voffB);
            PG8_BAR; PG8_WAIT_L(0); PG8_MMA(0, 1, At, B1); PG8_BAR;
            PG8_LDA(At, 1, 1); PG8_STAGE(PG8_SA(1, 0), a3, voffA);
            PG8_BAR; PG8_WAIT_L(0); PG8_MMA(1, 0, At, B0); PG8_BAR; PG8_SCHED;
            PG8_STAGE(PG8_SB(1, 1), b3 + hstep, voffB);
            PG8_WAIT_V(6); PG8_BAR; PG8_MMA(1, 1, At, B1); PG8_BAR;
            }
        }
        if constexpr (ALIGN_EPI) { if (wr == 0) PG8_BAR; }
        if constexpr (!Epi::AFTER_DRAIN) { E(acc, cur, wr, wc, fr, fq); S.done(cur); }
        if (!has_next) break;
#pragma unroll
        for (int a = 0; a < 2; ++a)
#pragma unroll
            for (int b = 0; b < 2; ++b)
#pragma unroll
                for (int m = 0; m < 4; ++m)
#pragma unroll
                    for (int n = 0; n < 2; ++n) acc[a][b][m][n] = (f32x4){0.f, 0.f, 0.f, 0.f};
        cur = nxt; cA = nA; cB = nB; ++ui;
        if constexpr (ALIGN_EPI) { if (wr == 1) PG8_BAR; }
    }
    PG8_WAIT_V(0);
    if constexpr (!ALIGN_EPI) { if (wr == 0) PG8_BAR; }
    PG8_BAR;
    if constexpr (Epi::AFTER_DRAIN) { E.fused(acc, cur, wr, wc, fr, fq, lds, wid, lane); S.done(cur); }
#undef PG8_SA
#undef PG8_SB
#undef PG8_STAGE
#undef PG8_LDA
#undef PG8_LDB
#undef PG8_MMA
#undef PG8_WAIT_V
#undef PG8_WAIT_L
#undef PG8_BAR
#undef PG8_SCHED
}
}

#ifndef REP_P0
#define REP_P0 1
#endif
#ifndef REP_BIG
#define REP_BIG 1
#endif
#ifndef REP_SMALL
#define REP_SMALL 1
#endif
#ifndef REP_P2
#define REP_P2 1
#endif
#ifndef REP_P3
#define REP_P3 1
#endif
#define LAS __attribute__((address_space(3)))
typedef unsigned short bf16;
typedef float f32x4 __attribute__((ext_vector_type(4)));
typedef float f32x2 __attribute__((ext_vector_type(2)));
typedef unsigned u32x4 __attribute__((ext_vector_type(4)));
typedef unsigned u32x2 __attribute__((ext_vector_type(2)));
typedef short bf16x8 __attribute__((ext_vector_type(8)));
typedef short s16x4 __attribute__((ext_vector_type(4)));

constexpr int D = 1024, MP = 16384, MS = 512, M = MP + MS, SEQ = 2048, NIN = 3072, FF = 4096, CD = 512, NH = 4, HD = 128, CW = 31, NPOS = 2052;
constexpr float EPS = 1e-6f;
constexpr int NWAVES = 8, NTHREADS = 512;
constexpr int LDS_BYTES = 147456;
constexpr size_t MiB = 1u << 20;
constexpr size_t WS_CTL = 0, CTL_BYTES = 65536;
constexpr size_t WS_ROPE = 1 * MiB;
constexpr size_t WS_SSQ = 3 * MiB;
constexpr size_t WS_W = 4 * MiB, W_LAYER = 24 * MiB;
constexpr size_t W_IN = 0, W_OUT = 6 * MiB, W_UP = 8 * MiB, W_DN = 16 * MiB;
constexpr size_t WS_XN = 52 * MiB;
constexpr size_t WS_R1 = 85 * MiB;
constexpr size_t WS_H = WS_R1;
constexpr size_t ACT512 = (size_t)M * 512 * 2;
constexpr size_t WS_GLU = WS_R1, WS_Q = WS_GLU + ACT512, WS_K = WS_Q + ACT512, WS_V = WS_K + ACT512, WS_GATE = WS_V + ACT512;
constexpr size_t WS_MIX = WS_GATE + ACT512;
constexpr size_t WS_KV = WS_MIX + (size_t)M * 1024 * 2;
constexpr size_t WS_SB = WS_KV + 32 * MiB;
constexpr size_t WS_END = WS_SB + 16 * MiB;
static_assert(WS_END <= 256 * MiB, "ws map");
static_assert(WS_H + (size_t)M * FF * 2 <= WS_END, "ws map H");
constexpr size_t O_Y = 0, O_CP = (size_t)M * D, O_RP = O_CP + 2 * 8 * 30 * 512, O_CS = O_RP + 2 * 8 * 4 * 128 * 128, O_RS = O_CS + 2 * 128 * 30 * 512;

__device__ const float ROPE_INV[64] = {
1.0f, 0.865964353f, 0.749894202f, 0.649381638f, 0.562341332f, 0.486967534f, 0.421696514f, 0.365174115f, 0.316227764f, 0.273841977f, 0.237137377f, 0.2053525f, 0.177827939f, 0.153992653f, 0.133352146f, 0.115478195f, 0.100000001f, 0.0865964293f, 0.0749894232f, 0.0649381652f, 0.0562341325f, 0.0486967526f, 0.0421696492f, 0.0365174115f, 0.0316227749f, 0.0273841955f, 0.0237137377f, 0.0205352511f, 0.0177827943f, 0.0153992651f, 0.013335214f, 0.0115478197f, 0.00999999978f, 0.00865964312f, 0.00749894232f, 0.00649381615f, 0.00562341325f, 0.00486967526f, 0.00421696482f, 0.00365174119f, 0.00316227763f, 0.00273841969f, 0.00237137382f, 0.00205352507f, 0.00177827943f, 0.00153992651f, 0.00133352145f, 0.00115478202f, 0.00100000005f, 0.000865964335f, 0.000749894185f, 0.000649381604f, 0.000562341302f, 0.000486967532f, 0.000421696517f, 0.000365174114f, 0.000316227757f, 0.000273841957f, 0.00023713737f, 0.00020535251f, 0.00017782794f, 0.00015399266f, 0.00013335215f, 0.0001154782f
};

struct Args { const float* in[16]; float* out; unsigned char* ws; };

__device__ __forceinline__ float bf2f(unsigned short x) { return __uint_as_float(((unsigned)x) << 16); }
__device__ __forceinline__ float bflo(unsigned w) { return __uint_as_float(w << 16); }
__device__ __forceinline__ float bfhi(unsigned w) { return __uint_as_float(w & 0xffff0000u); }
typedef __bf16 bf16x2_t __attribute__((ext_vector_type(2)));
__device__ __forceinline__ unsigned pk_bf16(float lo, float hi) { const f32x2 v = {lo, hi}; return __builtin_bit_cast(unsigned, __builtin_convertvector(v, bf16x2_t)); }
__device__ __forceinline__ float wave_sum(float v) {
#pragma unroll
    for (int o = 1; o < 64; o <<= 1) v += __shfl_xor(v, o);
    return v;
}
__device__ __forceinline__ int ltid() { int t = threadIdx.x; asm volatile("" : "+v"(t)); return t; }
__device__ __forceinline__ float fast_rcp(float x) { return __builtin_amdgcn_rcpf(x); }
__device__ __forceinline__ float sigmoidf_(float x) { return fast_rcp(1.0f + __expf(-x)); }

struct EpiIn {
    static constexpr bool PERM = true, AFTER_DRAIN = false;
    const float* ssq; bf16 *glu, *q, *k, *v, *gate; const f32x2* rope; const float* gn_g;
    __device__ __forceinline__ void operator()(const f32x4 (&acc)[2][2][4][2], const pg8::Unit& u, int wr, int wc, int fr, int fq) const {
        const int pn = u.pn, cl = wc * 32 + fq * 8;
#pragma unroll
        for (int ai = 0; ai < 2; ++ai)
#pragma unroll
            for (int m = 0; m < 4; ++m) {
                const int row = u.pm * 256 + ai * 128 + wr * 64 + m * 16 + fr;
                const float rstd = rsqrtf(ssq[row] * (1.0f / D) + EPS);
                const f32x4 a0 = acc[ai][0][m][0] * rstd, a1 = acc[ai][0][m][1] * rstd, b0 = acc[ai][1][m][0] * rstd, b1 = acc[ai][1][m][1] * rstd;
                if (pn < 4) {
                    u32x4 w;
                    w.x = pk_bf16(a0[0] * sigmoidf_(b0[0]), a0[1] * sigmoidf_(b0[1])); w.y = pk_bf16(a0[2] * sigmoidf_(b0[2]), a0[3] * sigmoidf_(b0[3]));
                    w.z = pk_bf16(a1[0] * sigmoidf_(b1[0]), a1[1] * sigmoidf_(b1[1])); w.w = pk_bf16(a1[2] * sigmoidf_(b1[2]), a1[3] * sigmoidf_(b1[3]));
                    *(u32x4*)(glu + (size_t)row * 512 + pn * 128 + cl) = w;
                } else if (pn < 8) {
                    const int which = (pn - 4) >> 1, tp = pn & 1, head = 2 * tp + (wc >> 1), dlo = (wc & 1) * 32 + fq * 8;
                    const int prow = row < MP ? (row & (SEQ - 1)) : SEQ + ((row - MP) & 3);
                    const f32x4* rp = (const f32x4*)(rope + (size_t)prow * 64 + dlo);
                    const f32x4 c01 = rp[0], c23 = rp[1], c45 = rp[2], c67 = rp[3];
                    const float sc = which ? 0.08838834764831845f : 1.0f;
                    float o1[8], o2[8];
                    o1[0] = a0[0] * c01[0] - b0[0] * c01[1]; o2[0] = b0[0] * c01[0] + a0[0] * c01[1];
                    o1[1] = a0[1] * c01[2] - b0[1] * c01[3]; o2[1] = b0[1] * c01[2] + a0[1] * c01[3];
                    o1[2] = a0[2] * c23[0] - b0[2] * c23[1]; o2[2] = b0[2] * c23[0] + a0[2] * c23[1];
                    o1[3] = a0[3] * c23[2] - b0[3] * c23[3]; o2[3] = b0[3] * c23[2] + a0[3] * c23[3];
                    o1[4] = a1[0] * c45[0] - b1[0] * c45[1]; o2[4] = b1[0] * c45[0] + a1[0] * c45[1];
                    o1[5] = a1[1] * c45[2] - b1[1] * c45[3]; o2[5] = b1[1] * c45[2] + a1[1] * c45[3];
                    o1[6] = a1[2] * c67[0] - b1[2] * c67[1]; o2[6] = b1[2] * c67[0] + a1[2] * c67[1];
                    o1[7] = a1[3] * c67[2] - b1[3] * c67[3]; o2[7] = b1[3] * c67[2] + a1[3] * c67[3];
                    bf16* dst = (which ? k : q) + (size_t)row * 512 + head * 128 + dlo;
                    u32x4 w1, w2;
                    w1.x = pk_bf16(o1[0] * sc, o1[1] * sc); w1.y = pk_bf16(o1[2] * sc, o1[3] * sc); w1.z = pk_bf16(o1[4] * sc, o1[5] * sc); w1.w = pk_bf16(o1[6] * sc, o1[7] * sc);
                    w2.x = pk_bf16(o2[0] * sc, o2[1] * sc); w2.y = pk_bf16(o2[2] * sc, o2[3] * sc); w2.z = pk_bf16(o2[4] * sc, o2[5] * sc); w2.w = pk_bf16(o2[6] * sc, o2[7] * sc);
                    *(u32x4*)dst = w1; *(u32x4*)(dst + 64) = w2;
                } else if (pn < 10) {
                    bf16* dst = v + (size_t)row * 512 + (pn - 8) * 256 + cl;
                    u32x4 w1, w2;
                    w1.x = pk_bf16(a0[0], a0[1]); w1.y = pk_bf16(a0[2], a0[3]); w1.z = pk_bf16(a1[0], a1[1]); w1.w = pk_bf16(a1[2], a1[3]);
                    w2.x = pk_bf16(b0[0], b0[1]); w2.y = pk_bf16(b0[2], b0[3]); w2.z = pk_bf16(b1[0], b1[1]); w2.w = pk_bf16(b1[2], b1[3]);
                    *(u32x4*)dst = w1; *(u32x4*)(dst + 128) = w2;
                } else {
                    const int c0 = (pn - 10) * 256 + cl;
                    const f32x4 g0 = *(const f32x4*)(gn_g + c0), g1 = *(const f32x4*)(gn_g + c0 + 4), g2 = *(const f32x4*)(gn_g + c0 + 128), g3 = *(const f32x4*)(gn_g + c0 + 132);
                    bf16* dst = gate + (size_t)row * 512 + c0;
                    u32x4 w1, w2;
                    w1.x = pk_bf16(a0[0] * sigmoidf_(a0[0]) * g0[0], a0[1] * sigmoidf_(a0[1]) * g0[1]); w1.y = pk_bf16(a0[2] * sigmoidf_(a0[2]) * g0[2], a0[3] * sigmoidf_(a0[3]) * g0[3]);
                    w1.z = pk_bf16(a1[0] * sigmoidf_(a1[0]) * g1[0], a1[1] * sigmoidf_(a1[1]) * g1[1]); w1.w = pk_bf16(a1[2] * sigmoidf_(a1[2]) * g1[2], a1[3] * sigmoidf_(a1[3]) * g1[3]);
                    w2.x = pk_bf16(b0[0] * sigmoidf_(b0[0]) * g2[0], b0[1] * sigmoidf_(b0[1]) * g2[1]); w2.y = pk_bf16(b0[2] * sigmoidf_(b0[2]) * g2[2], b0[3] * sigmoidf_(b0[3]) * g2[3]);
                    w2.z = pk_bf16(b1[0] * sigmoidf_(b1[0]) * g3[0], b1[1] * sigmoidf_(b1[1]) * g3[1]); w2.w = pk_bf16(b1[2] * sigmoidf_(b1[2]) * g3[2], b1[3] * sigmoidf_(b1[3]) * g3[3]);
                    *(u32x4*)dst = w1; *(u32x4*)(dst + 128) = w2;
                }
            }
    }

    __device__ __forceinline__ int brow(int cg, int fb) const { return 256 * (cg >> 2) + 32 * (cg & 3) + (fb >> 1) * 128 + (fb & 1) * 16; }
    __device__ __forceinline__ void small(int row, int cg, int s4, f32x4 a, f32x4 b) const {
        const int pn = cg >> 2, cl = 32 * (cg & 3) + s4;
        const float rstd = rsqrtf(ssq[row] * (1.0f / D) + EPS);
        a = a * rstd; b = b * rstd;
        if (pn < 4) {
            u32x2 w; w.x = pk_bf16(a[0] * sigmoidf_(b[0]), a[1] * sigmoidf_(b[1])); w.y = pk_bf16(a[2] * sigmoidf_(b[2]), a[3] * sigmoidf_(b[3]));
            *(u32x2*)(glu + (size_t)row * 512 + pn * 128 + cl) = w;
        } else if (pn < 8) {
            const int which = (pn - 4) >> 1, tp = pn & 1, head = 2 * tp + (cl >> 6), dlo = cl & 63;
            const int prow = row < MP ? (row & (SEQ - 1)) : SEQ + ((row - MP) & 3);
            const f32x4* rp = (const f32x4*)(rope + (size_t)prow * 64 + dlo);
            const f32x4 c01 = rp[0], c23 = rp[1];
            const float sc = which ? 0.08838834764831845f : 1.0f;
            const float p0 = a[0] * c01[0] - b[0] * c01[1], r0 = b[0] * c01[0] + a[0] * c01[1];
            const float p1 = a[1] * c01[2] - b[1] * c01[3], r1 = b[1] * c01[2] + a[1] * c01[3];
            const float p2 = a[2] * c23[0] - b[2] * c23[1], r2 = b[2] * c23[0] + a[2] * c23[1];
            const float p3 = a[3] * c23[2] - b[3] * c23[3], r3 = b[3] * c23[2] + a[3] * c23[3];
            bf16* dst = (which ? k : q) + (size_t)row * 512 + head * 128 + dlo;
            u32x2 w1, w2; w1.x = pk_bf16(p0 * sc, p1 * sc); w1.y = pk_bf16(p2 * sc, p3 * sc); w2.x = pk_bf16(r0 * sc, r1 * sc); w2.y = pk_bf16(r2 * sc, r3 * sc);
            *(u32x2*)dst = w1; *(u32x2*)(dst + 64) = w2;
        } else if (pn < 10) {
            bf16* dst = v + (size_t)row * 512 + (pn - 8) * 256 + cl;
            u32x2 w1, w2; w1.x = pk_bf16(a[0], a[1]); w1.y = pk_bf16(a[2], a[3]); w2.x = pk_bf16(b[0], b[1]); w2.y = pk_bf16(b[2], b[3]);
            *(u32x2*)dst = w1; *(u32x2*)(dst + 128) = w2;
        } else {
            const int c0 = (pn - 10) * 256 + cl;
            const f32x4 g0 = *(const f32x4*)(gn_g + c0), g2 = *(const f32x4*)(gn_g + c0 + 128);
            bf16* dst = gate + (size_t)row * 512 + c0;
            u32x2 w1, w2;
            w1.x = pk_bf16(a[0] * sigmoidf_(a[0]) * g0[0], a[1] * sigmoidf_(a[1]) * g0[1]); w1.y = pk_bf16(a[2] * sigmoidf_(a[2]) * g0[2], a[3] * sigmoidf_(a[3]) * g0[3]);
            w2.x = pk_bf16(b[0] * sigmoidf_(b[0]) * g2[0], b[1] * sigmoidf_(b[1]) * g2[1]); w2.y = pk_bf16(b[2] * sigmoidf_(b[2]) * g2[2], b[3] * sigmoidf_(b[3]) * g2[3]);
            *(u32x2*)dst = w1; *(u32x2*)(dst + 128) = w2;
        }
    }
};

struct EpiRes {
    static constexpr bool PERM = true, AFTER_DRAIN = false;
    bf16* xs; float* ssq;
    __device__ __forceinline__ void operator()(const f32x4 (&acc)[2][2][4][2], const pg8::Unit& u, int wr, int wc, int fr, int fq) const {
        const int colb = u.pn * 256 + wc * 32 + fq * 8;
#pragma unroll
        for (int ai = 0; ai < 2; ++ai)
#pragma unroll
            for (int m = 0; m < 4; ++m) {
                const int row = u.pm * 256 + ai * 128 + wr * 64 + m * 16 + fr;
                float ss = 0.f;
#pragma unroll
                for (int bj = 0; bj < 2; ++bj) {
                    bf16* p = xs + (size_t)row * D + colb + bj * 128;
                    const u32x4 rv = *(const u32x4*)p;
                    const f32x4 a0 = acc[ai][bj][m][0], a1 = acc[ai][bj][m][1];
                    const float x0 = bflo(rv.x) + a0[0], x1 = bfhi(rv.x) + a0[1], x2 = bflo(rv.y) + a0[2], x3 = bfhi(rv.y) + a0[3];
                    const float x4 = bflo(rv.z) + a1[0], x5 = bfhi(rv.z) + a1[1], x6 = bflo(rv.w) + a1[2], x7 = bfhi(rv.w) + a1[3];
                    ss += (x0 * x0 + x1 * x1) + (x2 * x2 + x3 * x3) + (x4 * x4 + x5 * x5) + (x6 * x6 + x7 * x7);
                    u32x4 w; w.x = pk_bf16(x0, x1); w.y = pk_bf16(x2, x3); w.z = pk_bf16(x4, x5); w.w = pk_bf16(x6, x7);
                    *(u32x4*)p = w;
                }
                ss += __shfl_xor(ss, 16); ss += __shfl_xor(ss, 32);
                if (fq == 0) unsafeAtomicAdd(ssq + row, ss);
            }
    }
    __device__ __forceinline__ int brow(int cg, int fb) const { return 64 * cg + 16 * fb; }
    __device__ __forceinline__ void small(int row, int cg, int s4, f32x4 a, f32x4 b) const {
        bf16* p = xs + (size_t)row * D + 64 * cg + s4;
        const u32x2 r0 = *(const u32x2*)p, r1 = *(const u32x2*)(p + 32);
        const float x0 = bflo(r0.x) + a[0], x1 = bfhi(r0.x) + a[1], x2 = bflo(r0.y) + a[2], x3 = bfhi(r0.y) + a[3];
        const float x4 = bflo(r1.x) + b[0], x5 = bfhi(r1.x) + b[1], x6 = bflo(r1.y) + b[2], x7 = bfhi(r1.y) + b[3];
        float ss = (x0 * x0 + x1 * x1) + (x2 * x2 + x3 * x3) + (x4 * x4 + x5 * x5) + (x6 * x6 + x7 * x7);
        u32x2 w0, w1; w0.x = pk_bf16(x0, x1); w0.y = pk_bf16(x2, x3); w1.x = pk_bf16(x4, x5); w1.y = pk_bf16(x6, x7);
        *(u32x2*)p = w0; *(u32x2*)(p + 32) = w1;
        ss += __shfl_xor(ss, 1); ss += __shfl_xor(ss, 2); ss += __shfl_xor(ss, 4);
        if ((s4 >> 2) == 0) unsafeAtomicAdd(ssq + row, ss);
    }
};

struct EpiUp {
    static constexpr bool PERM = true, AFTER_DRAIN = false;
    const float* ssq; bf16* h;
    __device__ __forceinline__ void operator()(const f32x4 (&acc)[2][2][4][2], const pg8::Unit& u, int wr, int wc, int fr, int fq) const {
        const int colb = u.pn * 256 + wc * 32 + fq * 8;
#pragma unroll
        for (int ai = 0; ai < 2; ++ai)
#pragma unroll
            for (int m = 0; m < 4; ++m) {
                const int row = u.pm * 256 + ai * 128 + wr * 64 + m * 16 + fr;
                const float rstd = rsqrtf(ssq[row] * (1.0f / D) + EPS);
#pragma unroll
                for (int bj = 0; bj < 2; ++bj) {
                    f32x4 x0 = acc[ai][bj][m][0] * rstd, x1 = acc[ai][bj][m][1] * rstd;
#pragma unroll
                    for (int e = 0; e < 4; ++e) { const float t0 = fmaxf(x0[e], 0.f), t1 = fmaxf(x1[e], 0.f); x0[e] = t0 * t0; x1[e] = t1 * t1; }
                    u32x4 w; w.x = pk_bf16(x0[0], x0[1]); w.y = pk_bf16(x0[2], x0[3]); w.z = pk_bf16(x1[0], x1[1]); w.w = pk_bf16(x1[2], x1[3]);
                    *(u32x4*)(h + (size_t)row * FF + colb + bj * 128) = w;
                }
            }
    }

    __device__ __forceinline__ int brow(int cg, int fb) const { return 64 * cg + 16 * fb; }
    __device__ __forceinline__ void small(int row, int cg, int s4, f32x4 a, f32x4 b) const {
        const float rstd = rsqrtf(ssq[row] * (1.0f / D) + EPS);
        const int col = 64 * cg + s4;
#pragma unroll
        for (int e = 0; e < 4; ++e) { const float t0 = fmaxf(a[e] * rstd, 0.f), t1 = fmaxf(b[e] * rstd, 0.f); a[e] = t0 * t0; b[e] = t1 * t1; }
        u32x2 w0, w1; w0.x = pk_bf16(a[0], a[1]); w0.y = pk_bf16(a[2], a[3]); w1.x = pk_bf16(b[0], b[1]); w1.y = pk_bf16(b[2], b[3]);
        *(u32x2*)(h + (size_t)row * FF + col) = w0; *(u32x2*)(h + (size_t)row * FF + col + 32) = w1;
    }
};

constexpr int SG_LD = 68;
template <class Epi, int RT>
__device__ __forceinline__ void small_gemm(LAS unsigned char* lds, const bf16* A, const bf16* Bt, int K, int ncg, const Epi& E) {
    const int tid = ltid(), lane = tid & 63, wave = __builtin_amdgcn_readfirstlane(tid >> 6), r = lane & 15, q = lane >> 4;
    constexpr int KS = RT == 2 ? 4 : 8;
    const int kw = K / KS, kq = RT == 2 ? (wave & 3) : wave, rh = RT == 2 ? (wave >> 2) : 0;
    for (int it = blockIdx.x; it < (8 / RT) * ncg; it += gridDim.x) {
        const int rt = it / ncg, cg = it % ncg;
        const int rowbase = MP + 64 * RT * rt;
        const bf16* ap = A + (size_t)(rowbase + 64 * rh + r) * K + kq * kw + 8 * q;
        const bf16* bp0 = Bt + (size_t)(E.brow(cg, 0) + r) * K + kq * kw + 8 * q;
        const bf16* bp1 = Bt + (size_t)(E.brow(cg, 1) + r) * K + kq * kw + 8 * q;
        const bf16* bp2 = Bt + (size_t)(E.brow(cg, 2) + r) * K + kq * kw + 8 * q;
        const bf16* bp3 = Bt + (size_t)(E.brow(cg, 3) + r) * K + kq * kw + 8 * q;
        f32x4 acc[4][4];
#pragma unroll
        for (int i = 0; i < 4; ++i)
#pragma unroll
            for (int j = 0; j < 4; ++j) acc[i][j] = (f32x4){0.f, 0.f, 0.f, 0.f};
        {
            LAS unsigned char* st = lds + wave * 9216;
            const int lrow = lane >> 3, lch = lane & 7;
            const bf16* ag = A + (size_t)(rowbase + 64 * rh + lrow) * K + kq * kw + lch * 8;
            const bf16* bg0 = Bt + (size_t)(E.brow(cg, 0) + lrow) * K + kq * kw + lch * 8;
            const bf16* bg1 = Bt + (size_t)(E.brow(cg, 1) + lrow) * K + kq * kw + lch * 8;
            const bf16* bg2 = Bt + (size_t)(E.brow(cg, 2) + lrow) * K + kq * kw + lch * 8;
            const bf16* bg3 = Bt + (size_t)(E.brow(cg, 3) + lrow) * K + kq * kw + lch * 8;
            const int wro = lrow * 144 + lch * 16, fro = r * 144 + q * 16;
            u32x4 ga[8], gb[8];
#define SG_GLOAD_A(kk) do { _Pragma("unroll") for (int i = 0; i < 8; ++i) ga[i] = *(const u32x4*)(ag + (size_t)(8 * i) * K + (kk)); } while (0)
#define SG_GLOAD_B(kk) do { \
            gb[0] = *(const u32x4*)(bg0 + (kk)); gb[1] = *(const u32x4*)(bg0 + (size_t)8 * K + (kk)); gb[2] = *(const u32x4*)(bg1 + (kk)); gb[3] = *(const u32x4*)(bg1 + (size_t)8 * K + (kk)); \
            gb[4] = *(const u32x4*)(bg2 + (kk)); gb[5] = *(const u32x4*)(bg2 + (size_t)8 * K + (kk)); gb[6] = *(const u32x4*)(bg3 + (kk)); gb[7] = *(const u32x4*)(bg3 + (size_t)8 * K + (kk)); } while (0)
            SG_GLOAD_A(0); SG_GLOAD_B(0);
#pragma unroll 1
            for (int kk = 0; kk < kw; kk += 64) {
                bf16x8 a[2][4], b[2][4];
#pragma unroll
                for (int i = 0; i < 8; ++i) *(LAS u32x4*)(st + i * (8 * 144) + wro) = ga[i];
                if (kk + 64 < kw) SG_GLOAD_A(kk + 64);
#pragma unroll
                for (int ks = 0; ks < 2; ++ks)
#pragma unroll
                    for (int fa = 0; fa < 4; ++fa) a[ks][fa] = *(const LAS bf16x8*)(st + fa * (16 * 144) + fro + ks * 64);
                asm volatile("s_waitcnt lgkmcnt(0)" ::: "memory");
#pragma unroll
                for (int i = 0; i < 8; ++i) *(LAS u32x4*)(st + i * (8 * 144) + wro) = gb[i];
                if (kk + 64 < kw) SG_GLOAD_B(kk + 64);
#pragma unroll
                for (int ks = 0; ks < 2; ++ks)
#pragma unroll
                    for (int fb = 0; fb < 4; ++fb) b[ks][fb] = *(const LAS bf16x8*)(st + fb * (16 * 144) + fro + ks * 64);
                asm volatile("s_waitcnt lgkmcnt(0)" ::: "memory");
#pragma unroll
                for (int ks = 0; ks < 2; ++ks)
#pragma unroll
                    for (int fa = 0; fa < 4; ++fa)
#pragma unroll
                        for (int fb = 0; fb < 4; ++fb) acc[fa][fb] = __builtin_amdgcn_mfma_f32_16x16x32_bf16(b[ks][fb], a[ks][fa], acc[fa][fb], 0, 0, 0);
            }
#undef SG_GLOAD_A
#undef SG_GLOAD_B
        }
        __syncthreads();
        LAS float* part = (LAS float*)lds + wave * (64 * SG_LD);
#pragma unroll
        for (int fa = 0; fa < 4; ++fa)
#pragma unroll
            for (int fb = 0; fb < 4; ++fb) *(LAS f32x4*)(part + (16 * fa + r) * SG_LD + 16 * fb + 4 * q) = acc[fa][fb];
        __syncthreads();
        if (RT == 1) {
            const int row = tid >> 3, s4 = (tid & 7) * 4;
            f32x4 va = (f32x4){0.f, 0.f, 0.f, 0.f}, vb = va;
#pragma unroll
            for (int w = 0; w < 8; ++w) { const LAS float* p = (const LAS float*)lds + w * (64 * SG_LD) + row * SG_LD + s4; va += *(const LAS f32x4*)p; vb += *(const LAS f32x4*)(p + 32); }
            E.small(rowbase + row, cg, s4, va, vb);
        } else {
            const int row = tid >> 2, rr = row & 63, hh = row >> 6;
#pragma unroll
            for (int j = 0; j < 2; ++j) {
                const int s4 = (tid & 3) * 4 + 16 * j;
                f32x4 va = (f32x4){0.f, 0.f, 0.f, 0.f}, vb = va;
#pragma unroll
                for (int w = 0; w < 4; ++w) { const LAS float* p = (const LAS float*)lds + (hh * 4 + w) * (64 * SG_LD) + rr * SG_LD + s4; va += *(const LAS f32x4*)p; vb += *(const LAS f32x4*)(p + 32); }
                E.small(rowbase + row, cg, s4, va, vb);
            }
        }
        __syncthreads();
    }
}

__device__ __forceinline__ void small_gemm32(LAS unsigned char* lds, const bf16* A, const bf16* Bt, int K, const EpiRes& E) {
    const int tid = ltid(), lane = tid & 63, wave = __builtin_amdgcn_readfirstlane(tid >> 6), r = lane & 15, q = lane >> 4;
    const int kw = K >> 3;
    for (int it = blockIdx.x; it < 256; it += gridDim.x) {
        const int rt = it >> 5, cg = it & 31;
        const int rowbase = MP + 64 * rt;
        f32x4 acc[4][2];
#pragma unroll
        for (int i = 0; i < 4; ++i) { acc[i][0] = (f32x4){0.f, 0.f, 0.f, 0.f}; acc[i][1] = (f32x4){0.f, 0.f, 0.f, 0.f}; }
        {
            LAS unsigned char* st = lds + wave * 9216;
            const int lrow = lane >> 3, lch = lane & 7;
            const bf16* ag = A + (size_t)(rowbase + lrow) * K + wave * kw + lch * 8;
            const bf16* bg = Bt + (size_t)(32 * cg + lrow) * K + wave * kw + lch * 8;
            const int wro = lrow * 144 + lch * 16, fro = r * 144 + q * 16;
            u32x4 ga0[8], gb0[4], ga1[8], gb1[4];
#define SG_GLOAD(ga, gb, kk) do { _Pragma("unroll") for (int i = 0; i < 8; ++i) ga[i] = *(const u32x4*)(ag + (size_t)(8 * i) * K + (kk)); \
            _Pragma("unroll") for (int i = 0; i < 4; ++i) gb[i] = *(const u32x4*)(bg + (size_t)(8 * i) * K + (kk)); } while (0)
#define SG_STEP(ga, gb, knext) do { bf16x8 a[2][4], b[2][2]; \
            _Pragma("unroll") for (int i = 0; i < 8; ++i) *(LAS u32x4*)(st + i * (8 * 144) + wro) = ga[i]; \
            _Pragma("unroll") for (int ks = 0; ks < 2; ++ks) _Pragma("unroll") for (int fa = 0; fa < 4; ++fa) a[ks][fa] = *(const LAS bf16x8*)(st + fa * (16 * 144) + fro + ks * 64); \
            asm volatile("s_waitcnt lgkmcnt(0)" ::: "memory"); \
            _Pragma("unroll") for (int i = 0; i < 4; ++i) *(LAS u32x4*)(st + i * (8 * 144) + wro) = gb[i]; \
            _Pragma("unroll") for (int ks = 0; ks < 2; ++ks) _Pragma("unroll") for (int fb = 0; fb < 2; ++fb) b[ks][fb] = *(const LAS bf16x8*)(st + fb * (16 * 144) + fro + ks * 64); \
            asm volatile("s_waitcnt lgkmcnt(0)" ::: "memory"); \
            if ((knext) < kw) SG_GLOAD(ga, gb, (knext)); \
            _Pragma("unroll") for (int ks = 0; ks < 2; ++ks) _Pragma("unroll") for (int fa = 0; fa < 4; ++fa) _Pragma("unroll") for (int fb = 0; fb < 2; ++fb) \
                acc[fa][fb] = __builtin_amdgcn_mfma_f32_16x16x32_bf16(b[ks][fb], a[ks][fa], acc[fa][fb], 0, 0, 0); } while (0)
            SG_GLOAD(ga0, gb0, 0); SG_GLOAD(ga1, gb1, 64);
#pragma unroll 1
            for (int kk = 0; kk < kw; kk += 128) {
                SG_STEP(ga0, gb0, kk + 128);
                SG_STEP(ga1, gb1, kk + 192);
            }
#undef SG_GLOAD
#undef SG_STEP
        }
        __syncthreads();
        LAS float* part = (LAS float*)lds + wave * (64 * 36);
#pragma unroll
        for (int fa = 0; fa < 4; ++fa)
#pragma unroll
            for (int fb = 0; fb < 2; ++fb) *(LAS f32x4*)(part + (16 * fa + r) * 36 + 16 * fb + 4 * q) = acc[fa][fb];
        __syncthreads();
        const int row = tid >> 3, s4 = (tid & 7) * 4;
        f32x4 va = (f32x4){0.f, 0.f, 0.f, 0.f};
#pragma unroll
        for (int w = 0; w < 8; ++w) va += *(const LAS f32x4*)((const LAS float*)lds + w * (64 * 36) + row * 36 + s4);
        {
            const int grow = rowbase + row;
            bf16* p = E.xs + (size_t)grow * D + 32 * cg + s4;
            const u32x2 r0 = *(const u32x2*)p;
            const float x0 = bflo(r0.x) + va[0], x1 = bfhi(r0.x) + va[1], x2 = bflo(r0.y) + va[2], x3 = bfhi(r0.y) + va[3];
            float ss = (x0 * x0 + x1 * x1) + (x2 * x2 + x3 * x3);
            u32x2 w0; w0.x = pk_bf16(x0, x1); w0.y = pk_bf16(x2, x3);
            *(u32x2*)p = w0;
            ss += __shfl_xor(ss, 1); ss += __shfl_xor(ss, 2); ss += __shfl_xor(ss, 4);
            if ((tid & 7) == 0) unsafeAtomicAdd(E.ssq + grow, ss);
        }
        __syncthreads();
    }
}

__device__ __forceinline__ int win_dest_row(int s) {
    if (s < 512) return ((s >> 7) << 8) + (s & 127);
    if (s < 1024) { const int t = s - 512; return ((t >> 7) << 8) + 128 + (t & 127); }
    if (s < 2048) { const int t = s - 1024; const int which = t >> 9, hd = (t >> 7) & 3, d = t & 127; return 1024 + which * 512 + (hd >> 1) * 256 + (d >> 6) * 128 + (hd & 1) * 64 + (d & 63); }
    return s;
}
__device__ __forceinline__ void p0_transpose_item(const float* W, const float* gk, int K, int N, bf16* WT, bool perm, LAS float* scr, int item, int lane) {
    const int nblk = N / 32, kb = item / nblk, nb = item % nblk, k0 = 64 * kb, n0 = 32 * nb;
#pragma unroll
    for (int i = 0; i < 32; ++i) { const int kk = 2 * i + (lane >> 5); const float gg = gk ? gk[k0 + kk] : 1.0f; scr[kk * 33 + (lane & 31)] = gg * __builtin_nontemporal_load(W + (size_t)(k0 + kk) * N + n0 + (lane & 31)); }
    asm volatile("s_waitcnt lgkmcnt(0)" ::: "memory");
    const int c = lane & 7;
    const int drow0 = perm ? win_dest_row(n0) : n0;
#pragma unroll
    for (int j = 0; j < 4; ++j) { const int n = (lane >> 3) + 8 * j; const LAS float* s = scr + (8 * c) * 33 + n;
        u32x4 o; o.x = pk_bf16(s[0 * 33], s[1 * 33]); o.y = pk_bf16(s[2 * 33], s[3 * 33]); o.z = pk_bf16(s[4 * 33], s[5 * 33]); o.w = pk_bf16(s[6 * 33], s[7 * 33]);
        *(u32x4*)(WT + (size_t)(drow0 + n) * K + k0 + 8 * c) = o; }
    asm volatile("s_waitcnt lgkmcnt(0)" ::: "memory");
}
__device__ __forceinline__ void sincos_acc(float ang, float& c, float& s) {
    const double a = (double)ang;
    const double kd = __builtin_rint(a * 0.63661977236758134308);
    double r = __builtin_fma(-kd, 1.57079632679489655800, a);
    r = __builtin_fma(-kd, 6.12323399573676603587e-17, r);
    const int n = ((int)kd) & 3;
    const double r2 = r * r;
    double sp = -1.0 / 1307674368000.0;
    sp = sp * r2 + 1.0 / 6227020800.0; sp = sp * r2 - 1.0 / 39916800.0; sp = sp * r2 + 1.0 / 362880.0; sp = sp * r2 - 1.0 / 5040.0; sp = sp * r2 + 1.0 / 120.0; sp = sp * r2 - 1.0 / 6.0; sp = sp * r2 + 1.0;
    const double sn = r * sp;
    double cp = 1.0 / 20922789888000.0;
    cp = cp * r2 - 1.0 / 87178291200.0; cp = cp * r2 + 1.0 / 479001600.0; cp = cp * r2 - 1.0 / 3628800.0; cp = cp * r2 + 1.0 / 40320.0; cp = cp * r2 - 1.0 / 720.0; cp = cp * r2 + 1.0 / 24.0; cp = cp * r2 - 0.5; cp = cp * r2 + 1.0;
    const double cs = cp;
    double so, co;
    if (n == 0) { so = sn; co = cs; } else if (n == 1) { so = cs; co = -sn; } else if (n == 2) { so = -sn; co = -cs; } else { so = -cs; co = sn; }
    c = (float)co; s = (float)so;
}

__device__ __forceinline__ void p0_prologue(const Args& a, LAS unsigned char* lds, int wave, int lane) {
    unsigned char* ws = a.ws;
    const int G = gridDim.x, gw = blockIdx.x * NWAVES + wave, NGW = G * NWAVES;
    const int gt = blockIdx.x * NTHREADS + threadIdx.x, NGT = G * NTHREADS;
    float* ssq = (float*)(ws + WS_SSQ);
    for (int i = gt; i < 4 * M; i += NGT) ssq[M + i] = 0.f;
    f32x2* rope = (f32x2*)(ws + WS_ROPE);
    for (int i = gt; i < NPOS * 64; i += NGT) {
        const int p = i >> 6, dd = i & 63;
        const float pos = p < SEQ ? (float)p : (float)(16384 + (p - SEQ));
        const float ang = pos * ROPE_INV[dd];
        float c, s; sincos_acc(ang, c, s);
        rope[i] = (f32x2){c, s};
    }
    LAS float* scr = (LAS float*)(lds + wave * 16384);
    constexpr int I_IN = (D / 64) * (NIN / 32), I_O = (D / 64) * (D / 32), I_UP = (D / 64) * (FF / 32), I_DN = (FF / 64) * (D / 32), I_L = I_IN + I_O + I_UP + I_DN;
    for (int it = gw; it < 2 * I_L; it += NGW) {
        const int l = it / I_L; int r = it % I_L;
        unsigned char* wl = ws + WS_W + (size_t)l * W_LAYER;
        if (r < I_IN) { p0_transpose_item(a.in[5] + (size_t)l * D * NIN, a.in[4] + l * D, D, NIN, (bf16*)(wl + W_IN), true, scr, r, lane); continue; } r -= I_IN;
        if (r < I_O) { p0_transpose_item(a.in[11] + (size_t)l * D * D, nullptr, D, D, (bf16*)(wl + W_OUT), false, scr, r, lane); continue; } r -= I_O;
        if (r < I_UP) { p0_transpose_item(a.in[13] + (size_t)l * D * FF, a.in[12] + l * D, D, FF, (bf16*)(wl + W_UP), false, scr, r, lane); continue; } r -= I_UP;
        p0_transpose_item(a.in[14] + (size_t)l * FF * D, nullptr, FF, D, (bf16*)(wl + W_DN), false, scr, r, lane);
    }
    bf16* XN = (bf16*)(ws + WS_XN);
    for (int m = gw; m < M; m += 2 * NGW) {
        const int m2 = m + NGW; const bool has2 = m2 < M; const int mb = has2 ? m2 : m;
        const float* xa = m < MP ? a.in[0] + (size_t)m * D : a.in[1] + (size_t)(m - MP) * D;
        const float* xb = mb < MP ? a.in[0] + (size_t)mb * D : a.in[1] + (size_t)(mb - MP) * D;
        f32x4 va[4], vb[4];
#pragma unroll
        for (int j = 0; j < 4; ++j) { va[j] = __builtin_nontemporal_load((const f32x4*)(xa + 4 * lane + 256 * j)); vb[j] = __builtin_nontemporal_load((const f32x4*)(xb + 4 * lane + 256 * j)); }
        float sa = 0.f, sb = 0.f;
#pragma unroll
        for (int j = 0; j < 4; ++j) {
            sa += (va[j][0] * va[j][0] + va[j][1] * va[j][1]) + (va[j][2] * va[j][2] + va[j][3] * va[j][3]);
            sb += (vb[j][0] * vb[j][0] + vb[j][1] * vb[j][1]) + (vb[j][2] * vb[j][2] + vb[j][3] * vb[j][3]);
            u32x2 w; w.x = pk_bf16(va[j][0], va[j][1]); w.y = pk_bf16(va[j][2], va[j][3]);
            *(u32x2*)(XN + (size_t)m * D + 4 * lane + 256 * j) = w;
            if (has2) { u32x2 w2; w2.x = pk_bf16(vb[j][0], vb[j][1]); w2.y = pk_bf16(vb[j][2], vb[j][3]); *(u32x2*)(XN + (size_t)mb * D + 4 * lane + 256 * j) = w2; }
        }
        sa = wave_sum(sa); sb = wave_sum(sb);
        if (lane == 0) { ssq[m] = sa; if (has2) ssq[mb] = sb; }
    }
}

template <int NT, bool SAMPLE>
__device__ __forceinline__ void conv_item(LAS unsigned char* lds, int b, int tt, const bf16* glu, const float* cache, const float* cw, const float* cb, const float* lng, const float* lnb,
                                          bf16* mix, float* out_conv, int wave, int lane) {
    const int c = ltid(); lane = c & 63; wave = __builtin_amdgcn_readfirstlane(c >> 6);
    constexpr int NI = NT + 30;
    float in[NI];
    const int t0 = tt * NT;
    if (SAMPLE) {
#pragma unroll
        for (int j = 0; j < 30; ++j) in[j] = __builtin_nontemporal_load(cache + ((size_t)b * 30 + j) * 512 + c);
#pragma unroll
        for (int j = 0; j < NT; ++j) in[30 + j] = bf2f(glu[((size_t)MP + 4 * b + j) * 512 + c]);
    } else {
#pragma unroll
        for (int j = 0; j < NI; ++j) { const int t = t0 - 30 + j; in[j] = t >= 0 ? bf2f(glu[((size_t)b * SEQ + t) * 512 + c]) : 0.f; }
    }
    float w[CW];
#pragma unroll
    for (int k = 0; k < CW; ++k) w[k] = cw[k * 512 + c];
    const float bias = cb[c];
    LAS float* co = (LAS float*)lds;
#pragma unroll
    for (int t = 0; t < NT; ++t) {
        float acc = bias;
#pragma unroll
        for (int k = 0; k < CW; ++k) acc += w[k] * in[t + k];
        co[t * 512 + c] = acc;
    }
    if (SAMPLE) {
#pragma unroll
        for (int jj = 0; jj < 30; ++jj) __builtin_nontemporal_store(in[jj + NT], out_conv + ((size_t)b * 30 + jj) * 512 + c);
    } else if (tt == SEQ / NT - 1) {
#pragma unroll
        for (int jj = 0; jj < 30; ++jj) __builtin_nontemporal_store(in[jj + NT], out_conv + ((size_t)b * 30 + jj) * 512 + c);
    }
    __syncthreads();
    for (int t = wave; t < NT; t += NWAVES) {
        const size_t row = SAMPLE ? (size_t)MP + 4 * b + t : (size_t)b * SEQ + t0 + t;
        f32x4 v0 = *(const LAS f32x4*)(co + t * 512 + lane * 8), v1 = *(const LAS f32x4*)(co + t * 512 + lane * 8 + 4);
        float s = (v0[0] + v0[1]) + (v0[2] + v0[3]) + (v1[0] + v1[1]) + (v1[2] + v1[3]);
        s = wave_sum(s);
        const float mean = s * (1.0f / 512.0f);
        v0 = v0 - mean; v1 = v1 - mean;
        float q = (v0[0] * v0[0] + v0[1] * v0[1]) + (v0[2] * v0[2] + v0[3] * v0[3]) + (v1[0] * v1[0] + v1[1] * v1[1]) + (v1[2] * v1[2] + v1[3] * v1[3]);
        q = wave_sum(q);
        const float rstd = rsqrtf(q * (1.0f / 512.0f) + EPS);
        const f32x4 g0 = *(const f32x4*)(lng + lane * 8), g1 = *(const f32x4*)(lng + lane * 8 + 4), b0 = *(const f32x4*)(lnb + lane * 8), b1 = *(const f32x4*)(lnb + lane * 8 + 4);
        f32x4 y0 = v0 * rstd * g0 + b0, y1 = v1 * rstd * g1 + b1;
#pragma unroll
        for (int e = 0; e < 4; ++e) { y0[e] = y0[e] * sigmoidf_(y0[e]); y1[e] = y1[e] * sigmoidf_(y1[e]); }
        u32x4 o; o.x = pk_bf16(y0[0], y0[1]); o.y = pk_bf16(y0[2], y0[3]); o.z = pk_bf16(y1[0], y1[1]); o.w = pk_bf16(y1[2], y1[3]);
        *(u32x4*)(mix + row * D + lane * 8) = o;
    }
    __syncthreads();
}

__device__ __forceinline__ void conv_pair(LAS unsigned char* lds, int pr, const bf16* glu, const float* cw, const float* cb, const float* lng, const float* lnb, bf16* mix, float* out_conv) {
    const int tid = ltid(), lane = tid & 63, half = __builtin_amdgcn_readfirstlane(tid >> 8), wl = __builtin_amdgcn_readfirstlane((tid >> 6) & 3), t = tid & 255;
    const int itc = pr * 2 + half, b = itc >> 6, tt = itc & 63, t0 = tt * 32;
    constexpr int NT = 32, NI = NT + 30;
    f32x2 in2[NI];
#pragma unroll
    for (int j = 0; j < NI; ++j) {
        const int tk = t0 - 30 + j;
        unsigned w = 0u;
        if (tk >= 0) w = *(const unsigned*)(glu + ((size_t)b * SEQ + tk) * 512 + 2 * t);
        in2[j] = (f32x2){bflo(w), bfhi(w)};
    }
    f32x2 w2[CW];
#pragma unroll
    for (int k = 0; k < CW; ++k) w2[k] = *(const f32x2*)(cw + k * 512 + 2 * t);
    const f32x2 bias2 = *(const f32x2*)(cb + 2 * t);
    LAS float* co = (LAS float*)(lds + half * 65536);
#pragma unroll
    for (int u = 0; u < NT; ++u) {
        f32x2 acc = bias2;
#pragma unroll
        for (int k = 0; k < CW; ++k) acc = w2[k] * in2[u + k] + acc;
        *(LAS f32x2*)(co + u * 512 + 2 * t) = acc;
    }
    if (tt == SEQ / NT - 1) {
#pragma unroll
        for (int jj = 0; jj < 30; ++jj) __builtin_nontemporal_store(in2[jj + NT], (f32x2*)(out_conv + ((size_t)b * 30 + jj) * 512 + 2 * t));
    }
    const f32x4 g0 = *(const f32x4*)(lng + lane * 8), g1 = *(const f32x4*)(lng + lane * 8 + 4), b0 = *(const f32x4*)(lnb + lane * 8), b1 = *(const f32x4*)(lnb + lane * 8 + 4);
    __syncthreads();
    for (int u = wl; u < NT; u += 4) {
        const size_t row = (size_t)b * SEQ + t0 + u;
        f32x4 v0 = *(const LAS f32x4*)(co + u * 512 + lane * 8), v1 = *(const LAS f32x4*)(co + u * 512 + lane * 8 + 4);
        float sm = (v0[0] + v0[1]) + (v0[2] + v0[3]) + (v1[0] + v1[1]) + (v1[2] + v1[3]);
        sm = wave_sum(sm);
        const float mean = sm * (1.0f / 512.0f);
        v0 = v0 - mean; v1 = v1 - mean;
        float qv = (v0[0] * v0[0] + v0[1] * v0[1]) + (v0[2] * v0[2] + v0[3] * v0[3]) + (v1[0] * v1[0] + v1[1] * v1[1]) + (v1[2] * v1[2] + v1[3] * v1[3]);
        qv = wave_sum(qv);
        const float rstd = rsqrtf(qv * (1.0f / 512.0f) + EPS);
        f32x4 y0 = v0 * rstd * g0 + b0, y1 = v1 * rstd * g1 + b1;
#pragma unroll
        for (int e = 0; e < 4; ++e) { y0[e] = y0[e] * sigmoidf_(y0[e]); y1[e] = y1[e] * sigmoidf_(y1[e]); }
        u32x4 o; o.x = pk_bf16(y0[0], y0[1]); o.y = pk_bf16(y0[2], y0[3]); o.z = pk_bf16(y1[0], y1[1]); o.w = pk_bf16(y1[2], y1[3]);
        *(u32x4*)(mix + row * D + lane * 8) = o;
    }
    __syncthreads();
}

constexpr int TS = 272;
__device__ __forceinline__ bf16x8 tr_frag(LAS unsigned char* tile, int rowA, int rowB, int col0, int lane) {
    const int i = lane & 15, qq = i >> 2, p = i & 3;
    const s16x4 lo = __builtin_amdgcn_ds_read_tr16_b64_v4i16((LAS s16x4*)(tile + (rowA + qq) * TS + (col0 + 4 * p) * 2));
    const s16x4 hi = __builtin_amdgcn_ds_read_tr16_b64_v4i16((LAS s16x4*)(tile + (rowB + qq) * TS + (col0 + 4 * p) * 2));
    bf16x8 r; r[0] = lo[0]; r[1] = lo[1]; r[2] = lo[2]; r[3] = lo[3]; r[4] = hi[0]; r[5] = hi[1]; r[6] = hi[2]; r[7] = hi[3];
    return r;
}
__device__ __forceinline__ u32x4 scale_bf16x8(u32x4 v, float s) {
    u32x4 o; o.x = pk_bf16(bflo(v.x) * s, bfhi(v.x) * s); o.y = pk_bf16(bflo(v.y) * s, bfhi(v.y) * s); o.z = pk_bf16(bflo(v.z) * s, bfhi(v.z) * s); o.w = pk_bf16(bflo(v.w) * s, bfhi(v.w) * s);
    return o;
}
__device__ __forceinline__ void kvloc_item(LAS unsigned char* lds, int b, int h, int c, const bf16* K, const bf16* V, float* kvbuf, float lg2, int wave, int lane) {
    LAS unsigned char* Kt = lds; LAS unsigned char* Vt = lds + 128 * TS;
    const int tid = ltid(); lane = tid & 63; wave = __builtin_amdgcn_readfirstlane(tid >> 6); const size_t r0 = (size_t)b * SEQ + c * 128;
#pragma unroll
    for (int i = 0; i < 4; ++i) {
        const int chunk = tid + 512 * i, j = chunk >> 4, cc = chunk & 15;
        u32x4 kv = *(const u32x4*)(K + (r0 + j) * 512 + h * 128 + cc * 8);
        const u32x4 vv = *(const u32x4*)(V + (r0 + j) * 512 + h * 128 + cc * 8);
        kv = scale_bf16x8(kv, exp2f(lg2 * (float)(127 - j)));
        *(LAS u32x4*)(Kt + j * TS + cc * 16) = kv; *(LAS u32x4*)(Vt + j * TS + cc * 16) = vv;
    }
    __syncthreads();
    const int r = lane & 15, q = lane >> 4;
    f32x4 acc[8];
#pragma unroll
    for (int vf = 0; vf < 8; ++vf) acc[vf] = (f32x4){0.f, 0.f, 0.f, 0.f};
#pragma unroll
    for (int ks = 0; ks < 4; ++ks) {
        const bf16x8 bfrag = tr_frag(Kt, 32 * ks + 8 * q, 32 * ks + 8 * q + 4, 16 * wave, lane);
#pragma unroll
        for (int vf = 0; vf < 8; ++vf) {
            const bf16x8 afrag = tr_frag(Vt, 32 * ks + 8 * q, 32 * ks + 8 * q + 4, 16 * vf, lane);
            acc[vf] = __builtin_amdgcn_mfma_f32_16x16x32_bf16(afrag, bfrag, acc[vf], 0, 0, 0);
        }
    }
    float* dst = kvbuf + ((size_t)((b * NH + h) * 16 + c)) * 16384 + (size_t)(16 * wave + r) * 128 + 4 * q;
#pragma unroll
    for (int vf = 0; vf < 8; ++vf) *(f32x4*)(dst + 16 * vf) = acc[vf];
    __syncthreads();
}

__device__ __forceinline__ void kvloc_pair(LAS unsigned char* lds, int pr, const bf16* K, const bf16* V, bf16* kvbuf) {
    const int tid = ltid(), lane = tid & 63, half = __builtin_amdgcn_readfirstlane(tid >> 8), wl = __builtin_amdgcn_readfirstlane((tid >> 6) & 3), t = tid & 255;
    const int k = pr * 2 + half, b = k >> 6, h = (k >> 4) & 3, c = k & 15;
    const float lg2 = __log2f(1.0f - exp2f(-5.0f - (float)h));
    LAS unsigned char* Kt = lds + half * (256 * TS); LAS unsigned char* Vt = Kt + 128 * TS;
    const size_t r0 = (size_t)b * SEQ + c * 128;
#pragma unroll
    for (int i = 0; i < 8; ++i) {
        const int chunk = t + 256 * i, j = chunk >> 4, cc = chunk & 15;
        u32x4 kv = *(const u32x4*)(K + (r0 + j) * 512 + h * 128 + cc * 8);
        const u32x4 vv = *(const u32x4*)(V + (r0 + j) * 512 + h * 128 + cc * 8);
        kv = scale_bf16x8(kv, exp2f(lg2 * (float)(127 - j)));
        *(LAS u32x4*)(Kt + j * TS + cc * 16) = kv; *(LAS u32x4*)(Vt + j * TS + cc * 16) = vv;
    }
    __syncthreads();
    const int r = lane & 15, q = lane >> 4;
    f32x4 acc[2][8];
#pragma unroll
    for (int u = 0; u < 2; ++u)
#pragma unroll
        for (int vf = 0; vf < 8; ++vf) acc[u][vf] = (f32x4){0.f, 0.f, 0.f, 0.f};
#pragma unroll
    for (int ks = 0; ks < 4; ++ks) {
        const bf16x8 b0 = tr_frag(Kt, 32 * ks + 8 * q, 32 * ks + 8 * q + 4, 32 * wl, lane);
        const bf16x8 b1 = tr_frag(Kt, 32 * ks + 8 * q, 32 * ks + 8 * q + 4, 32 * wl + 16, lane);
#pragma unroll
        for (int vf = 0; vf < 8; ++vf) {
            const bf16x8 afrag = tr_frag(Vt, 32 * ks + 8 * q, 32 * ks + 8 * q + 4, 16 * vf, lane);
            acc[0][vf] = __builtin_amdgcn_mfma_f32_16x16x32_bf16(afrag, b0, acc[0][vf], 0, 0, 0);
            acc[1][vf] = __builtin_amdgcn_mfma_f32_16x16x32_bf16(afrag, b1, acc[1][vf], 0, 0, 0);
        }
    }
    bf16* dst = kvbuf + ((size_t)((b * NH + h) * 16 + c)) * 16384 + (size_t)(32 * wl + r) * 128 + 4 * q;
#pragma unroll
    for (int u = 0; u < 2; ++u)
#pragma unroll
        for (int vf = 0; vf < 8; ++vf) { u32x2 w; w.x = pk_bf16(acc[u][vf][0], acc[u][vf][1]); w.y = pk_bf16(acc[u][vf][2], acc[u][vf][3]); *(u32x2*)(dst + (size_t)u * 16 * 128 + 16 * vf) = w; }
    __syncthreads();
}

__device__ __forceinline__ void retout_item(LAS unsigned char* lds, int b, int h, int c, const bf16* Q, const bf16* K, const bf16* V, const bf16* GATE, const bf16* sb, bf16* mix,
                                            float lg2, int wave, int lane) {
    LAS unsigned char* Kt = lds; LAS unsigned char* Vt = lds + 128 * TS; LAS unsigned char* St = lds + 256 * TS;
    const int tid = ltid(); lane = tid & 63; wave = __builtin_amdgcn_readfirstlane(tid >> 6); const size_t r0 = (size_t)b * SEQ + c * 128;
    {
        u32x4 kv[4], vv[4], sv[4];
        const bf16* sp = sb + ((size_t)((b * NH + h) * 16 + (c > 0 ? c : 1))) * 16384;
#pragma unroll
        for (int i = 0; i < 4; ++i) {
            const int chunk = tid + 512 * i, j = chunk >> 4, cc = chunk & 15;
            kv[i] = *(const u32x4*)(K + (r0 + j) * 512 + h * 128 + cc * 8);
            vv[i] = *(const u32x4*)(V + (r0 + j) * 512 + h * 128 + cc * 8);
            sv[i] = *(const u32x4*)(sp + j * 128 + cc * 8);
        }
#pragma unroll
        for (int i = 0; i < 4; ++i) {
            const int chunk = tid + 512 * i, j = chunk >> 4, cc = chunk & 15;
            *(LAS u32x4*)(Kt + j * TS + cc * 16) = kv[i]; *(LAS u32x4*)(Vt + j * TS + cc * 16) = vv[i]; *(LAS u32x4*)(St + j * TS + cc * 16) = sv[i];
        }
    }
    __syncthreads();
    const int r = lane & 15, q = lane >> 4;
    const size_t rowi = r0 + 16 * wave + r;
    bf16x8 qf[4];
#pragma unroll
    for (int ks = 0; ks < 4; ++ks) qf[ks] = *(const bf16x8*)(Q + rowi * 512 + h * 128 + 32 * ks + 8 * q);
    f32x4 sc[8];
#pragma unroll
    for (int jf = 0; jf < 8; ++jf) {
        sc[jf] = (f32x4){0.f, 0.f, 0.f, 0.f};
        if (jf <= wave) {
#pragma unroll
            for (int ks = 0; ks < 4; ++ks) {
                const bf16x8 kf = *(const LAS bf16x8*)(Kt + (16 * jf + r) * TS + (32 * ks + 8 * q) * 2);
                sc[jf] = __builtin_amdgcn_mfma_f32_16x16x32_bf16(kf, qf[ks], sc[jf], 0, 0, 0);
            }
#pragma unroll
            for (int e = 0; e < 4; ++e) { const int dlt = (16 * wave + r) - (16 * jf + 4 * q + e); sc[jf][e] = dlt >= 0 ? sc[jf][e] * exp2f(lg2 * (float)dlt) : 0.f; }
        }
    }
    f32x4 ao[8], ac[8];
#pragma unroll
    for (int vf = 0; vf < 8; ++vf) { ao[vf] = (f32x4){0.f, 0.f, 0.f, 0.f}; ac[vf] = (f32x4){0.f, 0.f, 0.f, 0.f}; }
#pragma unroll
    for (int k2 = 0; k2 < 4; ++k2) {
        if (2 * k2 <= wave) {
            union { u32x4 u; bf16x8 v; } pf;
            pf.u.x = pk_bf16(sc[2 * k2][0], sc[2 * k2][1]); pf.u.y = pk_bf16(sc[2 * k2][2], sc[2 * k2][3]); pf.u.z = pk_bf16(sc[2 * k2 + 1][0], sc[2 * k2 + 1][1]); pf.u.w = pk_bf16(sc[2 * k2 + 1][2], sc[2 * k2 + 1][3]);
#pragma unroll
            for (int vf = 0; vf < 8; ++vf) {
                const bf16x8 af = tr_frag(Vt, 32 * k2 + 4 * q, 32 * k2 + 16 + 4 * q, 16 * vf, lane);
                ao[vf] = __builtin_amdgcn_mfma_f32_16x16x32_bf16(af, pf.v, ao[vf], 0, 0, 0);
            }
        }
    }
    if (c > 0) {
#pragma unroll
        for (int ks = 0; ks < 4; ++ks) {
#pragma unroll
            for (int vf = 0; vf < 8; ++vf) {
                const bf16x8 af = tr_frag(St, 32 * ks + 8 * q, 32 * ks + 8 * q + 4, 16 * vf, lane);
                ac[vf] = __builtin_amdgcn_mfma_f32_16x16x32_bf16(af, qf[ks], ac[vf], 0, 0, 0);
            }
        }
    }
    const float gi = exp2f(lg2 * (float)(16 * wave + r + 1));
    float s = 0.f;
#pragma unroll
    for (int vf = 0; vf < 8; ++vf) { ao[vf] = ao[vf] + ac[vf] * gi; s += (ao[vf][0] + ao[vf][1]) + (ao[vf][2] + ao[vf][3]); }
    s += __shfl_xor(s, 16); s += __shfl_xor(s, 32);
    const float mean = s * (1.0f / 128.0f);
    float qv = 0.f;
#pragma unroll
    for (int vf = 0; vf < 8; ++vf) { ao[vf] = ao[vf] - mean; qv += (ao[vf][0] * ao[vf][0] + ao[vf][1] * ao[vf][1]) + (ao[vf][2] * ao[vf][2] + ao[vf][3] * ao[vf][3]); }
    qv += __shfl_xor(qv, 16); qv += __shfl_xor(qv, 32);
    const float rstd = rsqrtf(qv * (1.0f / 128.0f) + EPS);
#pragma unroll
    for (int vf = 0; vf < 8; ++vf) {
        const u32x2 gw = *(const u32x2*)(GATE + rowi * 512 + h * 128 + 16 * vf + 4 * q);
        u32x2 o; o.x = pk_bf16(ao[vf][0] * rstd * bflo(gw.x), ao[vf][1] * rstd * bfhi(gw.x)); o.y = pk_bf16(ao[vf][2] * rstd * bflo(gw.y), ao[vf][3] * rstd * bfhi(gw.y));
        *(u32x2*)(mix + rowi * D + 512 + h * 128 + 16 * vf + 4 * q) = o;
    }
    __syncthreads();
}

__device__ __forceinline__ void scan_phase(const bf16* kvbuf, bf16* sb, float* out_state) {
    const int tid = ltid();
    for (int idx = blockIdx.x * NTHREADS + tid; idx < 32 * 4096; idx += gridDim.x * NTHREADS) {
        const int bh = idx >> 12, e4 = idx & 4095, h = bh & 3;
        const float g128 = exp2f(128.0f * __log2f(1.0f - exp2f(-5.0f - (float)h)));
        const bf16* base = kvbuf + (size_t)bh * 16 * 16384 + e4 * 4;
        u32x2 kvr[16];
#pragma unroll
        for (int c = 0; c < 16; ++c) kvr[c] = *(const u32x2*)(base + (size_t)c * 16384);
        f32x4 s = (f32x4){0.f, 0.f, 0.f, 0.f};
#pragma unroll
        for (int c = 0; c < 16; ++c) {
            if (c > 0) { u32x2 w; w.x = pk_bf16(s[0], s[1]); w.y = pk_bf16(s[2], s[3]); *(u32x2*)(sb + ((size_t)(bh * 16 + c)) * 16384 + e4 * 4) = w; }
            s = s * g128 + (f32x4){bflo(kvr[c].x), bfhi(kvr[c].x), bflo(kvr[c].y), bfhi(kvr[c].y)};
        }
        __builtin_nontemporal_store(s, (f32x4*)(out_state + (size_t)bh * 16384 + e4 * 4));
    }
}

__device__ __forceinline__ void ret_sample_item(LAS unsigned char* lds, int b, int h, const bf16* Q, const bf16* K, const bf16* V, const bf16* GATE, const float* state_in, float* out_state,
                                                bf16* mix, float lg2, int wave, int lane) {
    LAS float* qs = (LAS float*)lds; LAS float* ks = qs + 512; LAS float* vs = ks + 512; LAS float* scs = vs + 512;
    LAS float* red = (LAS float*)(lds + 8192); LAS float* wsum = (LAS float*)(lds + 8192 + 32768);
    const int tid = ltid(); lane = tid & 63; wave = __builtin_amdgcn_readfirstlane(tid >> 6); const size_t row0 = (size_t)MP + 4 * b;
    { const int i = tid >> 7, d = tid & 127; const size_t o = (row0 + i) * 512 + h * 128 + d; qs[tid] = bf2f(Q[o]); ks[tid] = bf2f(K[o]); vs[tid] = bf2f(V[o]); }
    __syncthreads();
    { const int i = wave >> 1;
#pragma unroll
      for (int jj = 0; jj < 2; ++jj) { const int j = (wave & 1) * 2 + jj; float p = qs[i * 128 + lane] * ks[j * 128 + lane] + qs[i * 128 + 64 + lane] * ks[j * 128 + 64 + lane]; p = wave_sum(p);
          if (lane == 0) scs[i * 4 + j] = (j <= i) ? p * exp2f(lg2 * (float)(i - j)) : 0.f; } }
    const int v4 = (tid & 31) * 4, dg = tid >> 5;
    const float g4 = exp2f(lg2 * 4.0f), gk0 = exp2f(lg2 * 3.0f), gk1 = exp2f(lg2 * 2.0f), gk2 = exp2f(lg2), gk3 = 1.0f;
    const float* sin_ = state_in + ((size_t)(b * NH + h) * 128) * 128; float* sout = out_state + ((size_t)(b * NH + h) * 128) * 128;
    const f32x4 vv0 = *(const LAS f32x4*)(vs + v4), vv1 = *(const LAS f32x4*)(vs + 128 + v4), vv2 = *(const LAS f32x4*)(vs + 256 + v4), vv3 = *(const LAS f32x4*)(vs + 384 + v4);
    f32x4 p0 = (f32x4){0.f, 0.f, 0.f, 0.f}, p1 = p0, p2 = p0, p3 = p0;
#pragma unroll
    for (int dd = 0; dd < 8; ++dd) {
        const int d = dg * 8 + dd;
        const f32x4 s4 = *(const f32x4*)(sin_ + (size_t)d * 128 + v4);
        p0 += s4 * qs[d]; p1 += s4 * qs[128 + d]; p2 += s4 * qs[256 + d]; p3 += s4 * qs[384 + d];
        f32x4 ns = s4 * g4 + vv0 * (gk0 * ks[d]) + vv1 * (gk1 * ks[128 + d]) + vv2 * (gk2 * ks[256 + d]) + vv3 * (gk3 * ks[384 + d]);
        *(f32x4*)(sout + (size_t)d * 128 + v4) = ns;
    }
    *(LAS f32x4*)(red + (dg * 4 + 0) * 128 + v4) = p0; *(LAS f32x4*)(red + (dg * 4 + 1) * 128 + v4) = p1; *(LAS f32x4*)(red + (dg * 4 + 2) * 128 + v4) = p2; *(LAS f32x4*)(red + (dg * 4 + 3) * 128 + v4) = p3;
    __syncthreads();
    const int i = tid >> 7, v = tid & 127;
    float cross = 0.f;
#pragma unroll
    for (int g = 0; g < 16; ++g) cross += red[(g * 4 + i) * 128 + v];
    float o = exp2f(lg2 * (float)(i + 1)) * cross;
#pragma unroll
    for (int j = 0; j < 4; ++j) o += scs[i * 4 + j] * vs[j * 128 + v];
    float s = wave_sum(o);
    if (lane == 0) wsum[wave] = s;
    __syncthreads();
    const float mean = (wsum[2 * i] + wsum[2 * i + 1]) * (1.0f / 128.0f);
    const float dv = o - mean;
    float qv = wave_sum(dv * dv);
    if (lane == 0) wsum[8 + wave] = qv;
    __syncthreads();
    const float rstd = rsqrtf((wsum[8 + 2 * i] + wsum[8 + 2 * i + 1]) * (1.0f / 128.0f) + EPS);
    const float gt = bf2f(GATE[(row0 + i) * 512 + h * 128 + v]);
    const unsigned pk = pk_bf16(dv * rstd * gt, 0.f);
    mix[(row0 + i) * D + 512 + h * 128 + v] = (bf16)(pk & 0xffffu);
    __syncthreads();
}

__device__ __forceinline__ void ret_sample_pair(LAS unsigned char* lds, int pair, const bf16* Q, const bf16* K, const bf16* V, const bf16* GATE, const float* state_in, float* out_state, bf16* mix) {
    const int tid = ltid(), half = __builtin_amdgcn_readfirstlane(tid >> 8), t = tid & 255, lane = tid & 63, wl = __builtin_amdgcn_readfirstlane((tid >> 6) & 3);
    const int item = pair * 2 + half, b = item >> 2, h = item & 3;
    const float lg2 = __log2f(1.0f - exp2f(-5.0f - (float)h));
    LAS float* base = (LAS float*)(lds + half * 32768);
    LAS float* qs = base; LAS float* ks = base + 512; LAS float* vs = base + 1024; LAS float* red = base + 2048;
    const size_t row0 = (size_t)MP + 4 * b;
    unsigned short rq[2], rk[2], rv[2];
#pragma unroll
    for (int u = 0; u < 2; ++u) { const int e = t + 256 * u, i = e >> 7, d = e & 127; const size_t o = (row0 + i) * 512 + h * 128 + d; rq[u] = Q[o]; rk[u] = K[o]; rv[u] = V[o]; }
    asm volatile("" : "+v"(rq[0]), "+v"(rq[1]), "+v"(rk[0]), "+v"(rk[1]), "+v"(rv[0]), "+v"(rv[1]));
#pragma unroll
    for (int u = 0; u < 2; ++u) { const int e = t + 256 * u; qs[e] = bf2f(rq[u]); ks[e] = bf2f(rk[u]); vs[e] = bf2f(rv[u]); }
    const float gt0 = bf2f(GATE[(row0 + wl) * 512 + h * 128 + lane]), gt1 = bf2f(GATE[(row0 + wl) * 512 + h * 128 + 64 + lane]);
    __syncthreads();
    {
        const int v4 = (t & 31) * 4, dg = t >> 5;
        const float g4 = exp2f(lg2 * 4.0f), gk0 = exp2f(lg2 * 3.0f), gk1 = exp2f(lg2 * 2.0f), gk2 = exp2f(lg2);
        const float* sin_ = state_in + ((size_t)(b * NH + h) * 128) * 128; float* sout = out_state + ((size_t)(b * NH + h) * 128) * 128;
        const f32x4 vv0 = *(const LAS f32x4*)(vs + v4), vv1 = *(const LAS f32x4*)(vs + 128 + v4), vv2 = *(const LAS f32x4*)(vs + 256 + v4), vv3 = *(const LAS f32x4*)(vs + 384 + v4);
        f32x4 p0 = (f32x4){0.f, 0.f, 0.f, 0.f}, p1 = p0, p2 = p0, p3 = p0;
        f32x4 s4[16];
#pragma unroll
        for (int dd = 0; dd < 16; ++dd) s4[dd] = __builtin_nontemporal_load((const f32x4*)(sin_ + (size_t)(dg * 16 + dd) * 128 + v4));
#pragma unroll
        for (int dd = 0; dd < 16; ++dd) {
            const int d = dg * 16 + dd;
            p0 += s4[dd] * qs[d]; p1 += s4[dd] * qs[128 + d]; p2 += s4[dd] * qs[256 + d]; p3 += s4[dd] * qs[384 + d];
            const f32x4 ns = s4[dd] * g4 + vv0 * (gk0 * ks[d]) + vv1 * (gk1 * ks[128 + d]) + vv2 * (gk2 * ks[256 + d]) + vv3 * ks[384 + d];
            __builtin_nontemporal_store(ns, (f32x4*)(sout + (size_t)d * 128 + v4));
        }
        *(LAS f32x4*)(red + (dg * 4 + 0) * 128 + v4) = p0; *(LAS f32x4*)(red + (dg * 4 + 1) * 128 + v4) = p1; *(LAS f32x4*)(red + (dg * 4 + 2) * 128 + v4) = p2; *(LAS f32x4*)(red + (dg * 4 + 3) * 128 + v4) = p3;
    }
    __syncthreads();
    {
        const int i = wl;
        float o0 = 0.f, o1 = 0.f;
#pragma unroll
        for (int g = 0; g < 8; ++g) { o0 += red[(g * 4 + i) * 128 + lane]; o1 += red[(g * 4 + i) * 128 + 64 + lane]; }
        const float gi = exp2f(lg2 * (float)(i + 1));
        o0 *= gi; o1 *= gi;
#pragma unroll
        for (int j = 0; j < 4; ++j) {
            if (j <= i) {
                float p = qs[i * 128 + lane] * ks[j * 128 + lane] + qs[i * 128 + 64 + lane] * ks[j * 128 + 64 + lane];
                p = wave_sum(p) * exp2f(lg2 * (float)(i - j));
                o0 += p * vs[j * 128 + lane]; o1 += p * vs[j * 128 + 64 + lane];
            }
        }
        const float mean = wave_sum(o0 + o1) * (1.0f / 128.0f);
        const float d0 = o0 - mean, d1 = o1 - mean;
        const float rstd = rsqrtf(wave_sum(d0 * d0 + d1 * d1) * (1.0f / 128.0f) + EPS);
        const unsigned pk = pk_bf16(d0 * rstd * gt0, d1 * rstd * gt1);
        bf16* mo = mix + (row0 + i) * D + 512 + h * 128 + lane;
        mo[0] = (bf16)(pk & 0xffffu); mo[64] = (bf16)(pk >> 16);
    }
    __syncthreads();
}

#define XB_TMO      128
#define XB_XCNT(j)  (256  + 64 * (j))
#define XB_XSUB(j)  (1280 + 64 * (j))
#define XB_XGEN(j)  (2304 + 64 * (j))
#define XB_TOP      3328
#define XB_TOPGEN   3392
#define XCD_BAR_WORDS 3456
#define XB_SPIN_CAP (1u << 18)

__device__ __forceinline__ unsigned xb_ld(unsigned* p)              { return __hip_atomic_load(p, __ATOMIC_RELAXED, __HIP_MEMORY_SCOPE_AGENT); }
__device__ __forceinline__ unsigned xb_add(unsigned* p, unsigned v) { return __hip_atomic_fetch_add(p, v, __ATOMIC_RELAXED, __HIP_MEMORY_SCOPE_AGENT); }
__device__ __forceinline__ unsigned xb_xcc_id() { return (unsigned)__builtin_amdgcn_s_getreg((3 << 11) | 20) & 0xFu; }
#define XB_SPIN(cond, bar) do { unsigned _sp = 0; while (cond) { __builtin_amdgcn_s_sleep(1); \
    if ((++_sp & 255u) == 0u) { if (xb_ld(&(bar)[XB_TMO])) break; if (_sp > XB_SPIN_CAP) { atomicAdd(&(bar)[XB_TMO], 1u); break; } } } } while (0)

struct XcdBarrier {
    unsigned* bar; unsigned x;
    volatile LAS unsigned* st;
};

__device__ __forceinline__ XcdBarrier xcd_barrier_post(unsigned* bar, volatile LAS unsigned* st) {
    XcdBarrier b; b.bar = bar; b.x = xb_xcc_id(); b.st = st;
    if (threadIdx.x == 0) (void)xb_add(&bar[XB_XCNT(b.x)], 1u);
    return b;
}
__device__ __forceinline__ void xcd_barrier_complete(unsigned* bar, unsigned x, unsigned& nloc, unsigned& nx) {
    const unsigned G = gridDim.x * gridDim.y * gridDim.z;
    unsigned sum, cnt, mine, sp = 0u;
    for (;;) {
        sum = 0u; cnt = 0u; mine = 0u;
#pragma unroll
        for (unsigned j = 0; j < 16; ++j) { const unsigned c = xb_ld(&bar[XB_XCNT(j)]); sum += c; cnt += (c > 0u) ? 1u : 0u; mine = (j == x) ? c : mine; }
        if (sum == G) break;
        __builtin_amdgcn_s_sleep(1);
        if ((++sp & 255u) == 0u) { if (xb_ld(&bar[XB_TMO])) break; if (sp > XB_SPIN_CAP) { atomicAdd(&bar[XB_TMO], 1u); break; } }
    }
    nloc = mine > 0u ? mine : 1u; nx = cnt > 0u ? cnt : 1u;
}

__device__ __forceinline__ void xcd_barrier(const XcdBarrier& b) {
    asm volatile("s_waitcnt vmcnt(0)" ::: "memory");
    __syncthreads();
    if (threadIdx.x == 0) {
        unsigned* bar = b.bar;
        __builtin_amdgcn_s_waitcnt(0);
        unsigned nloc = b.st[0], nx = b.st[1];
        if (nloc == 0u) { xcd_barrier_complete(bar, b.x, nloc, nx); b.st[0] = nloc; b.st[1] = nx; }
        const unsigned old = xb_add(&bar[XB_XSUB(b.x)], 1u);
        const unsigned gen = old / nloc;
        if (old + 1u == (gen + 1u) * nloc) {
            __builtin_amdgcn_fence(__ATOMIC_RELEASE, "agent");
            asm volatile("s_waitcnt vmcnt(0)" ::: "memory");
            const unsigned og = xb_add(&bar[XB_TOP], 1u);
            const unsigned tg = og / nx;
            if (og + 1u == (tg + 1u) * nx) xb_add(&bar[XB_TOPGEN], 1u);
            else XB_SPIN(xb_ld(&bar[XB_TOPGEN]) == tg, bar);
            __builtin_amdgcn_fence(__ATOMIC_ACQUIRE, "agent");
            xb_add(&bar[XB_XGEN(b.x)], 1u);
            asm volatile("s_waitcnt vmcnt(0)" ::: "memory");
        } else {
            __builtin_amdgcn_fence(__ATOMIC_ACQUIRE, "agent");
            asm volatile("s_waitcnt vmcnt(0)" ::: "memory");
            XB_SPIN(xb_ld(&bar[XB_TOPGEN]) == gen, bar);
            asm volatile("" ::: "memory");
            asm volatile("s_waitcnt vmcnt(0)" ::: "memory");
        }
    }
    __syncthreads();
}

#define GRID_SYNC() do { XcdBarrier b_ = bar; unsigned* p_ = (unsigned*)(a.ws + WS_CTL) + 4096; asm volatile("" : "+s"(p_)); b_.bar = p_; unsigned x_ = bar.x; asm volatile("" : "+s"(x_)); b_.x = x_; xcd_barrier(b_); } while (0)

__global__ void __launch_bounds__(NTHREADS, 2) mega_fwd(Args a) {
    extern __shared__ __attribute__((aligned(16))) unsigned char lds_raw[];
    LAS unsigned char* lds = (LAS unsigned char*)lds_raw;
    cg::grid_group grid = cg::this_grid();
    const int tid = threadIdx.x, lane = tid & 63, wave = __builtin_amdgcn_readfirstlane(tid >> 6);
    const int G = gridDim.x, bid = blockIdx.x;
    unsigned char* ws = a.ws;
    float* ssq = (float*)(ws + WS_SSQ);
    const f32x2* rope = (const f32x2*)(ws + WS_ROPE);
    bf16* XN = (bf16*)(ws + WS_XN);
    bf16 *GLU = (bf16*)(ws + WS_GLU), *Qb = (bf16*)(ws + WS_Q), *Kb = (bf16*)(ws + WS_K), *Vb = (bf16*)(ws + WS_V), *GATE = (bf16*)(ws + WS_GATE), *MIX = (bf16*)(ws + WS_MIX), *Hb = (bf16*)(ws + WS_H);
    bf16* KVB = (bf16*)(ws + WS_KV);
    bf16* SB = (bf16*)(ws + WS_SB);
    float* XR = a.out + O_Y;
    volatile LAS unsigned* MISC = (volatile LAS unsigned*)(lds + LDS_BYTES - 256);
    if (tid < 64) MISC[tid] = 0u;
    __syncthreads();
    XcdBarrier bar = xcd_barrier_post((unsigned*)(ws + WS_CTL) + 4096, MISC + 8);

#ifndef SKIP_P0
    for (int rep = 0; rep < REP_P0; ++rep) p0_prologue(a, lds, wave, lane);
#endif
    if (a.ws == nullptr) grid.sync();
    GRID_SYNC();

    for (int l = 0; l < 2; ++l) {
        const unsigned char* wl = ws + WS_W + (size_t)l * W_LAYER;
        {
            pg8::Gemm g{XN, (const bf16*)(wl + W_IN), MP, NIN, D}; pg8::StaticOrder S; S.init(MP, NIN, G, bid);
            EpiIn E{ssq + (size_t)(2 * l) * M, GLU, Qb, Kb, Vb, GATE, rope, a.in[10] + l * 512};
#ifndef SKIP_IN
            for (int rep = 0; rep < REP_BIG; ++rep) pg8::gemm_phase<EpiIn, pg8::StaticOrder, true, true>(lds, g, S, E);
#endif
            for (int rep = 0; rep < REP_SMALL; ++rep) small_gemm<EpiIn, 2>(lds, XN, (const bf16*)(wl + W_IN), D, 48, E);
        }
        GRID_SYNC();
        {
            const float* cw = a.in[6] + (size_t)l * CW * 512; const float* cb = a.in[7] + l * 512; const float* lng = a.in[8] + l * 512; const float* lnb = a.in[9] + l * 512;
            const float* cache = a.in[2] + (size_t)l * 128 * 30 * 512;
            float* ocp = a.out + O_CP + (size_t)l * 8 * 30 * 512; float* ocs = a.out + O_CS + (size_t)l * 128 * 30 * 512;
            const float* st_in = a.in[3] + (size_t)l * 128 * NH * 16384; float* ors = a.out + O_RS + (size_t)l * 128 * NH * 16384;
            for (int rep = 0; rep < REP_P2; ++rep)
            for (int it = bid; it < 896; it += G) {
#ifndef SKIP_P2
                if (it < 256) { conv_pair(lds, it, GLU, cw, cb, lng, lnb, MIX, ocp); }
                else if (it < 384) { conv_item<4, true>(lds, it - 256, 0, GLU, cache, cw, cb, lng, lnb, MIX, ocs, wave, lane); }
                else if (it < 640) { kvloc_pair(lds, it - 384, Kb, Vb, KVB); }
                else { ret_sample_pair(lds, it - 640, Qb, Kb, Vb, GATE, st_in, ors, MIX); }
#endif
            }
        }
        GRID_SYNC();
        scan_phase(KVB, SB, a.out + O_RP + (size_t)l * 8 * NH * 16384);
        GRID_SYNC();
        {
#ifndef SKIP_P3
            for (int rep = 0; rep < REP_P3; ++rep)
            for (int it = bid; it < 512; it += G) { const int h = (it >> 4) & 3; retout_item(lds, it >> 6, h, it & 15, Qb, Kb, Vb, GATE, SB, MIX, __log2f(1.0f - exp2f(-5.0f - (float)h)), wave, lane); }
#endif
        }
        GRID_SYNC();
        {
            pg8::Gemm g{MIX, (const bf16*)(wl + W_OUT), MP, D, D}; pg8::StaticOrder S; S.init(MP, D, G, bid);
            EpiRes E{XN, ssq + (size_t)(2 * l + 1) * M};
#ifndef SKIP_RES
            pg8::gemm_phase<EpiRes, pg8::StaticOrder, true, true>(lds, g, S, E);
#endif
            small_gemm32(lds, MIX, (const bf16*)(wl + W_OUT), D, E);
        }
        GRID_SYNC();
        {
            pg8::Gemm g{XN, (const bf16*)(wl + W_UP), MP, FF, D}; pg8::StaticOrder S; S.init(MP, FF, G, bid);
            EpiUp E{ssq + (size_t)(2 * l + 1) * M, Hb};
#ifndef SKIP_UP
            for (int rep = 0; rep < REP_BIG; ++rep) pg8::gemm_phase<EpiUp, pg8::StaticOrder, true, true>(lds, g, S, E);
#endif
            for (int rep = 0; rep < REP_SMALL; ++rep) small_gemm<EpiUp, 2>(lds, XN, (const bf16*)(wl + W_UP), D, 64, E);
        }
        GRID_SYNC();
        {
            pg8::Gemm g{Hb, (const bf16*)(wl + W_DN), MP, D, FF}; pg8::StaticOrder S; S.init(MP, D, G, bid);
            EpiRes E{XN, ssq + (size_t)(2 * l + 2) * M};
#ifndef SKIP_RES
            pg8::gemm_phase<EpiRes, pg8::StaticOrder, true, true>(lds, g, S, E);
#endif
            small_gemm32(lds, Hb, (const bf16*)(wl + W_DN), FF, E);
        }
        GRID_SYNC();
    }
    {
        const float* gf = a.in[15]; const float* sq = ssq + (size_t)4 * M;
        const int gw = bid * NWAVES + wave, NGW = G * NWAVES;
        for (int m0 = gw; m0 < M; m0 += 4 * NGW) {
            u32x4 v[4][2]; float rs[4];
#pragma unroll
            for (int u = 0; u < 4; ++u) {
                const int m = (m0 + u * NGW) < M ? (m0 + u * NGW) : m0;
                rs[u] = sq[m];
                v[u][0] = *(const u32x4*)(XN + (size_t)m * D + 8 * lane); v[u][1] = *(const u32x4*)(XN + (size_t)m * D + 8 * lane + 512);
            }
#pragma unroll
            for (int u = 0; u < 4; ++u) {
                const int m = m0 + u * NGW;
                if (m < M) {
                    const float rstd = rsqrtf(rs[u] * (1.0f / D) + EPS);
                    float* yrow = XR + (size_t)m * D;
#pragma unroll
                    for (int j = 0; j < 2; ++j) {
                        const u32x4 w = v[u][j];
                        const f32x4 g0 = *(const f32x4*)(gf + 8 * lane + 512 * j), g1 = *(const f32x4*)(gf + 8 * lane + 512 * j + 4);
                        f32x4 y0, y1;
                        y0[0] = bflo(w.x) * rstd * g0[0]; y0[1] = bfhi(w.x) * rstd * g0[1]; y0[2] = bflo(w.y) * rstd * g0[2]; y0[3] = bfhi(w.y) * rstd * g0[3];
                        y1[0] = bflo(w.z) * rstd * g1[0]; y1[1] = bfhi(w.z) * rstd * g1[1]; y1[2] = bflo(w.w) * rstd * g1[2]; y1[3] = bfhi(w.w) * rstd * g1[3];
                        __builtin_nontemporal_store(y0, (f32x4*)(yrow + 8 * lane + 512 * j)); __builtin_nontemporal_store(y1, (f32x4*)(yrow + 8 * lane + 512 * j + 4));
                    }
                }
            }
        }
    }
}

extern "C" void kernel_launch(void* const* d_in, const int* in_sizes, int n_in, void* d_out, int out_size, void* d_ws, size_t ws_size, hipStream_t stream) {
    static int grid = 0;
    if (grid == 0) {
        int dev = 0, cus = 0, per_cu = 0;
        (void)hipGetDevice(&dev);
        (void)hipDeviceGetAttribute(&cus, hipDeviceAttributeMultiprocessorCount, dev);
        (void)hipFuncSetAttribute((const void*)mega_fwd, hipFuncAttributeMaxDynamicSharedMemorySize, LDS_BYTES);
        (void)hipOccupancyMaxActiveBlocksPerMultiprocessor(&per_cu, (const void*)mega_fwd, NTHREADS, LDS_BYTES);
        if (per_cu < 1) per_cu = 1;
        if (per_cu > 1) per_cu = 1;
        grid = cus * per_cu;
        if (n_in != 16 || ws_size < WS_END) { fprintf(stderr, "kernel_launch: unexpected n_in %d / ws %zu\n", n_in, ws_size); }
    }
    (void)hipMemsetAsync((char*)d_ws + WS_CTL, 0, CTL_BYTES, stream);
    Args a{};
    for (int i = 0; i < 16; ++i) a.in[i] = (const float*)d_in[i];
    a.out = (float*)d_out; a.ws = (unsigned char*)d_ws;
    void* args[] = {&a};
    hipError_t e = hipLaunchCooperativeKernel((const void*)mega_fwd, dim3(grid), dim3(NTHREADS), args, LDS_BYTES, stream);
    if (e != hipSuccess) fprintf(stderr, "cooperative launch failed: %s (grid %d)\n", hipGetErrorString(e), grid);
}
```
